# Optimizing an MI355X kernel written in HIP

```python
import math
import jax, jax.numpy as jnp
from jax import lax
import numpy as np

D_MODEL = 1024
BATCH = 2
SEQ = 8192
DEPTH = 4
DEC_BATCH = 128
DEC_SEQ = 1
PAST_LEN = 8192
PAGE_SIZE = 128

N_MEM = 256
EPS = 1e-6
GLA_HEADS = 4
GLA_DK = 48
GLA_DV = 96
GLA_RANK = 16
GLA_TAU = 16.0
GLA_CHUNK = 64
RG_WIDTH = 384
RG_BLOCKS = 4
RG_BW = RG_WIDTH // RG_BLOCKS
RG_C = 8.0
CONV_W = 4
SWA_HEADS = 4
SWA_KV = 2
SWA_G = SWA_HEADS // SWA_KV
HEAD_DIM = 64
WINDOW = 128
MEM_HEADS = 4
MEM_HD = 64
D_FF = 4 * D_MODEL

GLA_QK = GLA_HEADS * GLA_DK
GLA_V = GLA_HEADS * GLA_DV
SWA_Q = SWA_HEADS * HEAD_DIM
SWA_KVW = SWA_KV * HEAD_DIM
MIX_WIDTH = GLA_V + RG_WIDTH + SWA_Q
IN_SPLITS = (GLA_QK, GLA_QK, GLA_V, GLA_RANK, GLA_V, RG_WIDTH, RG_WIDTH, SWA_Q, SWA_KVW, SWA_KVW)
IN_WIDTH = GLA_QK * 2 + GLA_V * 2 + GLA_RANK + RG_WIDTH * 2 + SWA_Q + SWA_KVW * 2

kernel_name = "hymba_gla_rglru_swa_step"


def rmsnorm(x, g):
    xf = x.astype(jnp.float32)
    y = xf * lax.rsqrt(jnp.mean(xf * xf, axis=-1, keepdims=True) + EPS)
    return (y * g.astype(jnp.float32)).astype(x.dtype)


def split_cols(h):
    outs, start = [], 0
    for w in IN_SPLITS:
        outs.append(h[..., start:start + w])
        start += w
    return outs


def alibi_slopes():
    return jnp.exp2(-8.0 * jnp.arange(1, SWA_HEADS + 1, dtype=jnp.float32) / SWA_HEADS)


def gla_chunk_step(S0, inp):
    q, k, v, g = inp
    C = q.shape[1]
    cum = jnp.cumsum(g, axis=1)
    causal = jnp.tril(jnp.ones((C, C), bool))
    rel = jnp.where(causal[None, :, :, None, None], cum[:, :, None] - cum[:, None, :], -jnp.inf)
    A = jnp.einsum('bthk,bshk,btshk->bhts', q, k, jnp.exp(rel))
    o = jnp.einsum('bthk,bhkv->bthv', q * jnp.exp(cum), S0) + jnp.einsum('bhts,bshv->bthv', A, v)
    last = cum[:, -1]
    S = jnp.exp(last)[..., None] * S0 + jnp.einsum('bshk,bshv->bhkv', k * jnp.exp(last[:, None] - cum), v)
    return S, o


def gla_scan(S0, q, k, v, g):
    B, T = q.shape[:2]
    C = math.gcd(T, GLA_CHUNK)

    def to_chunks(a):
        return jnp.moveaxis(a.reshape(B, T // C, C, *a.shape[2:]), 1, 0)

    S, o = lax.scan(gla_chunk_step, S0, (to_chunks(q), to_chunks(k), to_chunks(v), to_chunks(g)))
    return S, jnp.moveaxis(o, 0, 1).reshape(B, T, GLA_HEADS, GLA_DV)


def causal_dwconv(x, buf, w, b):
    T = x.shape[1]
    xp = jnp.concatenate([buf.astype(x.dtype), x], axis=1)
    y = b
    for j in range(CONV_W):
        y = y + xp[:, j:j + T] * w[j]
    return y, xp[:, -(CONV_W - 1):]


def rglru(xc, h0, w_a, b_a, w_x, b_x, lam):
    f32 = jnp.float32
    B, T, _ = xc.shape
    xf = xc.astype(f32)
    xb = xf.reshape(B, T, RG_BLOCKS, RG_BW)
    r = jax.nn.sigmoid(jnp.einsum('btnc,ncd->btnd', xb, w_a.astype(f32)).reshape(B, T, RG_WIDTH) + b_a.astype(f32))
    i = jax.nn.sigmoid(jnp.einsum('btnc,ncd->btnd', xb, w_x.astype(f32)).reshape(B, T, RG_WIDTH) + b_x.astype(f32))
    log_a = -RG_C * r * jax.nn.softplus(-lam.astype(f32))
    a = jnp.exp(log_a)
    bx = jnp.sqrt(-jnp.expm1(2.0 * log_a)) * (i * xf)
    bx = bx.at[:, 0].add(a[:, 0] * h0)

    def comb(l, rr):
        return (l[0] * rr[0], rr[0] * l[1] + rr[1])

    _, h = lax.associative_scan(comb, (a, bx), axis=1)
    return h, h[:, -1]


def swa_attend(q, k, v, key_valid, slopes, sinks):
    T, S = q.shape[2], k.shape[2]
    dist = (S - T + jnp.arange(T, dtype=jnp.float32))[:, None] - jnp.arange(S, dtype=jnp.float32)[None, :]
    allowed = (dist >= 0) & (dist <= WINDOW) & key_valid[:, None, :]
    s = jnp.einsum('bntkgd,bnskd->bnkgts', q, k).astype(jnp.float32) * HEAD_DIM ** -0.5
    s = s - slopes[:, :, None, None] * dist
    s = jnp.where(allowed[None, :, None, None], s, -jnp.inf)
    sink = jnp.broadcast_to(sinks.astype(jnp.float32)[:, :, None, None], s.shape[:-1] + (1,))
    p = jax.nn.softmax(jnp.concatenate([s, sink], axis=-1), axis=-1)[..., :-1]
    return jnp.einsum('bnkgts,bnskd->bntkgd', p.astype(v.dtype), v)


def mixer_block(x, gla_S0, rg_h0, rg_buf, swa_kbuf, swa_vbuf, g_mix, w_in, gla_w_gate2, gla_b_gate, gla_g_out,
                rg_conv_w, rg_conv_b, rg_w_a, rg_b_a, rg_w_x, rg_b_x, rg_lam, swa_g_q, swa_g_k, swa_sinks, w_out):
    f32 = jnp.float32
    B, T, _ = x.shape
    h = rmsnorm(x, g_mix) @ w_in
    gq, gk, gv, glr, gog, rx, ry, sq, sk, sv = split_cols(h)
    q = gq.reshape(B, T, GLA_HEADS, GLA_DK).astype(f32) * GLA_DK ** -0.5
    k = gk.reshape(B, T, GLA_HEADS, GLA_DK).astype(f32)
    v = gv.reshape(B, T, GLA_HEADS, GLA_DV).astype(f32)
    glog = jax.nn.log_sigmoid((glr @ gla_w_gate2 + gla_b_gate).astype(f32)).reshape(B, T, GLA_HEADS, GLA_DK) / GLA_TAU
    S, o = gla_scan(gla_S0.astype(f32), q, k, v, glog)
    o_gla = (rmsnorm(o, gla_g_out) * jax.nn.silu(gog.astype(f32)).reshape(B, T, GLA_HEADS, GLA_DV))
    o_gla = o_gla.reshape(B, T, GLA_V).astype(x.dtype)
    xc, rg_buf_new = causal_dwconv(rx, rg_buf, rg_conv_w, rg_conv_b)
    hr, h_last = rglru(xc, rg_h0.astype(f32), rg_w_a, rg_b_a, rg_w_x, rg_b_x, rg_lam)
    o_rg = (hr * jax.nn.gelu(ry.astype(f32))).astype(x.dtype)
    q = rmsnorm(sq.reshape(B, T, SWA_HEADS, HEAD_DIM), swa_g_q).reshape(B, T, SWA_KV, SWA_G, HEAD_DIM)
    k = rmsnorm(sk.reshape(B, T, SWA_KV, HEAD_DIM), swa_g_k)
    v = sv.reshape(B, T, SWA_KV, HEAD_DIM)
    slopes = alibi_slopes().reshape(SWA_KV, SWA_G)
    sinks = swa_sinks.reshape(SWA_KV, SWA_G)
    if swa_kbuf is None:
        NB = T // WINDOW
        qb = q.reshape(B, NB, WINDOW, SWA_KV, SWA_G, HEAD_DIM)

        def band(a):
            ab = a.reshape(B, NB, WINDOW, SWA_KV, HEAD_DIM)
            prev = jnp.concatenate([jnp.zeros_like(ab[:, :1]), ab[:, :-1]], axis=1)
            return jnp.concatenate([prev, ab], axis=2)

        valid = (jnp.arange(NB)[:, None] > 0) | (jnp.arange(2 * WINDOW)[None, :] >= WINDOW)
        o = swa_attend(qb, band(k), band(v), valid, slopes, sinks)
        kb_new, vb_new = k[:, -WINDOW:], v[:, -WINDOW:]
    else:
        kk = jnp.concatenate([swa_kbuf.astype(k.dtype), k], axis=1)
        vv = jnp.concatenate([swa_vbuf.astype(v.dtype), v], axis=1)
        valid = jnp.ones((1, WINDOW + T), bool)
        o = swa_attend(q[:, None], kk[:, None], vv[:, None], valid, slopes, sinks)
        kb_new, vb_new = kk[:, -WINDOW:], vv[:, -WINDOW:]
    o_swa = o.reshape(B, T, SWA_Q).astype(x.dtype)
    y = jnp.concatenate([o_gla, o_rg, o_swa], axis=-1) @ w_out
    return y, S.astype(x.dtype), h_last.astype(x.dtype), rg_buf_new, kb_new, vb_new


def mem_kv(mem, g_m, w_kv, g_k):
    B = mem.shape[0]
    kv = rmsnorm(mem, g_m) @ w_kv
    k, v = jnp.split(kv, 2, axis=-1)
    k = rmsnorm(k.reshape(B, -1, MEM_HEADS, MEM_HD), g_k)
    return k, v.reshape(B, -1, MEM_HEADS, MEM_HD)


def mem_attend(x, mk, mv, g_x, w_q, g_q, w_o):
    B, T, _ = x.shape
    q = rmsnorm((rmsnorm(x, g_x) @ w_q).reshape(B, T, MEM_HEADS, MEM_HD), g_q)
    s = jnp.einsum('bthd,bshd->bhts', q, mk.astype(q.dtype)).astype(jnp.float32) * MEM_HD ** -0.5
    p = jax.nn.softmax(s, axis=-1).astype(x.dtype)
    o = jnp.einsum('bhts,bshd->bthd', p, mv.astype(x.dtype)).reshape(B, T, MEM_HEADS * MEM_HD)
    return o @ w_o


def ffn(x, g, w1, w2):
    h = rmsnorm(x, g) @ w1
    return jnp.square(jax.nn.relu(h)) @ w2


def setup_inputs(seed: int = 0) -> dict:
    key = jax.random.key(seed)
    k = jax.random.split(key, 40)
    f32 = jnp.float32

    def nrm(kk, shape, scale):
        return jax.random.normal(kk, shape, f32) * scale

    def gain(kk, shape):
        return 1.0 + nrm(kk, shape, 0.02)

    u = jax.random.uniform(k[21], (DEPTH, RG_WIDTH), f32, minval=0.9, maxval=0.999)
    a_base = u ** (1.0 / RG_C)
    rg_lam = jnp.log(a_base) - jnp.log1p(-a_base)
    return {
        "x_prompt": nrm(k[0], (BATCH, SEQ, D_MODEL), 1.0),
        "x_sample": nrm(k[1], (DEC_BATCH, DEC_SEQ, D_MODEL), 1.0),
        "mem_prompt": nrm(k[2], (BATCH, N_MEM, D_MODEL), 1.0),
        "state_gla": nrm(k[3], (DEPTH, DEC_BATCH, GLA_HEADS, GLA_DK, GLA_DV), 0.3),
        "state_rg_h": nrm(k[4], (DEPTH, DEC_BATCH, RG_WIDTH), 0.5),
        "state_rg_conv": nrm(k[5], (DEPTH, DEC_BATCH, CONV_W - 1, RG_WIDTH), 1.0),
        "cache_swa_k": nrm(k[6], (DEPTH, DEC_BATCH, WINDOW, SWA_KV, HEAD_DIM), 1.0),
        "cache_swa_v": nrm(k[7], (DEPTH, DEC_BATCH, WINDOW, SWA_KV, HEAD_DIM), 1.0),
        "cache_mem_k": nrm(k[8], (DEPTH, DEC_BATCH, N_MEM, MEM_HEADS, MEM_HD), 1.0),
        "cache_mem_v": nrm(k[9], (DEPTH, DEC_BATCH, N_MEM, MEM_HEADS, MEM_HD), 1.0),
        "g_mix": gain(k[10], (DEPTH, D_MODEL)),
        "w_in": nrm(k[11], (DEPTH, D_MODEL, IN_WIDTH), D_MODEL ** -0.5),
        "gla_w_gate2": nrm(k[12], (DEPTH, GLA_RANK, GLA_QK), GLA_RANK ** -0.5),
        "gla_b_gate": nrm(k[13], (DEPTH, GLA_QK), 0.1),
        "gla_g_out": gain(k[14], (DEPTH, GLA_DV)),
        "rg_conv_w": nrm(k[15], (DEPTH, CONV_W, RG_WIDTH), CONV_W ** -0.5),
        "rg_conv_b": nrm(k[16], (DEPTH, RG_WIDTH), 0.02),
        "rg_w_a": nrm(k[17], (DEPTH, RG_BLOCKS, RG_BW, RG_BW), RG_BW ** -0.5),
        "rg_b_a": nrm(k[18], (DEPTH, RG_WIDTH), 0.02),
        "rg_w_x": nrm(k[19], (DEPTH, RG_BLOCKS, RG_BW, RG_BW), RG_BW ** -0.5),
        "rg_b_x": nrm(k[20], (DEPTH, RG_WIDTH), 0.02),
        "rg_lam": rg_lam,
        "swa_g_q": gain(k[22], (DEPTH, HEAD_DIM)),
        "swa_g_k": gain(k[23], (DEPTH, HEAD_DIM)),
        "swa_sinks": nrm(k[24], (DEPTH, SWA_HEADS), 0.5),
        "w_out": nrm(k[25], (DEPTH, MIX_WIDTH, D_MODEL), 0.5 * MIX_WIDTH ** -0.5),
        "g_mem_x": gain(k[26], (DEPTH, D_MODEL)),
        "g_mem_m": gain(k[27], (DEPTH, D_MODEL)),
        "mem_w_q": nrm(k[28], (DEPTH, D_MODEL, MEM_HEADS * MEM_HD), D_MODEL ** -0.5),
        "mem_w_kv": nrm(k[29], (DEPTH, D_MODEL, 2 * MEM_HEADS * MEM_HD), D_MODEL ** -0.5),
        "mem_g_q": gain(k[30], (DEPTH, MEM_HD)),
        "mem_g_k": gain(k[31], (DEPTH, MEM_HD)),
        "mem_w_o": nrm(k[32], (DEPTH, MEM_HEADS * MEM_HD, D_MODEL), 0.5 * (MEM_HEADS * MEM_HD) ** -0.5),
        "g_ffn": gain(k[33], (DEPTH, D_MODEL)),
        "ffn_w1": nrm(k[34], (DEPTH, D_MODEL, D_FF), D_MODEL ** -0.5),
        "ffn_w2": nrm(k[35], (DEPTH, D_FF, D_MODEL), 0.5 * D_FF ** -0.5),
    }


def reference(x_prompt, x_sample, mem_prompt, state_gla, state_rg_h, state_rg_conv, cache_swa_k, cache_swa_v,
              cache_mem_k, cache_mem_v, g_mix, w_in, gla_w_gate2, gla_b_gate, gla_g_out, rg_conv_w, rg_conv_b,
              rg_w_a, rg_b_a, rg_w_x, rg_b_x, rg_lam, swa_g_q, swa_g_k, swa_sinks, w_out, g_mem_x, g_mem_m,
              mem_w_q, mem_w_kv, mem_g_q, mem_g_k, mem_w_o, g_ffn, ffn_w1, ffn_w2):
    xp, xs = x_prompt, x_sample
    Bp = xp.shape[0]
    gla_p, gla_s, rgh_p, rgh_s, rgc_p, rgc_s = [], [], [], [], [], []
    swk_p, swk_s, swv_p, swv_s, memk_p, memv_p = [], [], [], [], [], []
    for l in range(DEPTH):
        mix_w = (g_mix[l], w_in[l], gla_w_gate2[l], gla_b_gate[l], gla_g_out[l], rg_conv_w[l], rg_conv_b[l],
                 rg_w_a[l], rg_b_a[l], rg_w_x[l], rg_b_x[l], rg_lam[l], swa_g_q[l], swa_g_k[l], swa_sinks[l], w_out[l])
        S0 = jnp.zeros((Bp, GLA_HEADS, GLA_DK, GLA_DV), jnp.float32)
        h0 = jnp.zeros((Bp, RG_WIDTH), jnp.float32)
        cb0 = jnp.zeros((Bp, CONV_W - 1, RG_WIDTH), xp.dtype)
        y, S, hl, cb, kb, vb = mixer_block(xp, S0, h0, cb0, None, None, *mix_w)
        xp = xp + y
        mk, mv = mem_kv(mem_prompt, g_mem_m[l], mem_w_kv[l], mem_g_k[l])
        xp = xp + mem_attend(xp, mk, mv, g_mem_x[l], mem_w_q[l], mem_g_q[l], mem_w_o[l])
        xp = xp + ffn(xp, g_ffn[l], ffn_w1[l], ffn_w2[l])
        gla_p.append(S); rgh_p.append(hl); rgc_p.append(cb); swk_p.append(kb); swv_p.append(vb)
        memk_p.append(mk); memv_p.append(mv)
        y, S, hl, cb, kb, vb = mixer_block(xs, state_gla[l], state_rg_h[l], state_rg_conv[l],
                                           cache_swa_k[l], cache_swa_v[l], *mix_w)
        xs = xs + y
        xs = xs + mem_attend(xs, cache_mem_k[l], cache_mem_v[l], g_mem_x[l], mem_w_q[l], mem_g_q[l], mem_w_o[l])
        xs = xs + ffn(xs, g_ffn[l], ffn_w1[l], ffn_w2[l])
        gla_s.append(S); rgh_s.append(hl); rgc_s.append(cb); swk_s.append(kb); swv_s.append(vb)
    return (xp, xs, jnp.stack(gla_p), jnp.stack(gla_s), jnp.stack(rgh_p), jnp.stack(rgh_s),
            jnp.stack(rgc_p), jnp.stack(rgc_s), jnp.stack(swk_p), jnp.stack(swk_s),
            jnp.stack(swv_p), jnp.stack(swv_s), jnp.stack(memk_p), jnp.stack(memv_p))
```

```cpp
#include <hip/hip_runtime.h>
#include <hip/hip_cooperative_groups.h>
#include <cstdio>
#include <cstdint>
namespace cg = cooperative_groups;
namespace pg8 {
#define PG8_LAS __attribute__((address_space(3)))
typedef unsigned short bf16_t;
typedef short bf16x8 __attribute__((ext_vector_type(8)));
typedef float f32x4 __attribute__((ext_vector_type(4)));
typedef unsigned u32x4 __attribute__((ext_vector_type(4)));
constexpr int BM = 256, BK = 64, HALF = 128, HTB = HALF * BK * 2  , STAGE_BYTES = 8 * HTB, NXCD = 8, WGM = 8;

__host__ __device__ __forceinline__ int lds_byte(int r, int c) { const int st = (r >> 4) * 2 + (c >> 5), rr = r & 15, cc = c & 31, ob = rr * 64 + cc * 2; return st * 1024 + (ob ^ (((ob >> 9) & 1) << 5)); }
__host__ __device__ __forceinline__ void stage_rc(int b, int& R, int& C) { const int st = b / 1024, sb = b % 1024, swz = sb ^ (((sb >> 9) & 1) << 5); R = (st >> 1) * 16 + swz / 64; C = (st & 1) * 32 + (swz % 64) / 2; }
__host__ __device__ __forceinline__ int perm32(int rho) { const int n = rho >> 4, i = rho & 15; return 8 * (i >> 2) + 4 * n + (i & 3); }

struct Unit { int pm, pn; };
struct Gemm { const bf16_t* A; const bf16_t* Bt; int M, N, K; };

struct StaticOrder {
    int nM, nN, nwg, G, c;
    __host__ __device__ void init(int M, int N, int G_, int c_) { nM = M / BM; nN = N / BM; nwg = nM * nN; G = G_; c = c_; }
    __host__ __device__ bool next(int i, Unit& u) const {
        const long L = (long)i * G + c; if (L >= nwg) return false;
        int wgid = (int)L; { const int q = nwg / NXCD, r = nwg % NXCD, xcd = wgid % NXCD, off = wgid / NXCD; wgid = (xcd < r ? xcd * (q + 1) : r * (q + 1) + (xcd - r) * q) + off; }
        const int nig = WGM * nN, gid = wgid / nig, fm = gid * WGM, gsz = (nM - fm) < WGM ? (nM - fm) : WGM;
        u.pm = fm + ((wgid % nig) % gsz); u.pn = (wgid % nig) / gsz; return true;
    }
    __device__ __forceinline__ void a_ready(const Unit&) const {}
    __device__ __forceinline__ void done(const Unit&) const {}
};

__device__ __forceinline__ unsigned cvt_pk_bf16(float lo, float hi) { unsigned r; asm volatile("v_cvt_pk_bf16_f32 %0, %1, %2" : "=v"(r) : "v"(lo), "v"(hi)); return r; }
template <class Epi, class Sched, bool ALIGN_EPI = false, bool SP2 = false>
__device__ __forceinline__ void gemm_phase(PG8_LAS unsigned char* lds, const Gemm g, const Sched& S, const Epi& E) {
    int tid_l = threadIdx.x; asm volatile("" : "+v"(tid_l)); const int tid = tid_l, wid = __builtin_amdgcn_readfirstlane(tid >> 6), lane = tid & 63, wr = wid >> 2, wc = wid & 3, fr = lane & 15, fq = lane >> 4;
    const int K = g.K, nt = K / BK;
    unsigned voffA[2], voffB[2];
#pragma unroll
    for (int i = 0; i < 2; ++i) { int R, C; stage_rc(tid * 16 + i * 8192, R, C); const int Rb = Epi::PERM ? ((R & ~31) + perm32(R & 31)) : R;
        voffA[i] = (unsigned)(R * K + C) * 2u; voffB[i] = (unsigned)(Rb * K + C) * 2u; }
    const size_t kstep = (size_t)(BK * 2);
    const size_t hstep = (size_t)HALF * K * 2;
    const size_t tstep = 2 * hstep;
    const unsigned ldsw = (unsigned)wid * 1024u;
    const int aoff = lds_byte(wr * 64 + fr, fq * 8), boff = lds_byte(wc * 32 + fr, fq * 8);
#define PG8_SA(b, h) (((b) * 2 + (h)) * HTB)
#define PG8_SB(b, h) ((4 + (b) * 2 + (h)) * HTB)
#define PG8_STAGE(bufoff, gbase, voff) do { _Pragma("unroll") for (int _i = 0; _i < 2; ++_i) \
        __builtin_amdgcn_global_load_lds((const unsigned*)((const char*)(gbase) + (voff)[_i]), (PG8_LAS unsigned*)(lds + (bufoff) + ldsw + _i * 8192), 16, 0, 0); } while (0)
#define PG8_LDA(dst, b, h) do { _Pragma("unroll") for (int m = 0; m < 4; ++m) _Pragma("unroll") for (int k = 0; k < 2; ++k) dst[m][k] = *(const PG8_LAS bf16x8*)(lds + PG8_SA(b, h) + aoff + m * 2048 + k * 1024); } while (0)
#define PG8_LDB(dst, b, h) do { _Pragma("unroll") for (int n = 0; n < 2; ++n) _Pragma("unroll") for (int k = 0; k < 2; ++k) dst[n][k] = *(const PG8_LAS bf16x8*)(lds + PG8_SB(b, h) + boff + n * 2048 + k * 1024); } while (0)
#define PG8_MMA(ai, bj, At, Bt) do { __builtin_amdgcn_s_setprio(1); _Pragma("unroll") for (int m = 0; m < 4; ++m) _Pragma("unroll") for (int n = 0; n < 2; ++n) _Pragma("unroll") for (int k = 0; k < 2; ++k) \
        acc[ai][bj][m][n] = __builtin_amdgcn_mfma_f32_16x16x32_bf16(Bt[n][k], At[m][k], acc[ai][bj][m][n], 0, 0, 0); __builtin_amdgcn_s_setprio(0); } while (0)
#define PG8_WAIT_V(n) asm volatile("s_waitcnt vmcnt(" #n ")" ::: "memory")
#define PG8_WAIT_L(n) asm volatile("s_waitcnt lgkmcnt(" #n ")" ::: "memory")
#define PG8_BAR __builtin_amdgcn_s_barrier()
#define PG8_SCHED __builtin_amdgcn_sched_barrier(0)
    Unit cur, nxt; int ui = 0;
    if (!S.next(0, cur)) return;
    f32x4 acc[2][2][4][2];
#pragma unroll
    for (int a = 0; a < 2; ++a)
#pragma unroll
        for (int b = 0; b < 2; ++b)
#pragma unroll
            for (int m = 0; m < 4; ++m)
#pragma unroll
                for (int n = 0; n < 2; ++n) acc[a][b][m][n] = (f32x4){0.f, 0.f, 0.f, 0.f};
    bf16x8 At[4][2], B0[2][2], B1[2][2];
    const char* cA = (const char*)g.A + (size_t)cur.pm * tstep; const char* cB = (const char*)g.Bt + (size_t)cur.pn * tstep;
    S.a_ready(cur);
    if constexpr (SP2) {
        PG8_STAGE(PG8_SB(0, 0), cB, voffB); PG8_STAGE(PG8_SB(0, 1), cB + hstep, voffB); PG8_STAGE(PG8_SA(0, 0), cA, voffA); PG8_STAGE(PG8_SA(0, 1), cA + hstep, voffA);
        if (wr == 1) PG8_BAR;
        PG8_WAIT_V(2); PG8_BAR;
        PG8_STAGE(PG8_SB(1, 0), cB + kstep, voffB); PG8_STAGE(PG8_SA(1, 0), cA + kstep, voffA); PG8_STAGE(PG8_SB(1, 1), cB + hstep + kstep, voffB);
        PG8_WAIT_V(6); PG8_BAR;
    } else {
        PG8_STAGE(PG8_SB(0, 0), cB, voffB); PG8_STAGE(PG8_SA(0, 0), cA, voffA); PG8_STAGE(PG8_SB(0, 1), cB + hstep, voffB); PG8_STAGE(PG8_SA(0, 1), cA + hstep, voffA);
        if (wr == 1) PG8_BAR;
        PG8_WAIT_V(4); PG8_BAR;
        PG8_STAGE(PG8_SB(1, 0), cB + kstep, voffB); PG8_STAGE(PG8_SA(1, 0), cA + kstep, voffA); PG8_STAGE(PG8_SB(1, 1), cB + hstep + kstep, voffB);
        PG8_WAIT_V(6); PG8_BAR;
    }
    for (;;) {
        const bool has_next = S.next(ui + 1, nxt);
        const char* nA = has_next ? (const char*)g.A + (size_t)nxt.pm * tstep : cA; const char* nB = has_next ? (const char*)g.Bt + (size_t)nxt.pn * tstep : cB;
        for (int t = 0; t < nt; t += 2) {
            const bool last = (t == nt - 2);
            const char* a1 = cA + (size_t)(t + 1) * kstep;
            const char* a2 = last ? nA : cA + (size_t)(t + 2) * kstep; const char* b2 = last ? nB : cB + (size_t)(t + 2) * kstep;
            const char* a3 = a2 + kstep; const char* b3 = b2 + kstep;
            if (last && has_next) S.a_ready(nxt);
            if constexpr (SP2) {
            PG8_LDB(B0, 0, 0); PG8_LDB(B1, 0, 1); PG8_SCHED; PG8_LDA(At, 0, 0); PG8_STAGE(PG8_SA(1, 1), a1 + hstep, voffA);
            PG8_WAIT_V(8); PG8_WAIT_L(0); PG8_BAR; PG8_MMA(0, 0, At, B0); PG8_MMA(0, 1, At, B1); PG8_BAR; PG8_SCHED;
            PG8_LDA(At, 0, 1); PG8_STAGE(PG8_SB(0, 0), b2, voffB); PG8_STAGE(PG8_SB(0, 1), b2 + hstep, voffB); PG8_STAGE(PG8_SA(0, 0), a2, voffA);
            PG8_WAIT_V(8); PG8_WAIT_L(0); PG8_BAR; PG8_MMA(1, 0, At, B0); PG8_MMA(1, 1, At, B1); PG8_BAR; PG8_SCHED;
            PG8_LDB(B0, 1, 0); PG8_LDB(B1, 1, 1); PG8_SCHED; PG8_LDA(At, 1, 0); PG8_STAGE(PG8_SA(0, 1), a2 + hstep, voffA);
            PG8_WAIT_V(8); PG8_WAIT_L(0); PG8_BAR; PG8_MMA(0, 0, At, B0); PG8_MMA(0, 1, At, B1); PG8_BAR; PG8_SCHED;
            PG8_LDA(At, 1, 1); PG8_STAGE(PG8_SB(1, 0), b3, voffB); PG8_STAGE(PG8_SB(1, 1), b3 + hstep, voffB); PG8_STAGE(PG8_SA(1, 0), a3, voffA);
            PG8_WAIT_V(8); PG8_WAIT_L(0); PG8_BAR; PG8_MMA(1, 0, At, B0); PG8_MMA(1, 1, At, B1); PG8_BAR; PG8_SCHED;
            } else {
            PG8_LDB(B0, 0, 0); PG8_SCHED; PG8_LDA(At, 0, 0); PG8_STAGE(PG8_SA(1, 1), a1 + hstep, voffA);
            PG8_WAIT_L(8); PG8_BAR; PG8_WAIT_L(0); PG8_MMA(0, 0, At, B0); PG8_BAR; PG8_SCHED;
            PG8_LDB(B1, 0, 1); PG8_STAGE(PG8_SB(0, 0), b2, voffB);
            PG8_BAR; PG8_WAIT_L(0); PG8_MMA(0, 1, At, B1); PG8_BAR;
            PG8_LDA(At, 0, 1); PG8_STAGE(PG8_SA(0, 0), a2, voffA);
            PG8_BAR; PG8_WAIT_L(0); PG8_MMA(1, 0, At, B0); PG8_BAR; PG8_SCHED;
            PG8_STAGE(PG8_SB(0, 1), b2 + hstep, voffB);
            PG8_WAIT_V(6); PG8_BAR; PG8_MMA(1, 1, At, B1); PG8_BAR;
            PG8_LDB(B0, 1, 0); PG8_SCHED; PG8_LDA(At, 1, 0); PG8_STAGE(PG8_SA(0, 1), a2 + hstep, voffA);
            PG8_WAIT_L(8); PG8_BAR; PG8_WAIT_L(0); PG8_MMA(0, 0, At, B0); PG8_BAR; PG8_SCHED;
            PG8_LDB(B1, 1, 1); PG8_STAGE(PG8_SB(1, 0), b3, voffB);
            PG8_BAR; PG8_WAIT_L(0); PG8_MMA(0, 1, At, B1); PG8_BAR;
            PG8_LDA(At, 1, 1); PG8_STAGE(PG8_SA(1, 0), a3, voffA);
            PG8_BAR; PG8_WAIT_L(0); PG8_MMA(1, 0, At, B0); PG8_BAR; PG8_SCHED;
            PG8_STAGE(PG8_SB(1, 1), b3 + hstep, voffB);
            PG8_WAIT_V(6); PG8_BAR; PG8_MMA(1, 1, At, B1); PG8_BAR;
            }
        }
        if constexpr (ALIGN_EPI) { if (wr == 0) PG8_BAR; }
        if constexpr (!Epi::AFTER_DRAIN) { E(acc, cur, wr, wc, fr, fq); S.done(cur); }
        if (!has_next) break;
#pragma unroll
        for (int a = 0; a < 2; ++a)
#pragma unroll
            for (int b = 0; b < 2; ++b)
#pragma unroll
                for (int m = 0; m < 4; ++m)
#pragma unroll
                    for (int n = 0; n < 2; ++n) acc[a][b][m][n] = (f32x4){0.f, 0.f, 0.f, 0.f};
        cur = nxt; cA = nA; cB = nB; ++ui;
        if constexpr (ALIGN_EPI) { if (wr == 1) PG8_BAR; }
    }
    PG8_WAIT_V(0);
    if constexpr (!ALIGN_EPI) { if (wr == 0) PG8_BAR; }
    PG8_BAR;
    if constexpr (Epi::AFTER_DRAIN) { E.fused(acc, cur, wr, wc, fr, fq, lds, wid, lane); S.done(cur); }
#undef PG8_SA
#undef PG8_SB
#undef PG8_STAGE
#undef PG8_LDA
#undef PG8_LDB
#undef PG8_MMA
#undef PG8_WAIT_V
#undef PG8_WAIT_L
#undef PG8_BAR
#undef PG8_SCHED
}
}
#define GAS __attribute__((address_space(1)))
#define LAS __attribute__((address_space(3)))
typedef unsigned short bf16;
typedef unsigned v4u __attribute__((ext_vector_type(4)));
typedef float f32x4 __attribute__((ext_vector_type(4)));
typedef short bf16x8 __attribute__((ext_vector_type(8)));
typedef GAS unsigned gu32;
typedef GAS unsigned long long gu64;
#define RLX_AGENT __ATOMIC_RELAXED, __HIP_MEMORY_SCOPE_AGENT
#define LDS_WAIT() asm volatile("s_waitcnt lgkmcnt(0)" ::: "memory")
#define VM_WAIT() asm volatile("s_waitcnt vmcnt(0)" ::: "memory")
__device__ __forceinline__ unsigned long long rt() { return __builtin_amdgcn_s_memrealtime(); }
__device__ __forceinline__ unsigned f2bf(float f) { unsigned u = __builtin_bit_cast(unsigned, f); return (u + 0x7fffu + ((u >> 16) & 1u)) >> 16; }
__device__ __forceinline__ unsigned pk2(float lo, float hi) { return f2bf(lo) | (f2bf(hi) << 16); }

#define XB_TMO      128
#define XB_XCNT(j)  (256  + 64 * (j))
#define XB_XSUB(j)  (1280 + 64 * (j))
#define XB_XGEN(j)  (2304 + 64 * (j))
#define XB_TOP      3328
#define XB_TOPGEN   3392
#define XCD_BAR_WORDS 3456
#define XB_SPIN_CAP (1u << 18)

__device__ __forceinline__ unsigned xb_ld(unsigned* p)              { return __hip_atomic_load(p, __ATOMIC_RELAXED, __HIP_MEMORY_SCOPE_AGENT); }
__device__ __forceinline__ unsigned xb_add(unsigned* p, unsigned v) { return __hip_atomic_fetch_add(p, v, __ATOMIC_RELAXED, __HIP_MEMORY_SCOPE_AGENT); }
__device__ __forceinline__ unsigned xb_xcc_id() { return (unsigned)__builtin_amdgcn_s_getreg((3 << 11) | 20) & 0xFu; }
#define XB_SPIN(cond, bar) do { unsigned _sp = 0; while (cond) { __builtin_amdgcn_s_sleep(1); \
    if ((++_sp & 255u) == 0u) { if (xb_ld(&(bar)[XB_TMO])) break; if (_sp > XB_SPIN_CAP) { atomicAdd(&(bar)[XB_TMO], 1u); break; } } } } while (0)

struct XcdBarrier {
    unsigned* bar; unsigned x;
    volatile LAS unsigned* st;
};

__device__ __forceinline__ XcdBarrier xcd_barrier_post(unsigned* bar, volatile LAS unsigned* st) {
    XcdBarrier b; b.bar = bar; b.x = xb_xcc_id(); b.st = st;
    if (threadIdx.x == 0) (void)xb_add(&bar[XB_XCNT(b.x)], 1u);
    return b;
}
__device__ __forceinline__ void xcd_barrier_complete(unsigned* bar, unsigned x, unsigned& nloc, unsigned& nx) {
    const unsigned G = gridDim.x * gridDim.y * gridDim.z;
    unsigned sum, cnt, mine, sp = 0u;
    for (;;) {
        sum = 0u; cnt = 0u; mine = 0u;
#pragma unroll
        for (unsigned j = 0; j < 16; ++j) { const unsigned c = xb_ld(&bar[XB_XCNT(j)]); sum += c; cnt += (c > 0u) ? 1u : 0u; mine = (j == x) ? c : mine; }
        if (sum == G) break;
        __builtin_amdgcn_s_sleep(1);
        if ((++sp & 255u) == 0u) { if (xb_ld(&bar[XB_TMO])) break; if (sp > XB_SPIN_CAP) { atomicAdd(&bar[XB_TMO], 1u); break; } }
    }
    nloc = mine > 0u ? mine : 1u; nx = cnt > 0u ? cnt : 1u;
}

__device__ __forceinline__ void xcd_barrier(const XcdBarrier& b) {
    asm volatile("s_waitcnt vmcnt(0)" ::: "memory");
    __syncthreads();
    if (threadIdx.x == 0) {
        unsigned* bar = b.bar;
        __builtin_amdgcn_s_waitcnt(0);
        unsigned nloc = b.st[0], nx = b.st[1];
        if (nloc == 0u) { xcd_barrier_complete(bar, b.x, nloc, nx); b.st[0] = nloc; b.st[1] = nx; }
        const unsigned old = xb_add(&bar[XB_XSUB(b.x)], 1u);
        const unsigned gen = old / nloc;
        if (old + 1u == (gen + 1u) * nloc) {
            __builtin_amdgcn_fence(__ATOMIC_RELEASE, "agent");
            asm volatile("s_waitcnt vmcnt(0)" ::: "memory");
            const unsigned og = xb_add(&bar[XB_TOP], 1u);
            const unsigned tg = og / nx;
            if (og + 1u == (tg + 1u) * nx) xb_add(&bar[XB_TOPGEN], 1u);
            else XB_SPIN(xb_ld(&bar[XB_TOPGEN]) == tg, bar);
            __builtin_amdgcn_fence(__ATOMIC_ACQUIRE, "agent");
            xb_add(&bar[XB_XGEN(b.x)], 1u);
            asm volatile("s_waitcnt vmcnt(0)" ::: "memory");
        } else {
            XB_SPIN(xb_ld(&bar[XB_XGEN(b.x)]) == gen, bar);
            __builtin_amdgcn_fence(__ATOMIC_ACQUIRE, "agent");
            asm volatile("s_waitcnt vmcnt(0)" ::: "memory");
        }
    }
    __syncthreads();
}


constexpr int D = 1024, T = 8192, NB = 2, MP = NB * T, NS = 128, MR = MP + NS, M = 16640, HW = 2560, FF = 4096, DEPTH = 4, INW = 2448;
constexpr int C_GQ = 0, C_GK = 192, C_GV = 384, C_GOG = 768, C_RX = 1152, C_RY = 1536, C_SQ = 1920, C_SK = 2176, C_SV = 2304, C_GLR = 2432;
constexpr float EPS = 1e-6f;
constexpr int NTHR = 512, NWAVES = 8;
constexpr size_t O_Y = 0, O_YS = (size_t)MP * D, O_GLAP = O_YS + (size_t)NS * D, O_GLAS = O_GLAP + (size_t)DEPTH * NB * 4 * 48 * 96,
    O_RGHP = O_GLAS + (size_t)DEPTH * NS * 4 * 48 * 96, O_RGHS = O_RGHP + (size_t)DEPTH * NB * 384, O_RGCP = O_RGHS + (size_t)DEPTH * NS * 384,
    O_RGCS = O_RGCP + (size_t)DEPTH * NB * 3 * 384, O_SWKP = O_RGCS + (size_t)DEPTH * NS * 3 * 384, O_SWKS = O_SWKP + (size_t)DEPTH * NB * 128 * 128,
    O_SWVP = O_SWKS + (size_t)DEPTH * NS * 128 * 128, O_SWVS = O_SWVP + (size_t)DEPTH * NB * 128 * 128, O_MEMK = O_SWVS + (size_t)DEPTH * NS * 128 * 128,
    O_MEMV = O_MEMK + (size_t)DEPTH * NB * 256 * 256, O_END = O_MEMV + (size_t)DEPTH * NB * 256 * 256;
static_assert(O_END == 45379584, "output size");
constexpr size_t MiB = 1u << 20;
constexpr size_t WS_CTL = 0, CTL_ZERO_BYTES = 1 * MiB, WS_SS = 377 * MiB, SS_BYTES = 2 * MiB;
constexpr size_t WS_W = 2 * MiB, W_LAYER = 25 * MiB, WO_IN = 0, WO_OUT = 5 * MiB, WO_Q = 7 * MiB, WO_KV = 7 * MiB + MiB / 2, WO_O = 8 * MiB + MiB / 2, WO_1 = 9 * MiB, WO_2 = 17 * MiB;
constexpr size_t WS_XB = 102 * MiB, WS_MEMB = 135 * MiB, WS_KVRAW = 136 * MiB, WS_QM = 140 * MiB, WS_OMEM = 157 * MiB, WS_HF = 166 * MiB, WS_H = 166 * MiB, WS_OMIX = 248 * MiB;
constexpr size_t WS_CUM = 296 * MiB, WS_U = 308 * MiB, WS_DEC = 326 * MiB, WS_HLOC = 327 * MiB, WS_ACUM = 351 * MiB, WS_RGC = 375 * MiB, WS_END = 379 * MiB;
static_assert(WS_XB + (size_t)M * D * 2 <= WS_MEMB && WS_QM + (size_t)M * 256 * 4 <= WS_OMEM && WS_OMEM + (size_t)M * 256 * 2 <= WS_HF && WS_HF + (size_t)M * FF * 2 <= WS_CUM, "ws map");
static_assert(WS_H + (size_t)M * HW * 2 <= WS_OMIX && WS_OMIX + (size_t)M * D * 2 <= WS_CUM && (size_t)(13 * M + 512) * 8 <= SS_BYTES, "ws map 2");
constexpr int RGC_N = NB * 128 * 384;
constexpr int LDS_BYTES = 163840;
constexpr int CW_BAR = 4096;

struct Args { const float* in[36]; float* out; unsigned char* ws; int ph_lo, ph_hi, use_cg, pad; };

__device__ __forceinline__ float bf2f(bf16 b) { return __uint_as_float(((unsigned)b) << 16); }
__device__ __forceinline__ float wave_sum(float v) {
#pragma unroll
    for (int o = 1; o < 64; o <<= 1) v += __shfl_xor(v, o);
    return v;
}
__device__ __forceinline__ float wave_max(float v) {
#pragma unroll
    for (int o = 1; o < 64; o <<= 1) v = fmaxf(v, __shfl_xor(v, o));
    return v;
}
__device__ __forceinline__ float sigmoidf_(float x) { return 1.f / (1.f + __expf(-x)); }
__device__ __forceinline__ float softplusf_(float x) { return fmaxf(x, 0.f) + log1pf(__expf(-fabsf(x))); }
__device__ __forceinline__ float logsigf_(float x) { return fminf(x, 0.f) - log1pf(__expf(-fabsf(x))); }
__device__ __forceinline__ float gelu_tanh(float x) { return 0.5f * x * (1.f + tanhf(0.7978845608028654f * (x + 0.044715f * x * x * x))); }
__device__ __forceinline__ float siluf_(float x) { return x / (1.f + __expf(-x)); }

__device__ __forceinline__ f32x4 mm16(const LAS float* A, int sai, int sak, const LAS float* B, int sbk, int sbj, int K, f32x4 acc, int lane) {
    const int i = lane & 15, q = lane >> 4;
    const LAS float* pa = A + i * sai + q * sak; const LAS float* pb = B + q * sbk + i * sbj;
#pragma unroll 4
    for (int k = 0; k < K; k += 4) acc = __builtin_amdgcn_mfma_f32_16x16x4f32(pa[k * sak], pb[k * sbk], acc, 0, 0, 0);
    return acc;
}

namespace pg8 {
template <int ACT> struct EpiScaleBf16 {
    static constexpr bool PERM = true, AFTER_DRAIN = false;
    bf16_t* O; int ldc; const unsigned long long* ss;
    __device__ __forceinline__ void operator()(const f32x4 (&acc)[2][2][4][2], const Unit& u, int wr, int wc, int fr, int fq) const {
        const int row0 = u.pm * BM + wr * 64 + fr; const int col0 = u.pn * BM + wc * 32 + 8 * fq;
#pragma unroll
        for (int ai = 0; ai < 2; ++ai)
#pragma unroll
            for (int m = 0; m < 4; ++m) { const int row = row0 + ai * HALF + m * 16; const float sc = rsqrtf((float)ss[row] * (1.f / (1024.f * 16777216.f)) + 1e-6f); bf16_t* rowp = O + (size_t)row * ldc + col0;
#pragma unroll
                for (int bj = 0; bj < 2; ++bj) { f32x4 v0 = acc[ai][bj][m][0] * sc, v1 = acc[ai][bj][m][1] * sc;
                    if (ACT == 1) {
#pragma unroll
                        for (int e = 0; e < 4; ++e) { float a = fmaxf(v0[e], 0.f), b = fmaxf(v1[e], 0.f); v0[e] = a * a; v1[e] = b * b; } }
                    u32x4 w; w.x = cvt_pk_bf16(v0[0], v0[1]); w.y = cvt_pk_bf16(v0[2], v0[3]); w.z = cvt_pk_bf16(v1[0], v1[1]); w.w = cvt_pk_bf16(v1[2], v1[3]);
                    *(u32x4*)(rowp + bj * HALF) = w; } }
    }
};
struct EpiScaleF32 {
    static constexpr bool PERM = false, AFTER_DRAIN = false;
    float* O; int ldc; const unsigned long long* ss;
    __device__ __forceinline__ void operator()(const f32x4 (&acc)[2][2][4][2], const Unit& u, int wr, int wc, int fr, int fq) const {
        const int row0 = u.pm * BM + wr * 64 + fr; const int col0 = u.pn * BM + wc * 32 + 4 * fq;
#pragma unroll
        for (int ai = 0; ai < 2; ++ai)
#pragma unroll
            for (int m = 0; m < 4; ++m) { const int row = row0 + ai * HALF + m * 16; const float sc = rsqrtf((float)ss[row] * (1.f / (1024.f * 16777216.f)) + 1e-6f); float* rowp = O + (size_t)row * ldc + col0;
#pragma unroll
                for (int bj = 0; bj < 2; ++bj)
#pragma unroll
                    for (int n = 0; n < 2; ++n) *(f32x4*)(rowp + bj * HALF + n * 16) = acc[ai][bj][m][n] * sc; }
    }
};
struct EpiResid {
    static constexpr bool PERM = false, AFTER_DRAIN = false;
    float* X; bf16_t* XB; unsigned long long* ssout; int mreal;
    __device__ __forceinline__ void operator()(const f32x4 (&acc)[2][2][4][2], const Unit& u, int wr, int wc, int fr, int fq) const {
        typedef unsigned u32x2v __attribute__((ext_vector_type(2)));
        const int row0 = u.pm * BM + wr * 64 + fr; const int col0 = u.pn * BM + wc * 32 + 4 * fq;
#pragma unroll
        for (int ai = 0; ai < 2; ++ai)
#pragma unroll
            for (int m = 0; m < 4; ++m) { const int row = row0 + ai * HALF + m * 16; const bool ok = row < mreal; float s = 0.f;
                if (ok) { float* xr = X + (size_t)row * 1024 + col0; bf16_t* br = XB + (size_t)row * 1024 + col0;
#pragma unroll
                    for (int bj = 0; bj < 2; ++bj)
#pragma unroll
                        for (int n = 0; n < 2; ++n) { f32x4 v = *(const f32x4*)(xr + bj * HALF + n * 16) + acc[ai][bj][m][n]; *(f32x4*)(xr + bj * HALF + n * 16) = v;
                            u32x2v w; w.x = cvt_pk_bf16(v[0], v[1]); w.y = cvt_pk_bf16(v[2], v[3]); *(u32x2v*)(br + bj * HALF + n * 16) = w;
                            s += (v[0] * v[0] + v[1] * v[1]) + (v[2] * v[2] + v[3] * v[3]); } }
                s += __shfl_xor(s, 16); s += __shfl_xor(s, 32);
                if (ok && fq == 0) __hip_atomic_fetch_add(ssout + row, (unsigned long long)(s * 16777216.f), __ATOMIC_RELAXED, __HIP_MEMORY_SCOPE_AGENT); }
    }
};
}

__device__ __forceinline__ int win_map(int n) { return n < 768 ? n : (n < 784 ? n - 768 + C_GLR : n - 16); }
__device__ __forceinline__ void tr_item(const float* W, const float* g, int K, int N, bf16* WT, bool remap, LAS float* scr, int item, int lane) {
    const int nblk = (N + 31) / 32, kb = item / nblk, nb = item % nblk, k0 = 64 * kb, n0 = 32 * nb; const int nn = n0 + (lane & 31);
#pragma unroll 8
    for (int i = 0; i < 32; ++i) { const int kk = 2 * i + (lane >> 5); float w = 0.f; if (nn < N) { w = W[(size_t)(k0 + kk) * N + nn]; if (g) w *= g[k0 + kk]; } scr[kk * 33 + (lane & 31)] = w; }
    LDS_WAIT(); asm volatile("" ::: "memory");
    const int c = lane & 7;
#pragma unroll
    for (int j = 0; j < 4; ++j) { const int n = (lane >> 3) + 8 * j; const LAS float* s = scr + (8 * c) * 33 + n; const int src = n0 + n;
        if (src < N) { const int dst = remap ? win_map(src) : src;
            v4u o; o.x = pk2(s[0 * 33], s[1 * 33]); o.y = pk2(s[2 * 33], s[3 * 33]); o.z = pk2(s[4 * 33], s[5 * 33]); o.w = pk2(s[6 * 33], s[7 * 33]);
            *(v4u*)(WT + (size_t)dst * K + k0 + 8 * c) = o; } }
    LDS_WAIT(); asm volatile("" ::: "memory");
}

__global__ void __launch_bounds__(NTHR, 2) mk_fwd(Args a) {
    extern __shared__ __attribute__((aligned(16))) unsigned char lds_raw[];
    LAS unsigned char* lds = (LAS unsigned char*)lds_raw;
    LAS float* L = (LAS float*)lds;
    const int tid0 = threadIdx.x, wave = __builtin_amdgcn_readfirstlane(tid0 >> 6);
#define TID_DECL int tid_l = tid0; asm volatile("" : "+v"(tid_l)); const int tid = tid_l, lane = tid & 63, fr = lane & 15, fq = lane >> 4; (void)fr; (void)fq; (void)lane;
    const int G = gridDim.x, bid = blockIdx.x;
    unsigned char* ws = a.ws; float* out = a.out;
    unsigned long long* SS = (unsigned long long*)(ws + WS_SS); unsigned long long* SSM = SS + 12 * M;
    bf16* XB = (bf16*)(ws + WS_XB); bf16* MEMB = (bf16*)(ws + WS_MEMB); float* KVRAW = (float*)(ws + WS_KVRAW); float* QM = (float*)(ws + WS_QM);
    bf16* OMEM = (bf16*)(ws + WS_OMEM); bf16* HF = (bf16*)(ws + WS_HF); bf16* H = (bf16*)(ws + WS_H); bf16* OMIX = (bf16*)(ws + WS_OMIX);
    float* CUM = (float*)(ws + WS_CUM); float* U = (float*)(ws + WS_U); float* DEC = (float*)(ws + WS_DEC); float* HLOC = (float*)(ws + WS_HLOC); float* ACUM = (float*)(ws + WS_ACUM);
    float* HEND = (float*)(ws + WS_RGC); float* AEND = HEND + RGC_N; float* CARRY = AEND + RGC_N;
    cg::grid_group grid = cg::this_grid();
    int ph = 0;
#define PH_ON (ph >= a.ph_lo && ph < a.ph_hi)
#define PH_NEXT do { ++ph; if (ph > a.ph_lo && ph < a.ph_hi) { grid.sync(); } } while (0)

    if (PH_ON) { TID_DECL
        LAS float* scr = L + wave * 4096;
        const int gw = bid * NWAVES + wave, NGW = G * NWAVES;
        constexpr int I_IN = 16 * 77, I_OUT = 16 * 32, I_Q = 16 * 8, I_KV = 16 * 16, I_O = 4 * 32, I_1 = 16 * 128, I_2 = 64 * 32;
        constexpr int I_L = I_IN + I_OUT + I_Q + I_KV + I_O + I_1 + I_2;
        for (int it = gw; it < DEPTH * I_L; it += NGW) {
            const int l = it / I_L; int r = it % I_L; unsigned char* wl = ws + WS_W + (size_t)l * W_LAYER;
            if (r < I_IN) { tr_item(a.in[11] + (size_t)l * D * INW, a.in[10] + l * D, D, INW, (bf16*)(wl + WO_IN), true, scr, r, lane); continue; } r -= I_IN;
            if (r < I_OUT) { tr_item(a.in[25] + (size_t)l * D * D, nullptr, D, D, (bf16*)(wl + WO_OUT), false, scr, r, lane); continue; } r -= I_OUT;
            if (r < I_Q) { tr_item(a.in[28] + (size_t)l * D * 256, a.in[26] + l * D, D, 256, (bf16*)(wl + WO_Q), false, scr, r, lane); continue; } r -= I_Q;
            if (r < I_KV) { tr_item(a.in[29] + (size_t)l * D * 512, a.in[27] + l * D, D, 512, (bf16*)(wl + WO_KV), false, scr, r, lane); continue; } r -= I_KV;
            if (r < I_O) { tr_item(a.in[32] + (size_t)l * 256 * D, nullptr, 256, D, (bf16*)(wl + WO_O), false, scr, r, lane); continue; } r -= I_O;
            if (r < I_1) { tr_item(a.in[34] + (size_t)l * D * FF, a.in[33] + l * D, D, FF, (bf16*)(wl + WO_1), false, scr, r, lane); continue; } r -= I_1;
            tr_item(a.in[35] + (size_t)l * FF * D, nullptr, FF, D, (bf16*)(wl + WO_2), false, scr, r, lane);
        }
        for (int i = bid * NTHR + tid; i < DEPTH * 112 * 128; i += G * NTHR) { const int l = i / (112 * 128), r = i % (112 * 128);
            *(v4u*)(ws + WS_W + (size_t)l * W_LAYER + WO_IN + (size_t)INW * 2048 + (size_t)r * 16) = (v4u){0u, 0u, 0u, 0u}; }
        for (int m = gw; m < M + 512; m += NGW) {
            if (m < MR) { const float* src = m < MP ? a.in[0] + (size_t)m * D : a.in[1] + (size_t)(m - MP) * D;
                f32x4 v[4]; float s = 0.f;
#pragma unroll
                for (int j = 0; j < 4; ++j) { v[j] = ((const f32x4*)src)[lane + 64 * j]; s += (v[j].x * v[j].x + v[j].y * v[j].y) + (v[j].z * v[j].z + v[j].w * v[j].w); }
                s = wave_sum(s); if (lane == 0) SS[m] = (unsigned long long)(s * 16777216.f);
#pragma unroll
                for (int j = 0; j < 4; ++j) { ((f32x4*)(out + (size_t)m * D))[lane + 64 * j] = v[j];
                    ((unsigned long long*)(XB + (size_t)m * D))[lane + 64 * j] = (unsigned long long)pk2(v[j].x, v[j].y) | ((unsigned long long)pk2(v[j].z, v[j].w) << 32); }
            } else if (m < M) {
#pragma unroll
                for (int j = 0; j < 4; ++j) ((unsigned long long*)(XB + (size_t)m * D))[lane + 64 * j] = 0ull;
            } else { const int r = m - M; const float* src = a.in[2] + (size_t)r * D; f32x4 v[4]; float s = 0.f;
#pragma unroll
                for (int j = 0; j < 4; ++j) { v[j] = ((const f32x4*)src)[lane + 64 * j]; s += (v[j].x * v[j].x + v[j].y * v[j].y) + (v[j].z * v[j].z + v[j].w * v[j].w); }
                s = wave_sum(s); if (lane == 0) SSM[r] = (unsigned long long)(s * 16777216.f);
#pragma unroll
                for (int j = 0; j < 4; ++j) ((unsigned long long*)(MEMB + (size_t)r * D))[lane + 64 * j] = (unsigned long long)pk2(v[j].x, v[j].y) | ((unsigned long long)pk2(v[j].z, v[j].w) << 32);
            }
        }
        __syncthreads();
    }
    PH_NEXT;

#pragma unroll 1
    for (int l = 0; l < DEPTH; ++l) {
        unsigned char* wl = ws + WS_W + (size_t)l * W_LAYER;
        unsigned long long* ss0 = SS + (size_t)(l * 3 + 0) * M; unsigned long long* ss1 = SS + (size_t)(l * 3 + 1) * M; unsigned long long* ss2 = SS + (size_t)(l * 3 + 2) * M;
        unsigned long long* ssn = SS + (size_t)((l + 1) * 3) * M;
        if (PH_ON) { TID_DECL
            { pg8::Gemm g{XB, (const bf16*)(wl + WO_IN), M, HW, D}; pg8::StaticOrder S; S.init(M, HW, G, bid);
              pg8::EpiScaleBf16<0> E{H, HW, ss0};
              pg8::gemm_phase<pg8::EpiScaleBf16<0>, pg8::StaticOrder, true, true>(lds, g, S, E); }
            if (l == 0) { const int rb = G - 1 - bid; const int lw = rb >> 2; const int c = (lw < DEPTH) ? (rb & 3) : 1000000; const int lwc = lw < DEPTH ? lw : 0;
              __syncthreads();
              pg8::Gemm g{MEMB, (const bf16*)(ws + WS_W + (size_t)lwc * W_LAYER + WO_KV), 512, 512, D}; pg8::StaticOrder S; S.init(512, 512, G, c);
              pg8::EpiScaleF32 E{KVRAW + (size_t)lwc * 512 * 512, 512, SSM};
              pg8::gemm_phase<pg8::EpiScaleF32, pg8::StaticOrder, true, true>(lds, g, S, E); }
            __syncthreads();
        }
        PH_NEXT;
        if (PH_ON) { TID_DECL
            const float* gk_ = a.in[23] + l * 64; const float* gq_ = a.in[22] + l * 64;
            for (int u = bid; u < 3200; u += G) {
                if (u < 1024) {
                    const int b = u >> 9, qb = (u >> 1) & 255, kv = u & 1, t0 = qb * 32;
                    LAS float* Kn = L; LAS float* V = L + 10560; LAS float* Qn = L + 21120; LAS float* P = L + 25344;
                    const float gkl = gk_[lane], gql = gq_[lane];
                    for (int j = wave; j < 160; j += 8) { const int sp = t0 - 128 + j; float kx = 0.f, vx = 0.f;
                        if (sp >= 0) { const size_t row = (size_t)b * T + sp; kx = bf2f(H[row * HW + C_SK + kv * 64 + lane]); vx = bf2f(H[row * HW + C_SV + kv * 64 + lane]); }
                        const float ssq = wave_sum(kx * kx); const float kn = kx * rsqrtf(ssq * (1.f / 64.f) + EPS) * gkl; Kn[j * 66 + lane] = kn; V[j * 66 + lane] = vx;
                        if (t0 >= T - 128 && j >= 128) { const int tt = sp - (T - 128); const size_t o = ((size_t)(l * NB + b) * 128 + tt) * 128 + kv * 64 + lane; out[O_SWKP + o] = kn; out[O_SWVP + o] = vx; } }
                    for (int r = wave; r < 64; r += 8) { const int g = r >> 5, i = r & 31; const size_t row = (size_t)b * T + t0 + i; const float qx = bf2f(H[row * HW + C_SQ + (kv * 2 + g) * 64 + lane]);
                        const float ssq = wave_sum(qx * qx); Qn[r * 66 + lane] = qx * rsqrtf(ssq * (1.f / 64.f) + EPS) * gql * 0.125f; }
                    __syncthreads();
                    for (int tile = wave; tile < 40; tile += 8) { const int ti = tile / 10, tj = tile % 10;
                        f32x4 acc = mm16(Qn + ti * 16 * 66, 66, 1, Kn + tj * 16 * 66, 1, 66, 64, (f32x4){0.f, 0.f, 0.f, 0.f}, lane);
#pragma unroll
                        for (int r = 0; r < 4; ++r) { const int rr = ti * 16 + 4 * fq + r, j = tj * 16 + fr, g = rr >> 5, i = rr & 31, dist = 128 + i - j, sp = t0 - 128 + j;
                            const bool ok = dist >= 0 && dist <= 128 && sp >= 0; const float slope = exp2f(-2.f * (float)(kv * 2 + g + 1));
                            P[rr * 162 + j] = ok ? acc[r] - slope * (float)dist : -INFINITY; } }
                    __syncthreads();
                    for (int q = 0; q < 8; ++q) { const int rr = wave * 8 + q, g = rr >> 5; const float sink = a.in[24][l * 4 + kv * 2 + g];
                        const float x0 = P[rr * 162 + lane], x1 = P[rr * 162 + 64 + lane], x2 = lane < 32 ? P[rr * 162 + 128 + lane] : -INFINITY;
                        const float mx = fmaxf(wave_max(fmaxf(fmaxf(x0, x1), x2)), sink);
                        const float e0 = __expf(x0 - mx), e1 = __expf(x1 - mx), e2 = __expf(x2 - mx); const float sum = wave_sum(e0 + e1 + e2) + __expf(sink - mx); const float inv = 1.f / sum;
                        P[rr * 162 + lane] = e0 * inv; P[rr * 162 + 64 + lane] = e1 * inv; if (lane < 32) P[rr * 162 + 128 + lane] = e2 * inv; }
                    __syncthreads();
                    for (int tile = wave; tile < 16; tile += 8) { const int ti = tile >> 2, tj = tile & 3;
                        f32x4 acc = mm16(P + ti * 16 * 162, 162, 1, V + tj * 16, 66, 1, 160, (f32x4){0.f, 0.f, 0.f, 0.f}, lane);
#pragma unroll
                        for (int r = 0; r < 4; ++r) { const int rr = ti * 16 + 4 * fq + r, g = rr >> 5, i = rr & 31, d = tj * 16 + fr;
                            OMIX[((size_t)b * T + t0 + i) * D + 768 + (kv * 2 + g) * 64 + d] = (bf16)f2bf(acc[r]); } }
                    __syncthreads();
                } else if (u < 2048) {
                    const int uu = u - 1024, b = uu >> 9, c = (uu >> 2) & 127, blk = uu & 3, t0 = c * 64; const size_t r0 = (size_t)b * T + t0;
                    LAS float* xc = L; LAS float* wa = L + 6272; LAS float* wx = L + 15488; LAS float* aa = L + 24704; LAS float* bb = L + 30912;
                    const float* cw = a.in[15] + l * 4 * 384; const float* cb = a.in[16] + l * 384;
                    for (int i = tid; i < 6144; i += NTHR) { const int t = i / 96, ch = i % 96, gch = blk * 96 + ch; float acc = cb[gch];
#pragma unroll
                        for (int j = 0; j < 4; ++j) { const int tt = t0 + t - 3 + j; if (tt >= 0) acc += cw[j * 384 + gch] * bf2f(H[((size_t)b * T + tt) * HW + C_RX + gch]); }
                        xc[t * 98 + ch] = acc; }
                    { const float* wsa = a.in[17] + (size_t)l * 36864 + blk * 9216; const float* wsx = a.in[19] + (size_t)l * 36864 + blk * 9216;
                      for (int i = tid; i < 9216; i += NTHR) { wa[i] = wsa[i]; wx[i] = wsx[i]; } }
                    __syncthreads();
                    for (int tile = wave; tile < 24; tile += 8) { const int ti = tile / 6, tj = tile % 6;
                        f32x4 ar = mm16(xc + ti * 16 * 98, 98, 1, wa + tj * 16, 96, 1, 96, (f32x4){0.f, 0.f, 0.f, 0.f}, lane);
                        f32x4 ai_ = mm16(xc + ti * 16 * 98, 98, 1, wx + tj * 16, 96, 1, 96, (f32x4){0.f, 0.f, 0.f, 0.f}, lane);
                        const int d = tj * 16 + fr, gd = blk * 96 + d; const float ba = a.in[18][l * 384 + gd], bx_ = a.in[20][l * 384 + gd], sp = softplusf_(-a.in[21][l * 384 + gd]);
#pragma unroll
                        for (int r = 0; r < 4; ++r) { const int t = ti * 16 + 4 * fq + r; const float rr = sigmoidf_(ar[r] + ba), ii = sigmoidf_(ai_[r] + bx_); const float la = -8.f * rr * sp;
                            aa[t * 97 + d] = __expf(la); bb[t * 97 + d] = sqrtf(-expm1f(2.f * la)) * ii * xc[t * 98 + d]; } }
                    __syncthreads();
                    if (tid < 96) { float hh = 0.f, ap = 1.f; const int gch = blk * 96 + tid;
                        for (int t = 0; t < 64; ++t) { const float av = aa[t * 97 + tid]; hh = av * hh + bb[t * 97 + tid]; ap *= av; HLOC[(r0 + t) * 384 + gch] = hh; ACUM[(r0 + t) * 384 + gch] = ap; }
                        HEND[(b * 128 + c) * 384 + gch] = hh; AEND[(b * 128 + c) * 384 + gch] = ap; }
                    __syncthreads();
                } else if (u < 3072) {
                    const int uu = u - 2048, b = uu >> 9, c = (uu >> 2) & 127, h = uu & 3; const size_t r0 = (size_t)b * T + c * 64;
                    LAS float* glr = L; LAS float* wg = L + 1024; LAS float* bg = L + 1792; LAS float* cum = L + 1856; LAS float* kt = L + 4992; LAS float* vv = L + 8192;
                    for (int i = tid; i < 1024; i += NTHR) glr[i] = bf2f(H[(r0 + (i >> 4)) * HW + C_GLR + (i & 15)]);
                    for (int i = tid; i < 768; i += NTHR) wg[i] = a.in[12][l * 3072 + (i / 48) * 192 + h * 48 + (i % 48)];
                    if (tid < 48) bg[tid] = a.in[13][l * 192 + h * 48 + tid];
                    __syncthreads();
                    for (int i = tid; i < 3072; i += NTHR) { const int t = i / 48, k = i % 48; float z = bg[k];
#pragma unroll
                        for (int j = 0; j < 16; ++j) z += glr[t * 16 + j] * wg[j * 48 + k];
                        cum[t * 49 + k] = logsigf_(z) * (1.f / 16.f); }
                    __syncthreads();
                    if (tid < 48) { float s = 0.f; for (int t = 0; t < 64; ++t) { s += cum[t * 49 + tid]; cum[t * 49 + tid] = s; } }
                    __syncthreads();
                    for (int i = tid; i < 3072; i += NTHR) { const int t = i / 48, k = i % 48; const float cu = cum[t * 49 + k]; CUM[(r0 + t) * 192 + h * 48 + k] = cu;
                        kt[t * 50 + k] = bf2f(H[(r0 + t) * HW + C_GK + h * 48 + k]) * __expf(cum[63 * 49 + k] - cu); }
                    for (int i = tid; i < 6144; i += NTHR) { const int t = i / 96, v = i % 96; vv[t * 98 + v] = bf2f(H[(r0 + t) * HW + C_GV + h * 96 + v]); }
                    if (tid < 48) DEC[((b * 128 + c) * 4 + h) * 48 + tid] = __expf(cum[63 * 49 + tid]);
                    __syncthreads();
                    float* Ub = U + ((size_t)(b * 128 + c) * 4 + h) * 4608;
                    for (int tile = wave; tile < 18; tile += 8) { const int ti = tile / 6, tj = tile % 6;
                        f32x4 acc = mm16(kt + ti * 16, 1, 50, vv + tj * 16, 98, 1, 64, (f32x4){0.f, 0.f, 0.f, 0.f}, lane);
#pragma unroll
                        for (int r = 0; r < 4; ++r) Ub[(ti * 16 + 4 * fq + r) * 96 + tj * 16 + fr] = acc[r]; }
                    __syncthreads();
                } else {
                    const int n = u - 3072; const size_t row = (size_t)MP + n; const size_t ln = (size_t)l * NS + n;
                    LAS float* hrow = L; LAS float* eg = L + 2560; LAS float* qk = L + 2752; LAS float* og = L + 2760; LAS float* xcs = L + 3144; LAS float* qn = L + 3528; LAS float* knew = L + 3784;
                    LAS float* vnew = L + 3912; LAS float* sc = L + 4040; LAS float* red = L + 4600;
                    for (int i = tid; i < INW; i += NTHR) hrow[i] = bf2f(H[row * HW + i]);
                    __syncthreads();
                    const float qscale = 0.14433756729740643f;
                    if (tid < 192) { float z = a.in[13][l * 192 + tid];
#pragma unroll
                        for (int j = 0; j < 16; ++j) z += hrow[C_GLR + j] * a.in[12][l * 3072 + j * 192 + tid];
                        eg[tid] = __expf(logsigf_(z) * (1.f / 16.f)); }
                    if (wave < 4) { float p = lane < 48 ? hrow[C_GQ + wave * 48 + lane] * qscale * hrow[C_GK + wave * 48 + lane] : 0.f; p = wave_sum(p); if (lane == 0) qk[wave] = p; }
                    else if (wave < 8) { const int hq = wave - 4; const float qx = hrow[C_SQ + hq * 64 + lane]; const float ssq = wave_sum(qx * qx); qn[hq * 64 + lane] = qx * rsqrtf(ssq * (1.f / 64.f) + EPS) * gq_[lane] * 0.125f; }
                    __syncthreads();
                    if (wave < 2) { const float kx = hrow[C_SK + wave * 64 + lane]; const float ssq = wave_sum(kx * kx); knew[wave * 64 + lane] = kx * rsqrtf(ssq * (1.f / 64.f) + EPS) * gk_[lane]; vnew[wave * 64 + lane] = hrow[C_SV + wave * 64 + lane]; }
                    if (tid >= 128 && tid < 512) { const int e = tid - 128, h = e / 96, v = e % 96; const float* S0 = a.in[3] + (ln * 4 + h) * 4608; float* So = out + O_GLAS + (ln * 4 + h) * 4608;
                        const float vvv = hrow[C_GV + e]; float o = qk[h] * vvv;
                        for (int k = 0; k < 48; ++k) { const float s0 = S0[k * 96 + v], e_ = eg[h * 48 + k]; o += hrow[C_GQ + h * 48 + k] * qscale * e_ * s0; So[k * 96 + v] = e_ * s0 + hrow[C_GK + h * 48 + k] * vvv; }
                        og[e] = o; }
                    __syncthreads();
                    if (wave < 4) { const int h = wave; const float x0 = og[h * 96 + lane], x1 = lane < 32 ? og[h * 96 + 64 + lane] : 0.f; const float ssq = wave_sum(x0 * x0 + x1 * x1); const float rs = rsqrtf(ssq * (1.f / 96.f) + EPS);
                        OMIX[row * D + h * 96 + lane] = (bf16)f2bf(x0 * rs * a.in[14][l * 96 + lane] * siluf_(hrow[C_GOG + h * 96 + lane]));
                        if (lane < 32) OMIX[row * D + h * 96 + 64 + lane] = (bf16)f2bf(x1 * rs * a.in[14][l * 96 + 64 + lane] * siluf_(hrow[C_GOG + h * 96 + 64 + lane])); }
                    if (tid >= 128 && tid < 512) { const int ch = tid - 128; const float* cw = a.in[15] + l * 4 * 384; const float* bufp = a.in[5] + ln * 3 * 384;
                        const float b0 = bufp[ch], b1 = bufp[384 + ch], b2 = bufp[768 + ch], rx = hrow[C_RX + ch];
                        xcs[ch] = a.in[16][l * 384 + ch] + cw[ch] * b0 + cw[384 + ch] * b1 + cw[768 + ch] * b2 + cw[1152 + ch] * rx;
                        float* co = out + O_RGCS + ln * 3 * 384; co[ch] = b1; co[384 + ch] = b2; co[768 + ch] = rx; }
                    __syncthreads();
                    if (tid < 384) { const int ch = tid, blk = ch / 96, d = ch % 96; const float* wsa = a.in[17] + (size_t)l * 36864 + blk * 9216 + d; const float* wsx = a.in[19] + (size_t)l * 36864 + blk * 9216 + d;
                        float ra = a.in[18][l * 384 + ch], rxx = a.in[20][l * 384 + ch];
                        for (int c = 0; c < 96; ++c) { const float xv = xcs[blk * 96 + c]; ra += xv * wsa[c * 96]; rxx += xv * wsx[c * 96]; }
                        const float rr = sigmoidf_(ra), ii = sigmoidf_(rxx); const float la = -8.f * rr * softplusf_(-a.in[21][l * 384 + ch]);
                        const float hv = __expf(la) * a.in[4][ln * 384 + ch] + sqrtf(-expm1f(2.f * la)) * ii * xcs[ch];
                        out[O_RGHS + ln * 384 + ch] = hv; OMIX[row * D + 384 + ch] = (bf16)f2bf(hv * gelu_tanh(hrow[C_RY + ch])); }
                    { typedef float f32x2v __attribute__((ext_vector_type(2)));
                      const int kvh = lane >> 5, dd = (lane & 31) * 2; const float* ck = a.in[6] + ln * 128 * 128; const float* cv = a.in[7] + ln * 128 * 128;
                      float* ko = out + O_SWKS + ln * 128 * 128; float* vo = out + O_SWVS + ln * 128 * 128;
                      const float q00 = qn[(kvh * 2) * 64 + dd], q01 = qn[(kvh * 2) * 64 + dd + 1], q10 = qn[(kvh * 2 + 1) * 64 + dd], q11 = qn[(kvh * 2 + 1) * 64 + dd + 1];
                      for (int j = wave; j < 129; j += 8) { f32x2v kr; if (j < 128) kr = *(const f32x2v*)(ck + j * 128 + lane * 2); else { kr.x = knew[lane * 2]; kr.y = knew[lane * 2 + 1]; }
                          if (j >= 1) *(f32x2v*)(ko + (j - 1) * 128 + lane * 2) = kr;
                          float s0 = kr.x * q00 + kr.y * q01, s1 = kr.x * q10 + kr.y * q11;
#pragma unroll
                          for (int o = 1; o < 32; o <<= 1) { s0 += __shfl_xor(s0, o); s1 += __shfl_xor(s1, o); }
                          const float dist = (float)(128 - j);
                          if ((lane & 31) == 0) { sc[(kvh * 2) * 132 + j] = s0 - exp2f(-2.f * (float)(kvh * 2 + 1)) * dist; sc[(kvh * 2 + 1) * 132 + j] = s1 - exp2f(-2.f * (float)(kvh * 2 + 2)) * dist; } }
                      __syncthreads();
                      if (wave < 4) { const int h = wave; const float sink = a.in[24][l * 4 + h]; const float x0 = sc[h * 132 + lane], x1 = sc[h * 132 + 64 + lane], x2 = lane == 0 ? sc[h * 132 + 128] : -INFINITY;
                          const float mx = fmaxf(wave_max(fmaxf(fmaxf(x0, x1), x2)), sink); const float e0 = __expf(x0 - mx), e1 = __expf(x1 - mx), e2 = __expf(x2 - mx);
                          const float inv = 1.f / (wave_sum(e0 + e1 + e2) + __expf(sink - mx)); sc[h * 132 + lane] = e0 * inv; sc[h * 132 + 64 + lane] = e1 * inv; if (lane == 0) sc[h * 132 + 128] = e2 * inv; }
                      __syncthreads();
                      float a00 = 0.f, a01 = 0.f, a10 = 0.f, a11 = 0.f;
                      for (int j = wave; j < 129; j += 8) { f32x2v vr; if (j < 128) vr = *(const f32x2v*)(cv + j * 128 + lane * 2); else { vr.x = vnew[lane * 2]; vr.y = vnew[lane * 2 + 1]; }
                          if (j >= 1) *(f32x2v*)(vo + (j - 1) * 128 + lane * 2) = vr;
                          const float p0 = sc[(kvh * 2) * 132 + j], p1 = sc[(kvh * 2 + 1) * 132 + j]; a00 += p0 * vr.x; a01 += p0 * vr.y; a10 += p1 * vr.x; a11 += p1 * vr.y; }
                      red[wave * 256 + (kvh * 2) * 64 + dd] = a00; red[wave * 256 + (kvh * 2) * 64 + dd + 1] = a01; red[wave * 256 + (kvh * 2 + 1) * 64 + dd] = a10; red[wave * 256 + (kvh * 2 + 1) * 64 + dd + 1] = a11;
                      __syncthreads();
                      if (tid < 256) { float s = 0.f;
#pragma unroll
                          for (int w = 0; w < 8; ++w) s += red[w * 256 + tid];
                          OMIX[row * D + 768 + tid] = (bf16)f2bf(s); }
                      __syncthreads(); }
                }
            }
            if (l == 0) {
                for (int w = bid * NWAVES + wave; w < DEPTH * 512 * 4; w += G * NWAVES) { const int lw = w / 2048, row = (w >> 2) & 511, h = w & 3;
                    const float kx = KVRAW[((size_t)lw * 512 + row) * 512 + h * 64 + lane], vx = KVRAW[((size_t)lw * 512 + row) * 512 + 256 + h * 64 + lane];
                    const float ssq = wave_sum(kx * kx); const size_t o = ((size_t)lw * 512 + row) * 256 + h * 64 + lane;
                    out[O_MEMK + o] = kx * rsqrtf(ssq * (1.f / 64.f) + EPS) * a.in[31][lw * 64 + lane]; out[O_MEMV + o] = vx; }
            }
        }
        PH_NEXT;
        if (PH_ON) { TID_DECL
            for (int e = bid * NTHR + tid; e < 36864 + 768; e += G * NTHR) {
                if (e < 36864) { const int b = e / 18432, rem = e % 18432, hk = rem / 96; float S = 0.f;
                    float* Ub = U + (size_t)b * 128 * 18432 + rem; const float* Db = DEC + (size_t)b * 128 * 192 + hk;
                    for (int c0 = 0; c0 < 128; c0 += 8) { float uv[8], dv[8];
#pragma unroll
                        for (int j = 0; j < 8; ++j) { uv[j] = Ub[(size_t)(c0 + j) * 18432]; dv[j] = Db[(c0 + j) * 192]; }
#pragma unroll
                        for (int j = 0; j < 8; ++j) { Ub[(size_t)(c0 + j) * 18432] = S; S = dv[j] * S + uv[j]; } }
                    out[O_GLAP + (size_t)(l * NB + b) * 18432 + rem] = S;
                } else { const int q = e - 36864, b = q / 384, ch = q % 384; float cr = 0.f;
                    for (int c0 = 0; c0 < 128; c0 += 8) { float hv[8], av[8];
#pragma unroll
                        for (int j = 0; j < 8; ++j) { hv[j] = HEND[(b * 128 + c0 + j) * 384 + ch]; av[j] = AEND[(b * 128 + c0 + j) * 384 + ch]; }
#pragma unroll
                        for (int j = 0; j < 8; ++j) { CARRY[(b * 128 + c0 + j) * 384 + ch] = cr; cr = av[j] * cr + hv[j]; } }
                    out[O_RGHP + (size_t)(l * NB + b) * 384 + ch] = cr;
#pragma unroll
                    for (int j = 0; j < 3; ++j) out[O_RGCP + ((size_t)(l * NB + b) * 3 + j) * 384 + ch] = bf2f(H[((size_t)b * T + T - 3 + j) * HW + C_RX + ch]);
                }
            }
        }
        PH_NEXT;
        if (PH_ON) { TID_DECL
            for (int u = bid; u < 1024; u += G) {
                const int b = u >> 9, c = (u >> 2) & 127, h = u & 3; const size_t r0 = (size_t)b * T + c * 64;
                LAS float* qe = L; LAS float* ke = L + 3200; LAS float* vv = L + 6400; LAS float* S0 = L + 12672; LAS float* A = L + 17376; LAS float* o = L + 21600;
                const float* Ub = U + ((size_t)(b * 128 + c) * 4 + h) * 4608;
                for (int i = tid; i < 3072; i += NTHR) { const int t = i / 48, k = i % 48; const float cu = CUM[(r0 + t) * 192 + h * 48 + k];
                    qe[t * 50 + k] = bf2f(H[(r0 + t) * HW + C_GQ + h * 48 + k]) * 0.14433756729740643f * __expf(cu); ke[t * 50 + k] = bf2f(H[(r0 + t) * HW + C_GK + h * 48 + k]) * __expf(-cu); }
                for (int i = tid; i < 6144; i += NTHR) { const int t = i / 96, v = i % 96; vv[t * 98 + v] = bf2f(H[(r0 + t) * HW + C_GV + h * 96 + v]); }
                for (int i = tid; i < 4608; i += NTHR) S0[(i / 96) * 98 + (i % 96)] = Ub[i];
                __syncthreads();
                for (int tile = wave; tile < 16; tile += 8) { const int ti = tile >> 2, tj = tile & 3; f32x4 acc = (f32x4){0.f, 0.f, 0.f, 0.f};
                    if (tj <= ti) acc = mm16(qe + ti * 16 * 50, 50, 1, ke + tj * 16 * 50, 1, 50, 48, acc, lane);
#pragma unroll
                    for (int r = 0; r < 4; ++r) { const int tr = ti * 16 + 4 * fq + r, sc_ = tj * 16 + fr; A[tr * 66 + sc_] = (sc_ <= tr) ? acc[r] : 0.f; } }
                __syncthreads();
                for (int tile = wave; tile < 24; tile += 8) { const int ti = tile / 6, tj = tile % 6;
                    f32x4 acc = mm16(qe + ti * 16 * 50, 50, 1, S0 + tj * 16, 98, 1, 48, (f32x4){0.f, 0.f, 0.f, 0.f}, lane);
                    acc = mm16(A + ti * 16 * 66, 66, 1, vv + tj * 16, 98, 1, 64, acc, lane);
#pragma unroll
                    for (int r = 0; r < 4; ++r) o[(ti * 16 + 4 * fq + r) * 98 + tj * 16 + fr] = acc[r]; }
                __syncthreads();
                for (int q = 0; q < 8; ++q) { const int t = wave * 8 + q; const float x0 = o[t * 98 + lane], x1 = lane < 32 ? o[t * 98 + 64 + lane] : 0.f;
                    const float rs = rsqrtf(wave_sum(x0 * x0 + x1 * x1) * (1.f / 96.f) + EPS);
                    OMIX[(r0 + t) * D + h * 96 + lane] = (bf16)f2bf(x0 * rs * a.in[14][l * 96 + lane] * siluf_(bf2f(H[(r0 + t) * HW + C_GOG + h * 96 + lane])));
                    if (lane < 32) OMIX[(r0 + t) * D + h * 96 + 64 + lane] = (bf16)f2bf(x1 * rs * a.in[14][l * 96 + 64 + lane] * siluf_(bf2f(H[(r0 + t) * HW + C_GOG + h * 96 + 64 + lane]))); }
                __syncthreads();
            }
            for (size_t e = (size_t)bid * NTHR + tid; e < (size_t)MP * 384; e += (size_t)G * NTHR) { const size_t row = e / 384; const int ch = (int)(e % 384); const int bc = (int)(row >> 6);
                const float hv = HLOC[e] + ACUM[e] * CARRY[(size_t)bc * 384 + ch];
                OMIX[row * D + 384 + ch] = (bf16)f2bf(hv * gelu_tanh(bf2f(H[row * HW + C_RY + ch]))); }
        }
        PH_NEXT;
        if (PH_ON) { TID_DECL
            pg8::Gemm g{OMIX, (const bf16*)(wl + WO_OUT), M, D, D}; pg8::StaticOrder S; S.init(M, D, G, bid);
            pg8::EpiResid E{out, XB, ss1, MR};
            pg8::gemm_phase<pg8::EpiResid, pg8::StaticOrder, true, true>(lds, g, S, E);
            __syncthreads();
        }
        PH_NEXT;
        if (PH_ON) { TID_DECL
            pg8::Gemm g{XB, (const bf16*)(wl + WO_Q), M, 256, D}; pg8::StaticOrder S; S.init(M, 256, G, bid);
            pg8::EpiScaleF32 E{QM, 256, ss1};
            pg8::gemm_phase<pg8::EpiScaleF32, pg8::StaticOrder, true, true>(lds, g, S, E);
            __syncthreads();
        }
        PH_NEXT;
        if (PH_ON) { TID_DECL
            const float* gmq = a.in[30] + l * 64;
            for (int u = bid; u < 2048 + NS; u += G) {
                if (u < 2048) { const int b = u >> 10, rb = (u >> 2) & 255, h = u & 3; const size_t r0 = (size_t)b * T + rb * 32;
                    LAS float* Q = L; LAS float* KV = L + 2112; LAS float* P = L + 19008;
                    const float* mk = out + O_MEMK + (size_t)(l * NB + b) * 256 * 256 + h * 64; const float* mv = out + O_MEMV + (size_t)(l * NB + b) * 256 * 256 + h * 64;
                    for (int r = wave; r < 32; r += 8) { const float qx = QM[(r0 + r) * 256 + h * 64 + lane]; const float ssq = wave_sum(qx * qx); Q[r * 66 + lane] = qx * rsqrtf(ssq * (1.f / 64.f) + EPS) * gmq[lane] * 0.125f; }
                    for (int i = tid; i < 16384; i += NTHR) KV[(i >> 6) * 66 + (i & 63)] = mk[(size_t)(i >> 6) * 256 + (i & 63)];
                    __syncthreads();
                    for (int tile = wave; tile < 32; tile += 8) { const int ti = tile >> 4, tj = tile & 15;
                        f32x4 acc = mm16(Q + ti * 16 * 66, 66, 1, KV + tj * 16 * 66, 1, 66, 64, (f32x4){0.f, 0.f, 0.f, 0.f}, lane);
#pragma unroll
                        for (int r = 0; r < 4; ++r) P[(ti * 16 + 4 * fq + r) * 258 + tj * 16 + fr] = acc[r]; }
                    __syncthreads();
                    for (int i = tid; i < 16384; i += NTHR) KV[(i >> 6) * 66 + (i & 63)] = mv[(size_t)(i >> 6) * 256 + (i & 63)];
                    for (int q = 0; q < 4; ++q) { const int rr = wave * 4 + q; float x[4]; float mx = -INFINITY;
#pragma unroll
                        for (int j = 0; j < 4; ++j) { x[j] = P[rr * 258 + lane + 64 * j]; mx = fmaxf(mx, x[j]); }
                        mx = wave_max(mx); float sum = 0.f;
#pragma unroll
                        for (int j = 0; j < 4; ++j) { x[j] = __expf(x[j] - mx); sum += x[j]; }
                        const float inv = 1.f / wave_sum(sum);
#pragma unroll
                        for (int j = 0; j < 4; ++j) P[rr * 258 + lane + 64 * j] = x[j] * inv; }
                    __syncthreads();
                    { const int ti = wave >> 2, tj = wave & 3;
                      f32x4 acc = mm16(P + ti * 16 * 258, 258, 1, KV + tj * 16, 66, 1, 256, (f32x4){0.f, 0.f, 0.f, 0.f}, lane);
#pragma unroll
                      for (int r = 0; r < 4; ++r) OMEM[(r0 + ti * 16 + 4 * fq + r) * 256 + h * 64 + tj * 16 + fr] = (bf16)f2bf(acc[r]); }
                    __syncthreads();
                } else { const int n = u - 2048; const size_t row = (size_t)MP + n; const size_t ln = (size_t)l * NS + n;
                    LAS float* qn = L; LAS float* sc = L + 256; LAS float* red = L + 1296;
                    if (wave < 4) { const float qx = QM[row * 256 + wave * 64 + lane]; const float ssq = wave_sum(qx * qx); qn[wave * 64 + lane] = qx * rsqrtf(ssq * (1.f / 64.f) + EPS) * gmq[lane] * 0.125f; }
                    __syncthreads();
                    const int hh = lane >> 4; const f32x4 qv = *(const LAS f32x4*)(qn + lane * 4);
                    const float* ck = a.in[8] + ln * 256 * 256; const float* cv = a.in[9] + ln * 256 * 256;
                    for (int j = wave; j < 256; j += 8) { const f32x4 kr = *(const f32x4*)(ck + (size_t)j * 256 + lane * 4); float s = (kr.x * qv.x + kr.y * qv.y) + (kr.z * qv.z + kr.w * qv.w);
#pragma unroll
                        for (int o = 1; o < 16; o <<= 1) s += __shfl_xor(s, o);
                        if ((lane & 15) == 0) sc[hh * 260 + j] = s; }
                    __syncthreads();
                    if (wave < 4) { float x[4]; float mx = -INFINITY;
#pragma unroll
                        for (int j = 0; j < 4; ++j) { x[j] = sc[wave * 260 + lane + 64 * j]; mx = fmaxf(mx, x[j]); }
                        mx = wave_max(mx); float sum = 0.f;
#pragma unroll
                        for (int j = 0; j < 4; ++j) { x[j] = __expf(x[j] - mx); sum += x[j]; }
                        const float inv = 1.f / wave_sum(sum);
#pragma unroll
                        for (int j = 0; j < 4; ++j) sc[wave * 260 + lane + 64 * j] = x[j] * inv; }
                    __syncthreads();
                    f32x4 acc = (f32x4){0.f, 0.f, 0.f, 0.f};
                    for (int j = wave; j < 256; j += 8) { const f32x4 vr = *(const f32x4*)(cv + (size_t)j * 256 + lane * 4); acc += vr * sc[hh * 260 + j]; }
                    *(LAS f32x4*)(red + wave * 256 + lane * 4) = acc;
                    __syncthreads();
                    if (tid < 256) { float s = 0.f;
#pragma unroll
                        for (int w = 0; w < 8; ++w) s += red[w * 256 + tid];
                        OMEM[row * 256 + tid] = (bf16)f2bf(s); }
                    __syncthreads();
                }
            }
        }
        PH_NEXT;
        if (PH_ON) { TID_DECL
            pg8::Gemm g{OMEM, (const bf16*)(wl + WO_O), M, D, 256}; pg8::StaticOrder S; S.init(M, D, G, bid);
            pg8::EpiResid E{out, XB, ss2, MR};
            pg8::gemm_phase<pg8::EpiResid, pg8::StaticOrder, true, true>(lds, g, S, E);
            __syncthreads();
        }
        PH_NEXT;
        if (PH_ON) { TID_DECL
            pg8::Gemm g{XB, (const bf16*)(wl + WO_1), M, FF, D}; pg8::StaticOrder S; S.init(M, FF, G, bid);
            pg8::EpiScaleBf16<1> E{HF, FF, ss2};
            pg8::gemm_phase<pg8::EpiScaleBf16<1>, pg8::StaticOrder, true, true>(lds, g, S, E);
            __syncthreads();
        }
        PH_NEXT;
        if (PH_ON) { TID_DECL
            pg8::Gemm g{HF, (const bf16*)(wl + WO_2), M, D, FF}; pg8::StaticOrder S; S.init(M, D, G, bid);
            pg8::EpiResid E{out, XB, l + 1 < DEPTH ? ssn : SSM + 512, MR};
            pg8::gemm_phase<pg8::EpiResid, pg8::StaticOrder, true, true>(lds, g, S, E);
            __syncthreads();
        }
        PH_NEXT;
    }
}

#ifndef MK_MULTI
#define MK_MULTI 1
#endif
extern "C" void kernel_launch(void* const* d_in, const int* in_sizes, int n_in, void* d_out, int out_size, void* d_ws, size_t ws_size, hipStream_t stream) {
    static int grid = 0;
    constexpr int NPH = 1 + DEPTH * 10;
    if (grid == 0) {
        if (n_in != 36 || out_size != (int)O_END || ws_size < WS_END) { fprintf(stderr, "kernel_launch: unexpected shapes: n_in %d out %d ws %zu\n", n_in, out_size, ws_size); grid = -1; return; }
        int dev = 0, cus = 0, per_cu = 0;
        (void)hipGetDevice(&dev); (void)hipDeviceGetAttribute(&cus, hipDeviceAttributeMultiprocessorCount, dev);
        if (hipFuncSetAttribute((const void*)mk_fwd, hipFuncAttributeMaxDynamicSharedMemorySize, LDS_BYTES) != hipSuccess) { fprintf(stderr, "kernel_launch: hipFuncSetAttribute failed\n"); grid = -1; return; }
        if (hipOccupancyMaxActiveBlocksPerMultiprocessor(&per_cu, (const void*)mk_fwd, NTHR, LDS_BYTES) != hipSuccess || per_cu < 1) { fprintf(stderr, "kernel_launch: occupancy query says %d\n", per_cu); per_cu = 1; }
        (void)hipGetLastError();
        grid = cus;
        fprintf(stderr, "kernel_launch: grid %d (occupancy %d per CU)\n", grid, per_cu);
    }
    if (grid < 0) return;
    (void)hipMemsetAsync((char*)d_ws + WS_CTL, 0, CTL_ZERO_BYTES, stream);
    (void)hipMemsetAsync((char*)d_ws + WS_SS, 0, SS_BYTES, stream);
    Args a{};
    for (int i = 0; i < 36; ++i) a.in[i] = (const float*)d_in[i];
    a.out = (float*)d_out; a.ws = (unsigned char*)d_ws; a.use_cg = 0; a.pad = 0;
#if MK_MULTI
    for (int p = 0; p < NPH; ++p) { a.ph_lo = p; a.ph_hi = p + 1; hipLaunchKernelGGL(mk_fwd, dim3(grid), dim3(NTHR), LDS_BYTES, stream, a); }
#else
    a.ph_lo = 0; a.ph_hi = NPH; a.use_cg = 1;
    void* args[] = {&a};
    hipError_t e = hipLaunchCooperativeKernel((const void*)mk_fwd, dim3(grid), dim3(NTHR), args, LDS_BYTES, stream);
    if (e != hipSuccess) fprintf(stderr, "cooperative launch failed: %s (grid %d)\n", hipGetErrorString(e), grid);
#endif
}
```

```cpp
#include <hip/hip_runtime.h>
#include <hip/hip_cooperative_groups.h>
#include <cstdio>
#include <cstdint>
namespace cg = cooperative_groups;
namespace pg8 {
#define PG8_LAS __attribute__((address_space(3)))
typedef unsigned short bf16_t;
typedef short bf16x8 __attribute__((ext_vector_type(8)));
typedef float f32x4 __attribute__((ext_vector_type(4)));
typedef unsigned u32x4 __attribute__((ext_vector_type(4)));
constexpr int BM = 256, BK = 64, HALF = 128, HTB = HALF * BK * 2  , STAGE_BYTES = 8 * HTB, NXCD = 8, WGM = 8;

__host__ __device__ __forceinline__ int lds_byte(int r, int c) { const int st = (r >> 4) * 2 + (c >> 5), rr = r & 15, cc = c & 31, ob = rr * 64 + cc * 2; return st * 1024 + (ob ^ (((ob >> 9) & 1) << 5)); }
__host__ __device__ __forceinline__ void stage_rc(int b, int& R, int& C) { const int st = b / 1024, sb = b % 1024, swz = sb ^ (((sb >> 9) & 1) << 5); R = (st >> 1) * 16 + swz / 64; C = (st & 1) * 32 + (swz % 64) / 2; }
__host__ __device__ __forceinline__ int perm32(int rho) { const int n = rho >> 4, i = rho & 15; return 8 * (i >> 2) + 4 * n + (i & 3); }

struct Unit { int pm, pn; };
struct Gemm { const bf16_t* A; const bf16_t* Bt; int M, N, K; };

struct StaticOrder {
    int nM, nN, nwg, G, c;
    __host__ __device__ void init(int M, int N, int G_, int c_) { nM = M / BM; nN = N / BM; nwg = nM * nN; G = G_; c = c_; }
    __host__ __device__ bool next(int i, Unit& u) const {
        const long L = (long)i * G + c; if (L >= nwg) return false;
        int wgid = (int)L; { const int q = nwg / NXCD, r = nwg % NXCD, xcd = wgid % NXCD, off = wgid / NXCD; wgid = (xcd < r ? xcd * (q + 1) : r * (q + 1) + (xcd - r) * q) + off; }
        const int nig = WGM * nN, gid = wgid / nig, fm = gid * WGM, gsz = (nM - fm) < WGM ? (nM - fm) : WGM;
        u.pm = fm + ((wgid % nig) % gsz); u.pn = (wgid % nig) / gsz; return true;
    }
    __device__ __forceinline__ void a_ready(const Unit&) const {}
    __device__ __forceinline__ void done(const Unit&) const {}
};

__device__ __forceinline__ unsigned cvt_pk_bf16(float lo, float hi) { unsigned r; asm volatile("v_cvt_pk_bf16_f32 %0, %1, %2" : "=v"(r) : "v"(lo), "v"(hi)); return r; }
template <class Epi, class Sched, bool ALIGN_EPI = false, bool SP2 = false>
__device__ __forceinline__ void gemm_phase(PG8_LAS unsigned char* lds, const Gemm g, const Sched& S, const Epi& E) {
    int tid_l = threadIdx.x; asm volatile("" : "+v"(tid_l)); const int tid = tid_l, wid = __builtin_amdgcn_readfirstlane(tid >> 6), lane = tid & 63, wr = wid >> 2, wc = wid & 3, fr = lane & 15, fq = lane >> 4;
    const int K = g.K, nt = K / BK;
    unsigned voffA[2], voffB[2];
#pragma unroll
    for (int i = 0; i < 2; ++i) { int R, C; stage_rc(tid * 16 + i * 8192, R, C); const int Rb = Epi::PERM ? ((R & ~31) + perm32(R & 31)) : R;
        voffA[i] = (unsigned)(R * K + C) * 2u; voffB[i] = (unsigned)(Rb * K + C) * 2u; }
    const size_t kstep = (size_t)(BK * 2);
    const size_t hstep = (size_t)HALF * K * 2;
    const size_t tstep = 2 * hstep;
    const unsigned ldsw = (unsigned)wid * 1024u;
    const int aoff = lds_byte(wr * 64 + fr, fq * 8), boff = lds_byte(wc * 32 + fr, fq * 8);
#define PG8_SA(b, h) (((b) * 2 + (h)) * HTB)
#define PG8_SB(b, h) ((4 + (b) * 2 + (h)) * HTB)
#define PG8_STAGE(bufoff, gbase, voff) do { _Pragma("unroll") for (int _i = 0; _i < 2; ++_i) \
        __builtin_amdgcn_global_load_lds((const unsigned*)((const char*)(gbase) + (voff)[_i]), (PG8_LAS unsigned*)(lds + (bufoff) + ldsw + _i * 8192), 16, 0, 0); } while (0)
#define PG8_LDA(dst, b, h) do { _Pragma("unroll") for (int m = 0; m < 4; ++m) _Pragma("unroll") for (int k = 0; k < 2; ++k) dst[m][k] = *(const PG8_LAS bf16x8*)(lds + PG8_SA(b, h) + aoff + m * 2048 + k * 1024); } while (0)
#define PG8_LDB(dst, b, h) do { _Pragma("unroll") for (int n = 0; n < 2; ++n) _Pragma("unroll") for (int k = 0; k < 2; ++k) dst[n][k] = *(const PG8_LAS bf16x8*)(lds + PG8_SB(b, h) + boff + n * 2048 + k * 1024); } while (0)
#define PG8_MMA(ai, bj, At, Bt) do { __builtin_amdgcn_s_setprio(1); _Pragma("unroll") for (int m = 0; m < 4; ++m) _Pragma("unroll") for (int n = 0; n < 2; ++n) _Pragma("unroll") for (int k = 0; k < 2; ++k) \
        acc[ai][bj][m][n] = __builtin_amdgcn_mfma_f32_16x16x32_bf16(Bt[n][k], At[m][k], acc[ai][bj][m][n], 0, 0, 0); __builtin_amdgcn_s_setprio(0); } while (0)
#define PG8_WAIT_V(n) asm volatile("s_waitcnt vmcnt(" #n ")" ::: "memory")
#define PG8_WAIT_L(n) asm volatile("s_waitcnt lgkmcnt(" #n ")" ::: "memory")
#define PG8_BAR __builtin_amdgcn_s_barrier()
#define PG8_SCHED __builtin_amdgcn_sched_barrier(0)
    Unit cur, nxt; int ui = 0;
    if (!S.next(0, cur)) return;
    f32x4 acc[2][2][4][2];
#pragma unroll
    for (int a = 0; a < 2; ++a)
#pragma unroll
        for (int b = 0; b < 2; ++b)
#pragma unroll
            for (int m = 0; m < 4; ++m)
#pragma unroll
                for (int n = 0; n < 2; ++n) acc[a][b][m][n] = (f32x4){0.f, 0.f, 0.f, 0.f};
    bf16x8 At[4][2], B0[2][2], B1[2][2];
    const char* cA = (const char*)g.A + (size_t)cur.pm * tstep; const char* cB = (const char*)g.Bt + (size_t)cur.pn * tstep;
    S.a_ready(cur);
    if constexpr (SP2) {
        PG8_STAGE(PG8_SB(0, 0), cB, voffB); PG8_STAGE(PG8_SB(0, 1), cB + hstep, voffB); PG8_STAGE(PG8_SA(0, 0), cA, voffA); PG8_STAGE(PG8_SA(0, 1), cA + hstep, voffA);
        if (wr == 1) PG8_BAR;
        PG8_WAIT_V(2); PG8_BAR;
        PG8_STAGE(PG8_SB(1, 0), cB + kstep, voffB); PG8_STAGE(PG8_SA(1, 0), cA + kstep, voffA); PG8_STAGE(PG8_SB(1, 1), cB + hstep + kstep, voffB);
        PG8_WAIT_V(6); PG8_BAR;
    } else {
        PG8_STAGE(PG8_SB(0, 0), cB, voffB); PG8_STAGE(PG8_SA(0, 0), cA, voffA); PG8_STAGE(PG8_SB(0, 1), cB + hstep, voffB); PG8_STAGE(PG8_SA(0, 1), cA + hstep, voffA);
        if (wr == 1) PG8_BAR;
        PG8_WAIT_V(4); PG8_BAR;
        PG8_STAGE(PG8_SB(1, 0), cB + kstep, voffB); PG8_STAGE(PG8_SA(1, 0), cA + kstep, voffA); PG8_STAGE(PG8_SB(1, 1), cB + hstep + kstep, voffB);
        PG8_WAIT_V(6); PG8_BAR;
    }
    for (;;) {
        const bool has_next = S.next(ui + 1, nxt);
        const char* nA = has_next ? (const char*)g.A + (size_t)nxt.pm * tstep : cA; const char* nB = has_next ? (const char*)g.Bt + (size_t)nxt.pn * tstep : cB;
        for (int t = 0; t < nt; t += 2) {
            const bool last = (t == nt - 2);
            const char* a1 = cA + (size_t)(t + 1) * kstep;
            const char* a2 = last ? nA : cA + (size_t)(t + 2) * kstep; const char* b2 = last ? nB : cB + (size_t)(t + 2) * kstep;
            const char* a3 = a2 + kstep; const char* b3 = b2 + kstep;
            if (last && has_next) S.a_ready(nxt);
            if constexpr (SP2) {
            PG8_LDB(B0, 0, 0); PG8_LDB(B1, 0, 1); PG8_SCHED; PG8_LDA(At, 0, 0); PG8_STAGE(PG8_SA(1, 1), a1 + hstep, voffA);
            PG8_WAIT_V(8); PG8_WAIT_L(0); PG8_BAR; PG8_MMA(0, 0, At, B0); PG8_MMA(0, 1, At, B1); PG8_BAR; PG8_SCHED;
            PG8_LDA(At, 0, 1); PG8_STAGE(PG8_SB(0, 0), b2, voffB); PG8_STAGE(PG8_SB(0, 1), b2 + hstep, voffB); PG8_STAGE(PG8_SA(0, 0), a2, voffA);
            PG8_WAIT_V(8); PG8_WAIT_L(0); PG8_BAR; PG8_MMA(1, 0, At, B0); PG8_MMA(1, 1, At, B1); PG8_BAR; PG8_SCHED;
            PG8_LDB(B0, 1, 0); PG8_LDB(B1, 1, 1); PG8_SCHED; PG8_LDA(At, 1, 0); PG8_STAGE(PG8_SA(0, 1), a2 + hstep, voffA);
            PG8_WAIT_V(8); PG8_WAIT_L(0); PG8_BAR; PG8_MMA(0, 0, At, B0); PG8_MMA(0, 1, At, B1); PG8_BAR; PG8_SCHED;
            PG8_LDA(At, 1, 1); PG8_STAGE(PG8_SB(1, 0), b3, voffB); PG8_STAGE(PG8_SB(1, 1), b3 + hstep, voffB); PG8_STAGE(PG8_SA(1, 0), a3, voffA);
            PG8_WAIT_V(8); PG8_WAIT_L(0); PG8_BAR; PG8_MMA(1, 0, At, B0); PG8_MMA(1, 1, At, B1); PG8_BAR; PG8_SCHED;
            } else {
            PG8_LDB(B0, 0, 0); PG8_SCHED; PG8_LDA(At, 0, 0); PG8_STAGE(PG8_SA(1, 1), a1 + hstep, voffA);
            PG8_WAIT_L(8); PG8_BAR; PG8_WAIT_L(0); PG8_MMA(0, 0, At, B0); PG8_BAR; PG8_SCHED;
            PG8_LDB(B1, 0, 1); PG8_STAGE(PG8_SB(0, 0), b2, voffB);
            PG8_BAR; PG8_WAIT_L(0); PG8_MMA(0, 1, At, B1); PG8_BAR;
            PG8_LDA(At, 0, 1); PG8_STAGE(PG8_SA(0, 0), a2, voffA);
            PG8_BAR; PG8_WAIT_L(0); PG8_MMA(1, 0, At, B0); PG8_BAR; PG8_SCHED;
            PG8_STAGE(PG8_SB(0, 1), b2 + hstep, voffB);
            PG8_WAIT_V(6); PG8_BAR; PG8_MMA(1, 1, At, B1); PG8_BAR;
            PG8_LDB(B0, 1, 0); PG8_SCHED; PG8_LDA(At, 1, 0); PG8_STAGE(PG8_SA(0, 1), a2 + hstep, voffA);
            PG8_WAIT_L(8); PG8_BAR; PG8_WAIT_L(0); PG8_MMA(0, 0, At, B0); PG8_BAR; PG8_SCHED;
            PG8_LDB(B1, 1, 1); PG8_STAGE(PG8_SB(1, 0), b3, voffB);
            PG8_BAR; PG8_WAIT_L(0); PG8_MMA(0, 1, At, B1); PG8_BAR;
            PG8_LDA(At, 1, 1); PG8_STAGE(PG8_SA(1, 0), a3, voffA);
            PG8_BAR; PG8_WAIT_L(0); PG8_MMA(1, 0, At, B0); PG8_BAR; PG8_SCHED;
            PG8_STAGE(PG8_SB(1, 1), b3 + hstep, voffB);
            PG8_WAIT_V(6); PG8_BAR; PG8_MMA(1, 1, At, B1); PG8_BAR;
            }
        }
        if constexpr (ALIGN_EPI) { if (wr == 0) PG8_BAR; }
        if constexpr (!Epi::AFTER_DRAIN) { E(acc, cur, wr, wc, fr, fq); S.done(cur); }
        if (!has_next) break;
#pragma unroll
        for (int a = 0; a < 2; ++a)
#pragma unroll
            for (int b = 0; b < 2; ++b)
#pragma unroll
                for (int m = 0; m < 4; ++m)
#pragma unroll
                    for (int n = 0; n < 2; ++n) acc[a][b][m][n] = (f32x4){0.f, 0.f, 0.f, 0.f};
        cur = nxt; cA = nA; cB = nB; ++ui;
        if constexpr (ALIGN_EPI) { if (wr == 1) PG8_BAR; }
    }
    PG8_WAIT_V(0);
    if constexpr (!ALIGN_EPI) { if (wr == 0) PG8_BAR; }
    PG8_BAR;
    if constexpr (Epi::AFTER_DRAIN) { E.fused(acc, cur, wr, wc, fr, fq, lds, wid, lane); S.done(cur); }
#undef PG8_SA
#undef PG8_SB
#undef PG8_STAGE
#undef PG8_LDA
#undef PG8_LDB
#undef PG8_MMA
#undef PG8_WAIT_V
#undef PG8_WAIT_L
#undef PG8_BAR
#undef PG8_SCHED
}
}
#define GAS __attribute__((address_space(1)))
#define LAS __attribute__((address_space(3)))
typedef unsigned short bf16;
typedef unsigned v4u __attribute__((ext_vector_type(4)));
typedef float f32x4 __attribute__((ext_vector_type(4)));
typedef short bf16x8 __attribute__((ext_vector_type(8)));
typedef GAS unsigned gu32;
typedef GAS unsigned long long gu64;
#define RLX_AGENT __ATOMIC_RELAXED, __HIP_MEMORY_SCOPE_AGENT
#define LDS_WAIT() asm volatile("s_waitcnt lgkmcnt(0)" ::: "memory")
#define VM_WAIT() asm volatile("s_waitcnt vmcnt(0)" ::: "memory")
__device__ __forceinline__ unsigned long long rt() { return __builtin_amdgcn_s_memrealtime(); }
__device__ __forceinline__ unsigned f2bf(float f) { unsigned u = __builtin_bit_cast(unsigned, f); return (u + 0x7fffu + ((u >> 16) & 1u)) >> 16; }
__device__ __forceinline__ unsigned pk2(float lo, float hi) { return f2bf(lo) | (f2bf(hi) << 16); }

#define XB_TMO      128
#define XB_XCNT(j)  (256  + 64 * (j))
#define XB_XSUB(j)  (1280 + 64 * (j))
#define XB_XGEN(j)  (2304 + 64 * (j))
#define XB_TOP      3328
#define XB_TOPGEN   3392
#define XCD_BAR_WORDS 3456
#define XB_SPIN_CAP (1u << 18)

__device__ __forceinline__ unsigned xb_ld(unsigned* p)              { return __hip_atomic_load(p, __ATOMIC_RELAXED, __HIP_MEMORY_SCOPE_AGENT); }
__device__ __forceinline__ unsigned xb_add(unsigned* p, unsigned v) { return __hip_atomic_fetch_add(p, v, __ATOMIC_RELAXED, __HIP_MEMORY_SCOPE_AGENT); }
__device__ __forceinline__ unsigned xb_xcc_id() { return (unsigned)__builtin_amdgcn_s_getreg((3 << 11) | 20) & 0xFu; }
#define XB_SPIN(cond, bar) do { unsigned _sp = 0; while (cond) { __builtin_amdgcn_s_sleep(1); \
    if ((++_sp & 255u) == 0u) { if (xb_ld(&(bar)[XB_TMO])) break; if (_sp > XB_SPIN_CAP) { atomicAdd(&(bar)[XB_TMO], 1u); break; } } } } while (0)

struct XcdBarrier {
    unsigned* bar; unsigned x;
    volatile LAS unsigned* st;
};

__device__ __forceinline__ XcdBarrier xcd_barrier_post(unsigned* bar, volatile LAS unsigned* st) {
    XcdBarrier b; b.bar = bar; b.x = xb_xcc_id(); b.st = st;
    if (threadIdx.x == 0) (void)xb_add(&bar[XB_XCNT(b.x)], 1u);
    return b;
}
__device__ __forceinline__ void xcd_barrier_complete(unsigned* bar, unsigned x, unsigned& nloc, unsigned& nx) {
    const unsigned G = gridDim.x * gridDim.y * gridDim.z;
    unsigned sum, cnt, mine, sp = 0u;
    for (;;) {
        sum = 0u; cnt = 0u; mine = 0u;
#pragma unroll
        for (unsigned j = 0; j < 16; ++j) { const unsigned c = xb_ld(&bar[XB_XCNT(j)]); sum += c; cnt += (c > 0u) ? 1u : 0u; mine = (j == x) ? c : mine; }
        if (sum == G) break;
        __builtin_amdgcn_s_sleep(1);
        if ((++sp & 255u) == 0u) { if (xb_ld(&bar[XB_TMO])) break; if (sp > XB_SPIN_CAP) { atomicAdd(&bar[XB_TMO], 1u); break; } }
    }
    nloc = mine > 0u ? mine : 1u; nx = cnt > 0u ? cnt : 1u;
}

__device__ __forceinline__ void xcd_barrier(const XcdBarrier& b) {
    asm volatile("s_waitcnt vmcnt(0)" ::: "memory");
    __syncthreads();
    if (threadIdx.x == 0) {
        unsigned* bar = b.bar;
        __builtin_amdgcn_s_waitcnt(0);
        unsigned nloc = b.st[0], nx = b.st[1];
        if (nloc == 0u) { xcd_barrier_complete(bar, b.x, nloc, nx); b.st[0] = nloc; b.st[1] = nx; }
        const unsigned old = xb_add(&bar[XB_XSUB(b.x)], 1u);
        const unsigned gen = old / nloc;
        if (old + 1u == (gen + 1u) * nloc) {
            __builtin_amdgcn_fence(__ATOMIC_RELEASE, "agent");
            asm volatile("s_waitcnt vmcnt(0)" ::: "memory");
            const unsigned og = xb_add(&bar[XB_TOP], 1u);
            const unsigned tg = og / nx;
            if (og + 1u == (tg + 1u) * nx) xb_add(&bar[XB_TOPGEN], 1u);
            else XB_SPIN(xb_ld(&bar[XB_TOPGEN]) == tg, bar);
            __builtin_amdgcn_fence(__ATOMIC_ACQUIRE, "agent");
            xb_add(&bar[XB_XGEN(b.x)], 1u);
            asm volatile("s_waitcnt vmcnt(0)" ::: "memory");
        } else {
            XB_SPIN(xb_ld(&bar[XB_XGEN(b.x)]) == gen, bar);
            __builtin_amdgcn_fence(__ATOMIC_ACQUIRE, "agent");
            asm volatile("s_waitcnt vmcnt(0)" ::: "memory");
        }
    }
    __syncthreads();
}


constexpr int D = 1024, T = 8192, NB = 2, MP = NB * T, NS = 128, MR = MP + NS, M = 16640, HW = 2560, FF = 4096, DEPTH = 4, INW = 2448;
constexpr int C_GQ = 0, C_GK = 192, C_GV = 384, C_GOG = 768, C_RX = 1152, C_RY = 1536, C_SQ = 1920, C_SK = 2176, C_SV = 2304, C_GLR = 2432;
constexpr float EPS = 1e-6f;
constexpr int NTHR = 512, NWAVES = 8;
constexpr size_t O_Y = 0, O_YS = (size_t)MP * D, O_GLAP = O_YS + (size_t)NS * D, O_GLAS = O_GLAP + (size_t)DEPTH * NB * 4 * 48 * 96,
    O_RGHP = O_GLAS + (size_t)DEPTH * NS * 4 * 48 * 96, O_RGHS = O_RGHP + (size_t)DEPTH * NB * 384, O_RGCP = O_RGHS + (size_t)DEPTH * NS * 384,
    O_RGCS = O_RGCP + (size_t)DEPTH * NB * 3 * 384, O_SWKP = O_RGCS + (size_t)DEPTH * NS * 3 * 384, O_SWKS = O_SWKP + (size_t)DEPTH * NB * 128 * 128,
    O_SWVP = O_SWKS + (size_t)DEPTH * NS * 128 * 128, O_SWVS = O_SWVP + (size_t)DEPTH * NB * 128 * 128, O_MEMK = O_SWVS + (size_t)DEPTH * NS * 128 * 128,
    O_MEMV = O_MEMK + (size_t)DEPTH * NB * 256 * 256, O_END = O_MEMV + (size_t)DEPTH * NB * 256 * 256;
static_assert(O_END == 45379584, "output size");
constexpr size_t MiB = 1u << 20;
constexpr size_t WS_CTL = 0, CTL_ZERO_BYTES = 1 * MiB, WS_SS = 377 * MiB, SS_BYTES = 2 * MiB;
constexpr size_t WS_W = 2 * MiB, W_LAYER = 25 * MiB, WO_IN = 0, WO_OUT = 5 * MiB, WO_Q = 7 * MiB, WO_KV = 7 * MiB + MiB / 2, WO_O = 8 * MiB + MiB / 2, WO_1 = 9 * MiB, WO_2 = 17 * MiB;
constexpr size_t WS_XB = 102 * MiB, WS_MEMB = 135 * MiB, WS_KVRAW = 136 * MiB, WS_QM = 140 * MiB, WS_OMEM = 157 * MiB, WS_HF = 166 * MiB, WS_H = 166 * MiB, WS_OMIX = 248 * MiB;
constexpr size_t WS_CUM = 296 * MiB, WS_U = 308 * MiB, WS_DEC = 326 * MiB, WS_HLOC = 327 * MiB, WS_ACUM = 351 * MiB, WS_RGC = 375 * MiB, WS_WRG = 379 * MiB, WS_S0 = 380 * MiB, WS_DUMX = 400 * MiB, WS_DUMB = 470 * MiB, WS_DUMS = 510 * MiB, WS_END = 512 * MiB;
static_assert(WS_XB + (size_t)M * D * 2 <= WS_MEMB && WS_QM + (size_t)M * 256 * 4 <= WS_OMEM && WS_OMEM + (size_t)M * 256 * 2 <= WS_HF && WS_HF + (size_t)M * FF * 2 <= WS_CUM, "ws map");
static_assert(WS_H + (size_t)M * HW * 2 <= WS_OMIX && WS_OMIX + (size_t)M * D * 2 <= WS_CUM && (size_t)(13 * M + 512) * 8 <= SS_BYTES, "ws map 2");
constexpr int RGC_N = NB * 128 * 384;
constexpr int LDS_BYTES = 163840;
constexpr int CW_BAR = 4096;

#ifndef REP_SWA
#define REP_SWA 1
#endif
#ifndef REP_RG
#define REP_RG 1
#endif
#ifndef REP_GLA
#define REP_GLA 1
#endif
#ifndef REP_SMP
#define REP_SMP 1
#endif
#ifndef REP_P4
#define REP_P4 1
#endif
#ifndef REP_P7
#define REP_P7 1
#endif
#ifndef REP_P7S
#define REP_P7S 1
#endif
#ifndef REP_SYNC
#define REP_SYNC 1
#endif
#ifndef REP_P0
#define REP_P0 1
#endif
#ifndef REP_RGO
#define REP_RGO 1
#endif
#ifndef REP_G1
#define REP_G1 1
#endif
#ifndef REP_G6
#define REP_G6 1
#endif
#ifndef REP_G9
#define REP_G9 1
#endif
#ifndef REP_P3
#define REP_P3 1
#endif
#ifndef REP_G10
#define REP_G10 1
#endif
#ifndef PROF_MASK
#define PROF_MASK 0
#endif
#define REP_MAX 3
struct Args { const float* in[36]; float* out; unsigned char* ws; int ph_lo, ph_hi, use_cg, pad; };

__device__ __forceinline__ unsigned f2bf_hw(float f) { unsigned r; asm volatile("v_cvt_pk_bf16_f32 %0, %1, %1" : "=v"(r) : "v"(f)); return r & 0xffffu; }
__device__ __forceinline__ float bf2f(bf16 b) { return __uint_as_float(((unsigned)b) << 16); }
__device__ __forceinline__ float wave_sum(float x) {
    int v = __float_as_int(x);
#define WS_STEP(ctrl, rm) { const int t_ = __builtin_amdgcn_update_dpp(0, v, ctrl, rm, 0xf, false); v = __float_as_int(__int_as_float(v) + __int_as_float(t_)); }
    WS_STEP(0x111, 0xf) WS_STEP(0x112, 0xf) WS_STEP(0x114, 0xf) WS_STEP(0x118, 0xf) WS_STEP(0x142, 0xa) WS_STEP(0x143, 0xc)
#undef WS_STEP
    return __int_as_float(__builtin_amdgcn_readlane(v, 63));
}
__device__ __forceinline__ float wave_max(float x) {
    int v = __float_as_int(x);
#define WM_STEP(ctrl, rm) { const int t_ = __builtin_amdgcn_update_dpp((int)0xff800000u, v, ctrl, rm, 0xf, false); v = __float_as_int(fmaxf(__int_as_float(v), __int_as_float(t_))); }
    WM_STEP(0x111, 0xf) WM_STEP(0x112, 0xf) WM_STEP(0x114, 0xf) WM_STEP(0x118, 0xf) WM_STEP(0x142, 0xa) WM_STEP(0x143, 0xc)
#undef WM_STEP
    return __int_as_float(__builtin_amdgcn_readlane(v, 63));
}
#define DPP_ADD(x, ctrl) ((x) + __int_as_float(__builtin_amdgcn_update_dpp(0, __float_as_int(x), ctrl, 0xf, 0xf, false)))
__device__ __forceinline__ float sum8(float x) { x = DPP_ADD(x, 0xB1); x = DPP_ADD(x, 0x4E); x = DPP_ADD(x, 0x141); return x; }
__device__ __forceinline__ float sum16(float x) { x = sum8(x); x = DPP_ADD(x, 0x140); return x; }
__device__ __forceinline__ float sum32_hi(float x) { x = sum16(x); return x + __int_as_float(__builtin_amdgcn_update_dpp(0, __float_as_int(x), 0x142, 0xa, 0xf, false)); }
__device__ __forceinline__ float sigmoidf_(float x) { return __builtin_amdgcn_rcpf(1.f + __expf(-x)); }
__device__ __forceinline__ float neg_expm1_(float y) { if (fabsf(y) < 0.25f) { const float p = y * (1.f + y * (0.5f + y * (0.16666667f + y * (0.041666668f + y * (0.0083333338f + y * 0.0013888889f))))); return -p; } return -expm1f(y); }
__device__ __forceinline__ float softplusf_(float x) { return fmaxf(x, 0.f) + log1pf(__expf(-fabsf(x))); }
__device__ __forceinline__ float logsigf_(float x) { return fminf(x, 0.f) - __logf(1.f + __expf(-fabsf(x))); }
__device__ __forceinline__ float gelu_tanh(float x) { const float u2 = 1.5957691216057308f * (x + 0.044715f * x * x * x); return x * __builtin_amdgcn_rcpf(1.f + __expf(-u2)); }
__device__ __forceinline__ float siluf_(float x) { return x * __builtin_amdgcn_rcpf(1.f + __expf(-x)); }

__device__ __forceinline__ f32x4 mm16(const LAS float* A, int sai, int sak, const LAS float* B, int sbk, int sbj, int K, f32x4 acc, int lane) {
    const int i = lane & 15, q = lane >> 4;
    const LAS float* pa = A + i * sai + q * sak; const LAS float* pb = B + q * sbk + i * sbj;
#pragma unroll 4
    for (int k = 0; k < K; k += 4) acc = __builtin_amdgcn_mfma_f32_16x16x4f32(pa[k * sak], pb[k * sbk], acc, 0, 0, 0);
    return acc;
}

__device__ __forceinline__ f32x4 mmb16(const LAS bf16* A, int lda, const LAS bf16* B, int ldb, int K, f32x4 acc, int lane) {
    const LAS bf16* pa = A + (lane & 15) * lda + 8 * (lane >> 4); const LAS bf16* pb = B + (lane & 15) * ldb + 8 * (lane >> 4);
#pragma unroll 2
    for (int k = 0; k < K; k += 32) acc = __builtin_amdgcn_mfma_f32_16x16x32_bf16(*(const LAS bf16x8*)(pa + k), *(const LAS bf16x8*)(pb + k), acc, 0, 0, 0);
    return acc;
}

__device__ __forceinline__ void swa_issue(v4u (&raw)[6], const bf16* H, int u, int tid) {
    const int b = u >> 9, qb = (u >> 1) & 255, kv = u & 1, t0 = qb * 32;
#pragma unroll
    for (int i = 0; i < 6; ++i) { const int v = tid + NTHR * i; size_t row; int col;
        if (v >= 2560) { const int j = (v - 2560) >> 3, c = v & 7; row = (size_t)b * T + t0 + (j & 31); col = C_SQ + (kv * 2 + (j >> 5)) * 64 + c * 8; }
        else { const int vv_ = v < 1280 ? v : v - 1280; const int j = vv_ >> 3, c = vv_ & 7; const int sp = t0 - 128 + j; row = (size_t)b * T + (sp >= 0 ? sp : 0); col = (v < 1280 ? C_SK : C_SV) + kv * 64 + c * 8; }
        raw[i] = *(const v4u*)(H + row * HW + col); }
}
__device__ __forceinline__ void rg_issue(v4u (&cr)[2][4], const bf16* H, int uu, int tid) {
    const int b = uu >> 9, c = (uu >> 2) & 127, blk = uu & 3, t0 = c * 64;
#pragma unroll
    for (int i = 0; i < 2; ++i) { const int it0 = tid + NTHR * i; const int it = it0 < 768 ? it0 : 767; const int t = it / 12, c8 = (it % 12) * 8;
#pragma unroll
        for (int j = 0; j < 4; ++j) { const int tt = t0 + t - 3 + j; cr[i][j] = *(const v4u*)(H + ((size_t)b * T + (tt >= 0 ? tt : 0)) * HW + C_RX + blk * 96 + c8); } }
}

namespace pg8 {
template <int ACT> struct EpiScaleBf16 {
    static constexpr bool PERM = true, AFTER_DRAIN = false;
    bf16_t* O; int ldc; const unsigned long long* ss;
    __device__ __forceinline__ void operator()(const f32x4 (&acc)[2][2][4][2], const Unit& u, int wr, int wc, int fr, int fq) const {
        const int row0 = u.pm * BM + wr * 64 + fr; const int col0 = u.pn * BM + wc * 32 + 8 * fq;
#pragma unroll
        for (int ai = 0; ai < 2; ++ai)
#pragma unroll
            for (int m = 0; m < 4; ++m) { const int row = row0 + ai * HALF + m * 16; const float sc = rsqrtf((float)ss[row] * (1.f / (1024.f * 16777216.f)) + 1e-6f); bf16_t* rowp = O + (size_t)row * ldc + col0;
#pragma unroll
                for (int bj = 0; bj < 2; ++bj) { f32x4 v0 = acc[ai][bj][m][0] * sc, v1 = acc[ai][bj][m][1] * sc;
                    if (ACT == 1) {
#pragma unroll
                        for (int e = 0; e < 4; ++e) { float a = fmaxf(v0[e], 0.f), b = fmaxf(v1[e], 0.f); v0[e] = a * a; v1[e] = b * b; } }
                    u32x4 w; w.x = cvt_pk_bf16(v0[0], v0[1]); w.y = cvt_pk_bf16(v0[2], v0[3]); w.z = cvt_pk_bf16(v1[0], v1[1]); w.w = cvt_pk_bf16(v1[2], v1[3]);
                    *(u32x4*)(rowp + bj * HALF) = w; } }
    }
};
struct EpiScaleF32 {
    static constexpr bool PERM = false, AFTER_DRAIN = false;
    float* O; int ldc; const unsigned long long* ss;
    __device__ __forceinline__ void operator()(const f32x4 (&acc)[2][2][4][2], const Unit& u, int wr, int wc, int fr, int fq) const {
        const int row0 = u.pm * BM + wr * 64 + fr; const int col0 = u.pn * BM + wc * 32 + 4 * fq;
#pragma unroll
        for (int ai = 0; ai < 2; ++ai)
#pragma unroll
            for (int m = 0; m < 4; ++m) { const int row = row0 + ai * HALF + m * 16; const float sc = rsqrtf((float)ss[row] * (1.f / (1024.f * 16777216.f)) + 1e-6f); float* rowp = O + (size_t)row * ldc + col0;
#pragma unroll
                for (int bj = 0; bj < 2; ++bj)
#pragma unroll
                    for (int n = 0; n < 2; ++n) *(f32x4*)(rowp + bj * HALF + n * 16) = acc[ai][bj][m][n] * sc; }
    }
};
struct EpiResid {
    static constexpr bool PERM = false, AFTER_DRAIN = false;
    float* X; bf16_t* XB; unsigned long long* ssout; int mreal;
    __device__ __forceinline__ void operator()(const f32x4 (&acc)[2][2][4][2], const Unit& u, int wr, int wc, int fr, int fq) const {
        typedef unsigned u32x2v __attribute__((ext_vector_type(2)));
        const int row0 = u.pm * BM + wr * 64 + fr; const int col0 = u.pn * BM + wc * 32 + 4 * fq;
#pragma unroll
        for (int ai = 0; ai < 2; ++ai)
#pragma unroll
            for (int m = 0; m < 4; ++m) { const int row = row0 + ai * HALF + m * 16; const bool ok = row < mreal; float s = 0.f;
                if (ok) { float* xr = X + (size_t)row * 1024 + col0; bf16_t* br = XB + (size_t)row * 1024 + col0;
#pragma unroll
                    for (int bj = 0; bj < 2; ++bj)
#pragma unroll
                        for (int n = 0; n < 2; ++n) { f32x4 v = *(const f32x4*)(xr + bj * HALF + n * 16) + acc[ai][bj][m][n]; *(f32x4*)(xr + bj * HALF + n * 16) = v;
                            u32x2v w; w.x = cvt_pk_bf16(v[0], v[1]); w.y = cvt_pk_bf16(v[2], v[3]); *(u32x2v*)(br + bj * HALF + n * 16) = w;
                            s += (v[0] * v[0] + v[1] * v[1]) + (v[2] * v[2] + v[3] * v[3]); } }
                s += __shfl_xor(s, 16); s += __shfl_xor(s, 32);
                if (ok && fq == 0) __hip_atomic_fetch_add(ssout + row, (unsigned long long)(s * 16777216.f), __ATOMIC_RELAXED, __HIP_MEMORY_SCOPE_AGENT); }
    }
};
}

template <int MODE>
__device__ __forceinline__ void small_gemm(const bf16* A, const bf16* Bt, int K, int u, void* Ov, int ldc, const unsigned long long* ss, unsigned long long* ssout, float* X, bf16* XBo, int lane, int wave) {
    typedef unsigned u32x2v __attribute__((ext_vector_type(2)));
    const int rl = wave * 16 + (lane & 15), kq = 8 * (lane >> 4), n0 = u * 32;
    const bf16* pa = A + (size_t)rl * K + kq; const bf16* pb0 = Bt + (size_t)(n0 + (lane & 15)) * K + kq; const bf16* pb1 = pb0 + (size_t)16 * K;
    f32x4 acc0 = (f32x4){0.f, 0.f, 0.f, 0.f}, acc1 = (f32x4){0.f, 0.f, 0.f, 0.f};
    for (int k = 0; k < K; k += 256) { bf16x8 xa[8], w0[8], w1[8];
#pragma unroll
        for (int j = 0; j < 8; ++j) { xa[j] = *(const bf16x8*)(pa + k + 32 * j); w0[j] = *(const bf16x8*)(pb0 + k + 32 * j); w1[j] = *(const bf16x8*)(pb1 + k + 32 * j); }
#pragma unroll
        for (int j = 0; j < 8; ++j) { acc0 = __builtin_amdgcn_mfma_f32_16x16x32_bf16(w0[j], xa[j], acc0, 0, 0, 0); acc1 = __builtin_amdgcn_mfma_f32_16x16x32_bf16(w1[j], xa[j], acc1, 0, 0, 0); } }
    const int row = MP + rl; const int col = n0 + 4 * (lane >> 4);
    if constexpr (MODE == 3) {
        float* xr = X + (size_t)row * 1024 + col; bf16* br = XBo + (size_t)row * 1024 + col;
        const f32x4 v0 = *(const f32x4*)xr + acc0, v1 = *(const f32x4*)(xr + 16) + acc1; *(f32x4*)xr = v0; *(f32x4*)(xr + 16) = v1;
        u32x2v w; w.x = pg8::cvt_pk_bf16(v0[0], v0[1]); w.y = pg8::cvt_pk_bf16(v0[2], v0[3]); *(u32x2v*)br = w; w.x = pg8::cvt_pk_bf16(v1[0], v1[1]); w.y = pg8::cvt_pk_bf16(v1[2], v1[3]); *(u32x2v*)(br + 16) = w;
        float sq = ((v0[0] * v0[0] + v0[1] * v0[1]) + (v0[2] * v0[2] + v0[3] * v0[3])) + ((v1[0] * v1[0] + v1[1] * v1[1]) + (v1[2] * v1[2] + v1[3] * v1[3]));
        sq += __shfl_xor(sq, 16); sq += __shfl_xor(sq, 32);
        if ((lane >> 4) == 0) __hip_atomic_fetch_add(ssout + row, (unsigned long long)(sq * 16777216.f), __ATOMIC_RELAXED, __HIP_MEMORY_SCOPE_AGENT);
    } else {
        const float sc = rsqrtf((float)ss[row] * (1.f / (1024.f * 16777216.f)) + 1e-6f); f32x4 v0 = acc0 * sc, v1 = acc1 * sc;
        if constexpr (MODE == 1) {
#pragma unroll
            for (int e = 0; e < 4; ++e) { const float p = fmaxf(v0[e], 0.f), q = fmaxf(v1[e], 0.f); v0[e] = p * p; v1[e] = q * q; } }
        if constexpr (MODE == 2) { float* o = (float*)Ov + (size_t)row * ldc + col; *(f32x4*)o = v0; *(f32x4*)(o + 16) = v1; }
        else { bf16* o = (bf16*)Ov + (size_t)row * ldc + col; u32x2v w; w.x = pg8::cvt_pk_bf16(v0[0], v0[1]); w.y = pg8::cvt_pk_bf16(v0[2], v0[3]); *(u32x2v*)o = w;
            w.x = pg8::cvt_pk_bf16(v1[0], v1[1]); w.y = pg8::cvt_pk_bf16(v1[2], v1[3]); *(u32x2v*)(o + 16) = w; }
    }
}

template <int MODE>
__device__ __forceinline__ void small_gemm_sk(const bf16* A, const bf16* Bt, int K, int task, LAS float* red, void* Ov, int ldc, const unsigned long long* ss, unsigned long long* ssout, float* X, bf16* XBo, int lane, int wave) {
    typedef unsigned u32x2v __attribute__((ext_vector_type(2)));
    const int rt = task & 7, n0 = (task >> 3) * 32, kw = K >> 3, kq = 8 * (lane >> 4);
    const bf16* pa = A + (size_t)(rt * 16 + (lane & 15)) * K + wave * kw + kq; const bf16* pb0 = Bt + (size_t)(n0 + (lane & 15)) * K + wave * kw + kq; const bf16* pb1 = pb0 + (size_t)16 * K;
    f32x4 acc0 = (f32x4){0.f, 0.f, 0.f, 0.f}, acc1 = (f32x4){0.f, 0.f, 0.f, 0.f};
#pragma unroll 1
    for (int k = 0; k < kw; k += 256) { bf16x8 xa[8], w0[8], w1[8];
#pragma unroll
        for (int j = 0; j < 8; ++j) if (k + 32 * j < kw) { xa[j] = *(const bf16x8*)(pa + k + 32 * j); w0[j] = *(const bf16x8*)(pb0 + k + 32 * j); w1[j] = *(const bf16x8*)(pb1 + k + 32 * j); }
#pragma unroll
        for (int j = 0; j < 8; ++j) if (k + 32 * j < kw) { acc0 = __builtin_amdgcn_mfma_f32_16x16x32_bf16(w0[j], xa[j], acc0, 0, 0, 0); acc1 = __builtin_amdgcn_mfma_f32_16x16x32_bf16(w1[j], xa[j], acc1, 0, 0, 0); } }
    *(LAS f32x4*)(red + ((wave * 2 + 0) * 64 + lane) * 4) = acc0; *(LAS f32x4*)(red + ((wave * 2 + 1) * 64 + lane) * 4) = acc1;
    __syncthreads();
    if (wave < 2) { f32x4 v = *(const LAS f32x4*)(red + ((0 * 2 + wave) * 64 + lane) * 4);
#pragma unroll
        for (int w = 1; w < 8; ++w) v += *(const LAS f32x4*)(red + ((w * 2 + wave) * 64 + lane) * 4);
        const int row = MP + rt * 16 + (lane & 15); const int col = n0 + 16 * wave + 4 * (lane >> 4);
        if constexpr (MODE == 3) {
            float* xr = X + (size_t)row * 1024 + col; bf16* br = XBo + (size_t)row * 1024 + col;
            const f32x4 o = *(const f32x4*)xr + v; *(f32x4*)xr = o;
            u32x2v w; w.x = pg8::cvt_pk_bf16(o[0], o[1]); w.y = pg8::cvt_pk_bf16(o[2], o[3]); *(u32x2v*)br = w;
            float sq = (o[0] * o[0] + o[1] * o[1]) + (o[2] * o[2] + o[3] * o[3]);
            sq += __shfl_xor(sq, 16); sq += __shfl_xor(sq, 32);
            if ((lane >> 4) == 0) __hip_atomic_fetch_add(ssout + row, (unsigned long long)(sq * 16777216.f), __ATOMIC_RELAXED, __HIP_MEMORY_SCOPE_AGENT);
        } else {
            const float sc = rsqrtf((float)ss[row] * (1.f / (1024.f * 16777216.f)) + 1e-6f); *(f32x4*)((float*)Ov + (size_t)row * ldc + col) = v * sc;
        } }
    __syncthreads();
}

__device__ __forceinline__ void q_gemm64(const bf16* XBp, const bf16* Bt, int u, float* QMo, const unsigned long long* ss, int lane, int wave) {
    const int r0 = u * 64, kq = 8 * (lane >> 4), n0 = wave * 32;
    const bf16* pa = XBp + (size_t)(r0 + (lane & 15)) * 1024 + kq; const bf16* pb0 = Bt + (size_t)(n0 + (lane & 15)) * 1024 + kq; const bf16* pb1 = pb0 + (size_t)16 * 1024;
    f32x4 acc[4][2];
#pragma unroll
    for (int m = 0; m < 4; ++m) { acc[m][0] = (f32x4){0.f, 0.f, 0.f, 0.f}; acc[m][1] = (f32x4){0.f, 0.f, 0.f, 0.f}; }
#pragma unroll 1
    for (int k = 0; k < 1024; k += 128) { bf16x8 xa[4][4], w0[4], w1[4];
#pragma unroll
        for (int j = 0; j < 4; ++j) { w0[j] = *(const bf16x8*)(pb0 + k + 32 * j); w1[j] = *(const bf16x8*)(pb1 + k + 32 * j);
#pragma unroll
            for (int m = 0; m < 4; ++m) xa[m][j] = *(const bf16x8*)(pa + (size_t)m * 16 * 1024 + k + 32 * j); }
#pragma unroll
        for (int j = 0; j < 4; ++j)
#pragma unroll
            for (int m = 0; m < 4; ++m) { acc[m][0] = __builtin_amdgcn_mfma_f32_16x16x32_bf16(w0[j], xa[m][j], acc[m][0], 0, 0, 0); acc[m][1] = __builtin_amdgcn_mfma_f32_16x16x32_bf16(w1[j], xa[m][j], acc[m][1], 0, 0, 0); } }
#pragma unroll
    for (int m = 0; m < 4; ++m) { const int row = r0 + m * 16 + (lane & 15); const float sc = rsqrtf((float)ss[row] * (1.f / (1024.f * 16777216.f)) + 1e-6f);
        float* o = QMo + (size_t)row * 256 + n0 + 4 * (lane >> 4); *(f32x4*)o = acc[m][0] * sc; *(f32x4*)(o + 16) = acc[m][1] * sc; }
}

__device__ __forceinline__ int win_map(int n) { return n < 768 ? n : (n < 784 ? n - 768 + C_GLR : n - 16); }
__device__ __forceinline__ void tr_item(const float* W, const float* g, int K, int N, bf16* WT, bool remap, LAS float* scr, int item, int lane) {
    const int nblk = (N + 63) / 64, kb = item / nblk, nb = item % nblk, k0 = 64 * kb, n0 = 64 * nb; const int nn = n0 + lane; const bool okn = nn < N;
    { float wv[64]; const float* wp = W + (size_t)k0 * N + (okn ? nn : 0);
#pragma unroll
      for (int kk = 0; kk < 64; ++kk) wv[kk] = __builtin_nontemporal_load(wp + (size_t)kk * N);
#pragma unroll
      for (int kk = 0; kk < 64; ++kk) { float w = okn ? wv[kk] : 0.f; if (g) w *= g[k0 + kk]; scr[kk * 65 + lane] = w; } }
    LDS_WAIT(); asm volatile("" ::: "memory");
#pragma unroll
    for (int j = 0; j < 8; ++j) { const int id = lane + 64 * j, n = id >> 3, c = id & 7; const LAS float* s = scr + (8 * c) * 65 + n; const int src = n0 + n;
        if (src < N) { const int dst = remap ? win_map(src) : src;
            v4u o; o.x = pk2(s[0 * 65], s[1 * 65]); o.y = pk2(s[2 * 65], s[3 * 65]); o.z = pk2(s[4 * 65], s[5 * 65]); o.w = pk2(s[6 * 65], s[7 * 65]);
            *(v4u*)(WT + (size_t)dst * K + k0 + 8 * c) = o; } }
    LDS_WAIT(); asm volatile("" ::: "memory");
}

__global__ void __launch_bounds__(NTHR, 2) mk_fwd(Args a) {
    extern __shared__ __attribute__((aligned(16))) unsigned char lds_raw[];
    LAS unsigned char* lds = (LAS unsigned char*)lds_raw;
    LAS float* L = (LAS float*)lds;
    const int tid0 = threadIdx.x, wave0 = __builtin_amdgcn_readfirstlane(tid0 >> 6);
#define TID_UNIT int tid_u = tid0; asm volatile("" : "+v"(tid_u)); const int tid = tid_u, lane = tid & 63, fr = lane & 15, fq = lane >> 4; (void)fr; (void)fq; (void)lane;
#define TID_DECL int tid_l = tid0; asm volatile("" : "+v"(tid_l)); const int tid = tid_l, lane = tid & 63, fr = lane & 15, fq = lane >> 4; (void)fr; (void)fq; (void)lane; \
    int l_l = l_it, wv_l = wave0, bid_l = bid0; unsigned char* ws = ws0; float* out = out0; asm volatile("" : "+s"(l_l), "+s"(wv_l), "+s"(bid_l), "+s"(ws), "+s"(out)); const int l = l_l, wave = wv_l, bid = bid_l; (void)l; (void)wave; (void)bid; const int vb = (G % 8 == 0) ? (bid & 7) * (G >> 3) + (bid >> 3) : bid; (void)vb; \
    unsigned long long* SS = (unsigned long long*)(ws + WS_SS); unsigned long long* SSM = SS + 12 * M; (void)SSM; \
    bf16* XB = (bf16*)(ws + WS_XB); bf16* MEMB = (bf16*)(ws + WS_MEMB); float* KVRAW = (float*)(ws + WS_KVRAW); float* QM = (float*)(ws + WS_QM); (void)XB; (void)MEMB; (void)KVRAW; (void)QM; \
    bf16* OMEM = (bf16*)(ws + WS_OMEM); bf16* HF = (bf16*)(ws + WS_HF); bf16* H = (bf16*)(ws + WS_H); bf16* OMIX = (bf16*)(ws + WS_OMIX); (void)OMEM; (void)HF; (void)H; (void)OMIX; \
    float* CUM = (float*)(ws + WS_CUM); float* U = (float*)(ws + WS_U); float* DEC = (float*)(ws + WS_DEC); bf16* HLOC = (bf16*)(ws + WS_HLOC); bf16* ACUM = (bf16*)(ws + WS_ACUM); (void)CUM; (void)U; (void)DEC; (void)HLOC; (void)ACUM; \
    bf16* WRG = (bf16*)(ws + WS_WRG); bf16* S0G = (bf16*)(ws + WS_S0); (void)WRG; (void)S0G; \
    float* HEND = (float*)(ws + WS_RGC); float* AEND = HEND + RGC_N; float* CARRY = AEND + RGC_N; (void)HEND; (void)AEND; (void)CARRY; \
    unsigned char* wl = ws + WS_W + (size_t)l * W_LAYER; (void)wl; \
    unsigned long long* ss0 = SS + (size_t)(l * 3 + 0) * M; unsigned long long* ss1 = SS + (size_t)(l * 3 + 1) * M; unsigned long long* ss2 = SS + (size_t)(l * 3 + 2) * M; unsigned long long* ssn = SS + (size_t)((l + 1) * 3) * M; (void)ss0; (void)ss1; (void)ss2; (void)ssn;
    const int G = gridDim.x, bid0 = blockIdx.x;
    unsigned char* ws0 = a.ws; float* out0 = a.out;
    int l_it = 0;
    cg::grid_group grid = cg::this_grid();
    volatile LAS unsigned* MISC = (volatile LAS unsigned*)(lds + LDS_BYTES - 64);
    if (tid0 < 16) MISC[tid0] = 0u;
    __syncthreads();
    XcdBarrier xbar = xcd_barrier_post((unsigned*)(ws0 + WS_CTL) + CW_BAR, MISC + 8);
    int ph = 0;
#define PH_ON (ph >= a.ph_lo && ph < a.ph_hi)
#if PROF_MASK
    unsigned long long t_acc = 0ull, t_prev = rt();
#define PH_PROF do { const unsigned long long now_ = rt(); const int pil_ = (ph == 1) ? 0 : ((ph - 2) % 10) + 1; if ((PROF_MASK >> pil_) & 1) t_acc += now_ - t_prev; t_prev = now_; } while (0)
#else
#define PH_PROF do { } while (0)
#endif
#if PROF_MASK
#define SUB_PROF(bit_) do { const unsigned long long now_ = rt(); if ((PROF_MASK >> (bit_)) & 1) t_acc += now_ - t_prev; t_prev = now_; } while (0)
#else
#define SUB_PROF(bit_) do { } while (0)
#endif
#define PH_NEXT do { ++ph; if (ph > a.ph_lo && ph < a.ph_hi) { for (int r_ = 0; r_ < REP_SYNC; ++r_) { if (ph == 1) grid.sync(); else xcd_barrier(xbar); } } PH_PROF; } while (0)

    if (PH_ON) { TID_DECL
        for (int rep_ = 0; rep_ < REP_P0; ++rep_) {
        LAS float* scr = L + wave * 4160;
        const int gw = bid * NWAVES + wave, NGW = G * NWAVES;
        constexpr int I_IN = 16 * 39, I_OUT = 16 * 16, I_Q = 16 * 4, I_KV = 16 * 8, I_O = 4 * 16, I_1 = 16 * 64, I_2 = 64 * 16;
        constexpr int I_L = I_IN + I_OUT + I_Q + I_KV + I_O + I_1 + I_2;
        for (int it = gw; it < DEPTH * I_L; it += NGW) {
            const int l = it / I_L; int r = it % I_L; unsigned char* wl = ws + WS_W + (size_t)l * W_LAYER;
            if (r < I_IN) { tr_item(a.in[11] + (size_t)l * D * INW, a.in[10] + l * D, D, INW, (bf16*)(wl + WO_IN), true, scr, r, lane); continue; } r -= I_IN;
            if (r < I_OUT) { tr_item(a.in[25] + (size_t)l * D * D, nullptr, D, D, (bf16*)(wl + WO_OUT), false, scr, r, lane); continue; } r -= I_OUT;
            if (r < I_Q) { tr_item(a.in[28] + (size_t)l * D * 256, a.in[26] + l * D, D, 256, (bf16*)(wl + WO_Q), false, scr, r, lane); continue; } r -= I_Q;
            if (r < I_KV) { tr_item(a.in[29] + (size_t)l * D * 512, a.in[27] + l * D, D, 512, (bf16*)(wl + WO_KV), false, scr, r, lane); continue; } r -= I_KV;
            if (r < I_O) { tr_item(a.in[32] + (size_t)l * 256 * D, nullptr, 256, D, (bf16*)(wl + WO_O), false, scr, r, lane); continue; } r -= I_O;
            if (r < I_1) { tr_item(a.in[34] + (size_t)l * D * FF, a.in[33] + l * D, D, FF, (bf16*)(wl + WO_1), false, scr, r, lane); continue; } r -= I_1;
            tr_item(a.in[35] + (size_t)l * FF * D, nullptr, FF, D, (bf16*)(wl + WO_2), false, scr, r, lane);
        }
        for (int i = bid * NTHR + tid; i < DEPTH * 112 * 128; i += G * NTHR) { const int l = i / (112 * 128), r = i % (112 * 128);
            *(v4u*)(ws + WS_W + (size_t)l * W_LAYER + WO_IN + (size_t)INW * 2048 + (size_t)r * 16) = (v4u){0u, 0u, 0u, 0u}; }
        for (int i = bid * NTHR + tid; i < DEPTH * 2 * 36864; i += G * NTHR) { const int l = i / 73728, gate = (i / 36864) & 1, r = i % 36864, blk = r / 9216, d = (r % 9216) / 96, c = r % 96;
            WRG[i] = (bf16)f2bf(a.in[gate ? 19 : 17][(size_t)l * 36864 + blk * 9216 + c * 96 + d]); }
        for (int m = gw; m < M + 512; m += NGW) {
            if (m < MR) { const float* src = m < MP ? a.in[0] + (size_t)m * D : a.in[1] + (size_t)(m - MP) * D;
                f32x4 v[4]; float s = 0.f;
#pragma unroll
                for (int j = 0; j < 4; ++j) { v[j] = ((const f32x4*)src)[lane + 64 * j]; s += (v[j].x * v[j].x + v[j].y * v[j].y) + (v[j].z * v[j].z + v[j].w * v[j].w); }
                s = wave_sum(s); if (lane == 0) SS[m] = (unsigned long long)(s * 16777216.f);
#pragma unroll
                for (int j = 0; j < 4; ++j) { ((f32x4*)(out + (size_t)m * D))[lane + 64 * j] = v[j];
                    ((unsigned long long*)(XB + (size_t)m * D))[lane + 64 * j] = (unsigned long long)pk2(v[j].x, v[j].y) | ((unsigned long long)pk2(v[j].z, v[j].w) << 32); }
            } else if (m < M) {
#pragma unroll
                for (int j = 0; j < 4; ++j) ((unsigned long long*)(XB + (size_t)m * D))[lane + 64 * j] = 0ull;
            } else { const int r = m - M; const float* src = a.in[2] + (size_t)r * D; f32x4 v[4]; float s = 0.f;
#pragma unroll
                for (int j = 0; j < 4; ++j) { v[j] = ((const f32x4*)src)[lane + 64 * j]; s += (v[j].x * v[j].x + v[j].y * v[j].y) + (v[j].z * v[j].z + v[j].w * v[j].w); }
                s = wave_sum(s); if (lane == 0) SSM[r] = (unsigned long long)(s * 16777216.f);
#pragma unroll
                for (int j = 0; j < 4; ++j) ((unsigned long long*)(MEMB + (size_t)r * D))[lane + 64 * j] = (unsigned long long)pk2(v[j].x, v[j].y) | ((unsigned long long)pk2(v[j].z, v[j].w) << 32);
            }
        }
        }
        __syncthreads();
    }
    PH_NEXT;

#pragma unroll 1
    for (l_it = 0; l_it < DEPTH; ++l_it) {
        if (PH_ON) { TID_DECL
            for (int rep_ = 0; rep_ < REP_G1; ++rep_)
            { pg8::Gemm g{XB, (const bf16*)(wl + WO_IN), MP, HW, D}; pg8::StaticOrder S; S.init(MP, HW, G, bid);
              pg8::EpiScaleBf16<0> E{H, HW, ss0};
              pg8::gemm_phase<pg8::EpiScaleBf16<0>, pg8::StaticOrder, true, true>(lds, g, S, E);
              for (int u = G - 1 - bid; u < HW / 32; u += G) small_gemm<0>(XB + (size_t)MP * D, (const bf16*)(wl + WO_IN), D, u, H, HW, ss0, nullptr, nullptr, nullptr, lane, wave); }
            if (l == 0) { const int rb = G - 1 - bid; const int lw = rb >> 2; const int c = (lw < DEPTH) ? (rb & 3) : 1000000; const int lwc = lw < DEPTH ? lw : 0;
              __syncthreads();
              pg8::Gemm g{MEMB, (const bf16*)(ws + WS_W + (size_t)lwc * W_LAYER + WO_KV), 512, 512, D}; pg8::StaticOrder S; S.init(512, 512, G, c);
              pg8::EpiScaleF32 E{KVRAW + (size_t)lwc * 512 * 512, 512, SSM};
              pg8::gemm_phase<pg8::EpiScaleF32, pg8::StaticOrder, true, true>(lds, g, S, E); }
            __syncthreads();
        }
        PH_NEXT;
        if (PH_ON) { TID_DECL
            const float* gk_ = a.in[23] + l * 64; const float* gq_ = a.in[22] + l * 64;
            {
                TID_UNIT
                LAS bf16* Kb = (LAS bf16*)lds; LAS bf16* Vt = (LAS bf16*)(lds + 27648); LAS bf16* Qb = (LAS bf16*)(lds + 53248); LAS float* S = (LAS float*)(lds + 71680);
                for (int u = bid; u < 512; u += G) {
                    const int b = u >> 8, qb = (u >> 1) & 127, kv = u & 1, t0 = qb * 64;
                    const bool lastblk = t0 >= T - 128;
                    v4u raw[8];
#pragma unroll
                    for (int i = 0; i < 8; ++i) { const int v = tid + NTHR * i; size_t row; int col;
                        if (i >= 6) { const int j = (v - 3072) >> 3, c = v & 7; row = (size_t)b * T + t0 + (j & 63); col = C_SQ + (kv * 2 + (j >> 6)) * 64 + c * 8; }
                        else { const int vv_ = i < 3 ? v : v - 1536; const int j = i < 3 ? vv_ >> 3 : vv_ % 192, c = i < 3 ? vv_ & 7 : vv_ / 192; const int sp = t0 - 128 + j; row = (size_t)b * T + (sp >= 0 ? sp : 0); col = (i < 3 ? C_SK : C_SV) + kv * 64 + c * 8; }
                        raw[i] = *(const v4u*)(H + row * HW + col); }
#pragma unroll
                    for (int i = 0; i < 8; ++i) { const int v = tid + NTHR * i;
                        if (i < 3 || i >= 6) {
                            const bool isq = i >= 6; const int vv_ = isq ? v - 3072 : v; const int j = vv_ >> 3, c = vv_ & 7; const int sp = t0 - 128 + j;
                            v4u rw = raw[i]; if (!isq && sp < 0) rw = (v4u){0u, 0u, 0u, 0u};
                            float x[8];
#pragma unroll
                            for (int e = 0; e < 4; ++e) { x[2 * e] = __uint_as_float(rw[e] << 16); x[2 * e + 1] = __uint_as_float(rw[e] & 0xffff0000u); }
                            float ssq = 0.f;
#pragma unroll
                            for (int e = 0; e < 8; ++e) ssq += x[e] * x[e];
                            ssq = sum8(ssq);
                            const float sc = rsqrtf(ssq * (1.f / 64.f) + EPS) * (isq ? 0.125f : 1.f); const float* gp = (isq ? gq_ : gk_) + c * 8;
#pragma unroll
                            for (int e = 0; e < 8; ++e) x[e] *= sc * gp[e];
                            v4u w; w.x = pg8::cvt_pk_bf16(x[0], x[1]); w.y = pg8::cvt_pk_bf16(x[2], x[3]); w.z = pg8::cvt_pk_bf16(x[4], x[5]); w.w = pg8::cvt_pk_bf16(x[6], x[7]);
                            *(LAS v4u*)((isq ? Qb : Kb) + j * 72 + c * 8) = w;
                            if (!isq && lastblk && j >= 128) { float* o = out + O_SWKP + ((size_t)(l * NB + b) * 128 + (sp - (T - 128))) * 128 + kv * 64 + c * 8;
                                *(f32x4*)o = (f32x4){x[0], x[1], x[2], x[3]}; *(f32x4*)(o + 4) = (f32x4){x[4], x[5], x[6], x[7]}; }
                        } else {
                            const int vv_ = v - 1536; const int j = vv_ % 192, c = vv_ / 192; const int sp = t0 - 128 + j;
                            v4u rw = raw[i]; if (sp < 0) rw = (v4u){0u, 0u, 0u, 0u};
#pragma unroll
                            for (int e = 0; e < 4; ++e) { Vt[(c * 8 + 2 * e) * 200 + j] = (bf16)(rw[e] & 0xffffu); Vt[(c * 8 + 2 * e + 1) * 200 + j] = (bf16)(rw[e] >> 16); }
                            if (lastblk && j >= 128) { float* o = out + O_SWVP + ((size_t)(l * NB + b) * 128 + (sp - (T - 128))) * 128 + kv * 64 + c * 8;
                                *(f32x4*)o = (f32x4){__uint_as_float(rw[0] << 16), __uint_as_float(rw[0] & 0xffff0000u), __uint_as_float(rw[1] << 16), __uint_as_float(rw[1] & 0xffff0000u)};
                                *(f32x4*)(o + 4) = (f32x4){__uint_as_float(rw[2] << 16), __uint_as_float(rw[2] & 0xffff0000u), __uint_as_float(rw[3] << 16), __uint_as_float(rw[3] & 0xffff0000u)}; }
                        } }
                    __syncthreads();
#pragma unroll 1
                    for (int g = 0; g < 2; ++g) {
                        const float slope = exp2f(-2.f * (float)(kv * 2 + g + 1)); const float sink = a.in[24][l * 4 + kv * 2 + g];
#pragma unroll 1
                        for (int tile = wave; tile < 48; tile += 8) { const int ti = tile / 12, tj = tile % 12;
                            f32x4 acc = mmb16(Qb + (g * 64 + ti * 16) * 72, 72, Kb + tj * 16 * 72, 72, 64, (f32x4){0.f, 0.f, 0.f, 0.f}, lane);
#pragma unroll
                            for (int r = 0; r < 4; ++r) { const int i = ti * 16 + 4 * fq + r, j = tj * 16 + fr, dist = 128 + i - j, sp = t0 - 128 + j;
                                const bool ok = dist >= 0 && dist <= 128 && sp >= 0; S[i * 196 + j] = ok ? acc[r] - slope * (float)dist : -INFINITY; } }
                        __syncthreads();
#pragma unroll
                        for (int q = 0; q < 8; ++q) { const int rr = wave * 8 + q;
                            const float x0 = S[rr * 196 + lane], x1 = S[rr * 196 + 64 + lane], x2 = S[rr * 196 + 128 + lane];
                            const float mx = fmaxf(wave_max(fmaxf(fmaxf(x0, x1), x2)), sink);
                            const float e0 = __expf(x0 - mx), e1 = __expf(x1 - mx), e2 = __expf(x2 - mx); const float inv = __builtin_amdgcn_rcpf(wave_sum(e0 + e1 + e2) + __expf(sink - mx));
                            LAS bf16* pr = (LAS bf16*)(S + rr * 196); pr[lane] = (bf16)f2bf(e0 * inv); pr[64 + lane] = (bf16)f2bf(e1 * inv); pr[128 + lane] = (bf16)f2bf(e2 * inv); }
                        __syncthreads();
#pragma unroll 1
                        for (int tile = wave; tile < 16; tile += 8) { const int ti = tile >> 2, tj = tile & 3;
                            f32x4 acc = mmb16((LAS bf16*)S + ti * 16 * 392, 392, Vt + tj * 16 * 200, 200, 192, (f32x4){0.f, 0.f, 0.f, 0.f}, lane);
#pragma unroll
                            for (int r = 0; r < 4; ++r) { const int i = ti * 16 + 4 * fq + r, d = tj * 16 + fr;
                                OMIX[((size_t)b * T + t0 + i) * D + 768 + (kv * 2 + g) * 64 + d] = (bf16)f2bf(acc[r]); } }
                        __syncthreads();
                    }
                }
            }
            SUB_PROF(11);
            {
                TID_UNIT
                LAS float* xcf = (LAS float*)lds; LAS bf16* xcb = (LAS bf16*)(lds + 25600); LAS bf16* Wa = (LAS bf16*)(lds + 38912); LAS bf16* Wx = (LAS bf16*)(lds + 58880);
                LAS float* aa = (LAS float*)(lds + 78848); LAS float* bb = (LAS float*)(lds + 103680);
                LAS float* toth = xcf; LAS float* tota = xcf + 512;
                int staged_blk = -1;
                for (int uu = bid; uu < 1024; uu += G) {
                    const int b = uu >> 9, c = (uu >> 2) & 127, blk = uu & 3, t0 = c * 64; const size_t r0 = (size_t)b * T + t0;
                    const float* cw = a.in[15] + l * 4 * 384 + blk * 96; const float* cb = a.in[16] + l * 384 + blk * 96;
                    v4u cr[2][4]; rg_issue(cr, H, uu, tid);
                    if (blk != staged_blk) { staged_blk = blk; const bf16* wsrc = WRG + (size_t)l * 73728 + blk * 9216;
                        for (int v = tid; v < 2304; v += NTHR) { const int gate = v / 1152, rem = v % 1152, d = rem / 12, c8 = (rem % 12) * 8;
                            *(LAS v4u*)((gate ? Wx : Wa) + d * 104 + c8) = *(const v4u*)(wsrc + (size_t)gate * 36864 + d * 96 + c8); } }
#pragma unroll
                    for (int i = 0; i < 2; ++i) { const int it = tid + NTHR * i;
                        if (it < 768) { const int t = it / 12, c8 = (it % 12) * 8; float acc[8];
                            { const f32x4 b0 = *(const f32x4*)(cb + c8), b1 = *(const f32x4*)(cb + c8 + 4); acc[0] = b0.x; acc[1] = b0.y; acc[2] = b0.z; acc[3] = b0.w; acc[4] = b1.x; acc[5] = b1.y; acc[6] = b1.z; acc[7] = b1.w; }
#pragma unroll
                            for (int j = 0; j < 4; ++j) { const int tt = t0 + t - 3 + j;
                                v4u rw = cr[i][j]; if (tt < 0) rw = (v4u){0u, 0u, 0u, 0u};
                                const f32x4 w0 = *(const f32x4*)(cw + j * 384 + c8), w1 = *(const f32x4*)(cw + j * 384 + c8 + 4);
                                acc[0] += w0.x * __uint_as_float(rw[0] << 16); acc[1] += w0.y * __uint_as_float(rw[0] & 0xffff0000u); acc[2] += w0.z * __uint_as_float(rw[1] << 16); acc[3] += w0.w * __uint_as_float(rw[1] & 0xffff0000u);
                                acc[4] += w1.x * __uint_as_float(rw[2] << 16); acc[5] += w1.y * __uint_as_float(rw[2] & 0xffff0000u); acc[6] += w1.z * __uint_as_float(rw[3] << 16); acc[7] += w1.w * __uint_as_float(rw[3] & 0xffff0000u); }
                            *(LAS f32x4*)(xcf + t * 100 + c8) = (f32x4){acc[0], acc[1], acc[2], acc[3]}; *(LAS f32x4*)(xcf + t * 100 + c8 + 4) = (f32x4){acc[4], acc[5], acc[6], acc[7]};
                            v4u w; w.x = pg8::cvt_pk_bf16(acc[0], acc[1]); w.y = pg8::cvt_pk_bf16(acc[2], acc[3]); w.z = pg8::cvt_pk_bf16(acc[4], acc[5]); w.w = pg8::cvt_pk_bf16(acc[6], acc[7]);
                            *(LAS v4u*)(xcb + t * 104 + c8) = w; } }
                    __syncthreads();
#pragma unroll 1
                    for (int tile = wave; tile < 24; tile += 8) { const int ti = tile / 6, tj = tile % 6;
                        f32x4 ar = mmb16(xcb + ti * 16 * 104, 104, Wa + tj * 16 * 104, 104, 96, (f32x4){0.f, 0.f, 0.f, 0.f}, lane);
                        f32x4 ai_ = mmb16(xcb + ti * 16 * 104, 104, Wx + tj * 16 * 104, 104, 96, (f32x4){0.f, 0.f, 0.f, 0.f}, lane);
                        const int d = tj * 16 + fr, gd = blk * 96 + d; const float ba = a.in[18][l * 384 + gd], bx_ = a.in[20][l * 384 + gd], sp = softplusf_(-a.in[21][l * 384 + gd]);
#pragma unroll
                        for (int r = 0; r < 4; ++r) { const int t = ti * 16 + 4 * fq + r; const float rr = sigmoidf_(ar[r] + ba), ii = sigmoidf_(ai_[r] + bx_); const float la = -8.f * rr * sp;
                            aa[t * 97 + d] = __expf(la); bb[t * 97 + d] = sqrtf(neg_expm1_(2.f * la)) * ii * xcf[t * 100 + d]; } }
                    __syncthreads();
                    {
                        const int seg = tid / 96, d = tid % 96, gch = blk * 96 + d;
                        if (tid < 384) { float hh = 0.f, ap = 1.f;
#pragma unroll 4
                            for (int j = 0; j < 16; ++j) { const float av = aa[(seg * 16 + j) * 97 + d]; hh = av * hh + bb[(seg * 16 + j) * 97 + d]; ap *= av; }
                            toth[seg * 96 + d] = hh; tota[seg * 96 + d] = ap; }
                        __syncthreads();
                        if (tid < 384) { float hh = 0.f, ap = 1.f;
                            for (int s2 = 0; s2 < seg; ++s2) { const float ta = tota[s2 * 96 + d]; hh = ta * hh + toth[s2 * 96 + d]; ap *= ta; }
#pragma unroll 4
                            for (int j = 0; j < 16; ++j) { const float av = aa[(seg * 16 + j) * 97 + d]; hh = av * hh + bb[(seg * 16 + j) * 97 + d]; ap *= av;
                                HLOC[(r0 + seg * 16 + j) * 384 + gch] = (bf16)f2bf(hh); ACUM[(r0 + seg * 16 + j) * 384 + gch] = (bf16)f2bf(ap); }
                            if (seg == 3) { HEND[(b * 128 + c) * 384 + gch] = hh; AEND[(b * 128 + c) * 384 + gch] = ap; } }
                    }
                    __syncthreads();
                }
            }
            SUB_PROF(12);
            for (int u = 2048 + bid; u < 3072; u += G) {
                    TID_UNIT
                    const int uu = u - 2048, b = uu >> 9, c = (uu >> 2) & 127, h = uu & 3; const size_t r0 = (size_t)b * T + c * 64;
                    LAS float* glr = L; LAS float* wg = L + 1024; LAS float* bg = L + 1792; LAS float* cum = L + 1856; LAS bf16* Kt = (LAS bf16*)(lds + 19968); LAS bf16* Vt = (LAS bf16*)(lds + 26880);
                    const int kt_t = tid & 63, kt_k0 = (tid >> 6) * 8;
                    v4u kraw = (v4u){0u, 0u, 0u, 0u}; if (tid < 384) kraw = *(const v4u*)(H + (r0 + kt_t) * HW + C_GK + h * 48 + kt_k0);
                    if (tid < 128) { const v4u g = *(const v4u*)(H + (r0 + (tid >> 1)) * HW + C_GLR + (tid & 1) * 8);
#pragma unroll
                        for (int e = 0; e < 4; ++e) { glr[tid * 8 + 2 * e] = __uint_as_float(g[e] << 16); glr[tid * 8 + 2 * e + 1] = __uint_as_float(g[e] & 0xffff0000u); } }
                    for (int i = tid; i < 768; i += NTHR) wg[i] = a.in[12][l * 3072 + (i / 48) * 192 + h * 48 + (i % 48)];
                    if (tid < 48) bg[tid] = a.in[13][l * 192 + h * 48 + tid];
#pragma unroll
                    for (int i = 0; i < 2; ++i) { const int v = tid + NTHR * i; if (v < 768) { const int t = v & 63, c8 = (v >> 6) * 8;
                        const v4u raw = *(const v4u*)(H + (r0 + t) * HW + C_GV + h * 96 + c8);
#pragma unroll
                        for (int e = 0; e < 4; ++e) { Vt[(c8 + 2 * e) * 72 + t] = (bf16)(raw[e] & 0xffffu); Vt[(c8 + 2 * e + 1) * 72 + t] = (bf16)(raw[e] >> 16); } } }
                    __syncthreads();
                    for (int tile = wave; tile < 12; tile += 8) { const int ti = tile / 3, tj = tile % 3;
                        f32x4 acc = mm16(glr + ti * 16 * 16, 16, 1, wg + tj * 16, 48, 1, 16, (f32x4){0.f, 0.f, 0.f, 0.f}, lane); const float bz = bg[tj * 16 + fr];
#pragma unroll
                        for (int r = 0; r < 4; ++r) cum[(ti * 16 + 4 * fq + r) * 49 + tj * 16 + fr] = logsigf_(acc[r] + bz) * (1.f / 16.f); }
                    __syncthreads();
                    if (tid < 48) { float s = 0.f;
#pragma unroll 1
                        for (int tb = 0; tb < 64; tb += 16) { float cv_[16];
#pragma unroll
                            for (int j = 0; j < 16; ++j) cv_[j] = cum[(tb + j) * 49 + tid];
#pragma unroll
                            for (int j = 0; j < 16; ++j) { s += cv_[j]; cum[(tb + j) * 49 + tid] = s; } } }
                    __syncthreads();
                    if (tid < 384) { float cu[8], kt[8];
#pragma unroll
                        for (int e = 0; e < 8; ++e) cu[e] = cum[kt_t * 49 + kt_k0 + e];
                        *(f32x4*)(CUM + (r0 + kt_t) * 192 + h * 48 + kt_k0) = (f32x4){cu[0], cu[1], cu[2], cu[3]}; *(f32x4*)(CUM + (r0 + kt_t) * 192 + h * 48 + kt_k0 + 4) = (f32x4){cu[4], cu[5], cu[6], cu[7]};
#pragma unroll
                        for (int e = 0; e < 4; ++e) { kt[2 * e] = __uint_as_float(kraw[e] << 16) * __expf(cum[63 * 49 + kt_k0 + 2 * e] - cu[2 * e]); kt[2 * e + 1] = __uint_as_float(kraw[e] & 0xffff0000u) * __expf(cum[63 * 49 + kt_k0 + 2 * e + 1] - cu[2 * e + 1]); }
#pragma unroll
                        for (int e = 0; e < 8; ++e) Kt[(kt_k0 + e) * 72 + kt_t] = (bf16)f2bf(kt[e]); }
                    if (tid < 48) DEC[((b * 128 + c) * 4 + h) * 48 + tid] = __expf(cum[63 * 49 + tid]);
                    __syncthreads();
                    float* Ub = U + ((size_t)(b * 128 + c) * 4 + h) * 4608;
                    for (int tile = wave; tile < 18; tile += 8) { const int ti = tile / 6, tj = tile % 6;
                        f32x4 acc = mmb16(Kt + ti * 16 * 72, 72, Vt + tj * 16 * 72, 72, 64, (f32x4){0.f, 0.f, 0.f, 0.f}, lane);
#pragma unroll
                        for (int r = 0; r < 4; ++r) Ub[(ti * 16 + 4 * fq + r) * 96 + tj * 16 + fr] = acc[r]; }
                    __syncthreads();
            }
            SUB_PROF(13);
            for (int u2 = bid; u2 < 2 * NS; u2 += G) {
                    TID_UNIT
                    const int n = u2 >> 1, part = u2 & 1; const size_t row = (size_t)MP + n; const size_t ln = (size_t)l * NS + n;
                    LAS float* hrow = L; LAS float* eg = L + 2560; LAS float* qk = L + 2752; LAS float* og = L + 2760; LAS float* xcs = L + 3144; LAS float* qn = L + 3528; LAS float* knew = L + 3784;
                    LAS float* vnew = L + 3912; LAS float* sc = L + 4040; LAS float* red = L + 4600;
                    for (int i = tid; i < INW; i += NTHR) hrow[i] = bf2f(H[row * HW + i]);
                    __syncthreads();
                    const float qscale = 0.14433756729740643f;
                    if (part == 0 && tid < 192) { float z = a.in[13][l * 192 + tid];
#pragma unroll
                        for (int j = 0; j < 16; ++j) z += hrow[C_GLR + j] * a.in[12][l * 3072 + j * 192 + tid];
                        eg[tid] = __expf(logsigf_(z) * (1.f / 16.f)); }
                    if (part == 0 && wave < 4) { float p = lane < 48 ? hrow[C_GQ + wave * 48 + lane] * qscale * hrow[C_GK + wave * 48 + lane] : 0.f; p = wave_sum(p); if (lane == 0) qk[wave] = p; }
                    else if (part == 1 && wave >= 4) { const int hq = wave - 4; const float qx = hrow[C_SQ + hq * 64 + lane]; const float ssq = wave_sum(qx * qx); qn[hq * 64 + lane] = qx * rsqrtf(ssq * (1.f / 64.f) + EPS) * gq_[lane] * 0.125f; }
                    __syncthreads();
                    if (part == 1 && wave < 2) { const float kx = hrow[C_SK + wave * 64 + lane]; const float ssq = wave_sum(kx * kx); knew[wave * 64 + lane] = kx * rsqrtf(ssq * (1.f / 64.f) + EPS) * gk_[lane]; vnew[wave * 64 + lane] = hrow[C_SV + wave * 64 + lane]; }
                    if (part == 0 && tid >= 128 && tid < 512) { const int e = tid - 128, h = e / 96, v = e % 96; const float* S0 = a.in[3] + (ln * 4 + h) * 4608; float* So = out + O_GLAS + (ln * 4 + h) * 4608;
                        const float vvv = hrow[C_GV + e]; float o = qk[h] * vvv;
#pragma unroll 1
                        for (int kb = 0; kb < 48; kb += 16) { float sv[16];
#pragma unroll
                            for (int j = 0; j < 16; ++j) sv[j] = __builtin_nontemporal_load(S0 + (kb + j) * 96 + v);
#pragma unroll
                            for (int j = 0; j < 16; ++j) { const int k = kb + j; const float s0 = sv[j], e_ = eg[h * 48 + k]; o += hrow[C_GQ + h * 48 + k] * qscale * e_ * s0; __builtin_nontemporal_store(e_ * s0 + hrow[C_GK + h * 48 + k] * vvv, So + k * 96 + v); } }
                        og[e] = o; }
                    __syncthreads();
                    if (part == 0 && wave < 4) { const int h = wave; const float x0 = og[h * 96 + lane], x1 = lane < 32 ? og[h * 96 + 64 + lane] : 0.f; const float ssq = wave_sum(x0 * x0 + x1 * x1); const float rs = rsqrtf(ssq * (1.f / 96.f) + EPS);
                        OMIX[row * D + h * 96 + lane] = (bf16)f2bf(x0 * rs * a.in[14][l * 96 + lane] * siluf_(hrow[C_GOG + h * 96 + lane]));
                        if (lane < 32) OMIX[row * D + h * 96 + 64 + lane] = (bf16)f2bf(x1 * rs * a.in[14][l * 96 + 64 + lane] * siluf_(hrow[C_GOG + h * 96 + 64 + lane])); }
                    if (part == 0 && tid >= 128 && tid < 512) { const int ch = tid - 128; const float* cw = a.in[15] + l * 4 * 384; const float* bufp = a.in[5] + ln * 3 * 384;
                        const float b0 = bufp[ch], b1 = bufp[384 + ch], b2 = bufp[768 + ch], rx = hrow[C_RX + ch];
                        xcs[ch] = a.in[16][l * 384 + ch] + cw[ch] * b0 + cw[384 + ch] * b1 + cw[768 + ch] * b2 + cw[1152 + ch] * rx;
                        float* co = out + O_RGCS + ln * 3 * 384; co[ch] = b1; co[384 + ch] = b2; co[768 + ch] = rx; }
                    __syncthreads();
                    if (part == 0 && tid < 384) { const int ch = tid, blk = ch / 96, d = ch % 96; const float* wsa = a.in[17] + (size_t)l * 36864 + blk * 9216 + d; const float* wsx = a.in[19] + (size_t)l * 36864 + blk * 9216 + d;
                        float ra = a.in[18][l * 384 + ch], rxx = a.in[20][l * 384 + ch];
#pragma unroll 1
                        for (int cb_ = 0; cb_ < 96; cb_ += 16) { float wa_[16], wx_[16];
#pragma unroll
                            for (int j = 0; j < 16; ++j) { wa_[j] = wsa[(cb_ + j) * 96]; wx_[j] = wsx[(cb_ + j) * 96]; }
#pragma unroll
                            for (int j = 0; j < 16; ++j) { const float xv = xcs[blk * 96 + cb_ + j]; ra += xv * wa_[j]; rxx += xv * wx_[j]; } }
                        const float rr = sigmoidf_(ra), ii = sigmoidf_(rxx); const float la = -8.f * rr * softplusf_(-a.in[21][l * 384 + ch]);
                        const float hv = __expf(la) * a.in[4][ln * 384 + ch] + sqrtf(neg_expm1_(2.f * la)) * ii * xcs[ch];
                        out[O_RGHS + ln * 384 + ch] = hv; OMIX[row * D + 384 + ch] = (bf16)f2bf(hv * gelu_tanh(hrow[C_RY + ch])); }
                    if (part == 1) { typedef float f32x2v __attribute__((ext_vector_type(2)));
                      const int kvh = lane >> 5, dd = (lane & 31) * 2; const float* ck = a.in[6] + ln * 128 * 128; const float* cv = a.in[7] + ln * 128 * 128;
                      float* ko = out + O_SWKS + ln * 128 * 128; float* vo = out + O_SWVS + ln * 128 * 128;
                      const float q00 = qn[(kvh * 2) * 64 + dd], q01 = qn[(kvh * 2) * 64 + dd + 1], q10 = qn[(kvh * 2 + 1) * 64 + dd], q11 = qn[(kvh * 2 + 1) * 64 + dd + 1];
                      const float sl0 = exp2f(-2.f * (float)(kvh * 2 + 1)), sl1 = exp2f(-2.f * (float)(kvh * 2 + 2));
#pragma unroll 1
                      for (int ib = 0; ib < 17; ib += 8) { f32x2v kr[8];
#pragma unroll
                          for (int jj = 0; jj < 8; ++jj) { const int j = (tid >> 6) + 8 * (ib + jj); kr[jj] = (f32x2v){0.f, 0.f}; if (j < 128) kr[jj] = __builtin_nontemporal_load((const f32x2v*)(ck + j * 128 + lane * 2)); else if (j == 128) { kr[jj].x = knew[lane * 2]; kr[jj].y = knew[lane * 2 + 1]; } }
#pragma unroll
                          for (int jj = 0; jj < 8; ++jj) { const int j = (tid >> 6) + 8 * (ib + jj);
                              if (j >= 1 && j < 129) __builtin_nontemporal_store(kr[jj], (f32x2v*)(ko + (j - 1) * 128 + lane * 2));
                              float s0 = kr[jj].x * q00 + kr[jj].y * q01, s1 = kr[jj].x * q10 + kr[jj].y * q11;
                              s0 = sum32_hi(s0); s1 = sum32_hi(s1);
                              const float dist = (float)(128 - j);
                              if ((lane & 31) == 16 && j < 129) { sc[(kvh * 2) * 132 + j] = s0 - sl0 * dist; sc[(kvh * 2 + 1) * 132 + j] = s1 - sl1 * dist; } }
                      }
                      __syncthreads();
                      if (wave < 4) { const int h = wave; const float sink = a.in[24][l * 4 + h]; const float x0 = sc[h * 132 + lane], x1 = sc[h * 132 + 64 + lane], x2 = lane == 0 ? sc[h * 132 + 128] : -INFINITY;
                          const float mx = fmaxf(wave_max(fmaxf(fmaxf(x0, x1), x2)), sink); const float e0 = __expf(x0 - mx), e1 = __expf(x1 - mx), e2 = __expf(x2 - mx);
                          const float inv = 1.f / (wave_sum(e0 + e1 + e2) + __expf(sink - mx)); sc[h * 132 + lane] = e0 * inv; sc[h * 132 + 64 + lane] = e1 * inv; if (lane == 0) sc[h * 132 + 128] = e2 * inv; }
                      __syncthreads();
                      float a00 = 0.f, a01 = 0.f, a10 = 0.f, a11 = 0.f;
#pragma unroll 1
                      for (int ib = 0; ib < 17; ib += 8) { f32x2v vr[8];
#pragma unroll
                          for (int jj = 0; jj < 8; ++jj) { const int j = (tid >> 6) + 8 * (ib + jj); vr[jj] = (f32x2v){0.f, 0.f}; if (j < 128) vr[jj] = __builtin_nontemporal_load((const f32x2v*)(cv + j * 128 + lane * 2)); else if (j == 128) { vr[jj].x = vnew[lane * 2]; vr[jj].y = vnew[lane * 2 + 1]; } }
#pragma unroll
                          for (int jj = 0; jj < 8; ++jj) { const int j = (tid >> 6) + 8 * (ib + jj);
                              if (j >= 1 && j < 129) __builtin_nontemporal_store(vr[jj], (f32x2v*)(vo + (j - 1) * 128 + lane * 2));
                              if (j < 129) { const float p0 = sc[(kvh * 2) * 132 + j], p1 = sc[(kvh * 2 + 1) * 132 + j]; a00 += p0 * vr[jj].x; a01 += p0 * vr[jj].y; a10 += p1 * vr[jj].x; a11 += p1 * vr[jj].y; } } }
                      red[wave * 256 + (kvh * 2) * 64 + dd] = a00; red[wave * 256 + (kvh * 2) * 64 + dd + 1] = a01; red[wave * 256 + (kvh * 2 + 1) * 64 + dd] = a10; red[wave * 256 + (kvh * 2 + 1) * 64 + dd + 1] = a11;
                      __syncthreads();
                      if (tid < 256) { float s = 0.f;
#pragma unroll
                          for (int w = 0; w < 8; ++w) s += red[w * 256 + tid];
                          OMIX[row * D + 768 + tid] = (bf16)f2bf(s); }
                      __syncthreads(); }
            }
            if (l == 0) {
                for (int w = bid * NWAVES + wave; w < DEPTH * 512 * 4; w += G * NWAVES) { const int lw = w / 2048, row = (w >> 2) & 511, h = w & 3;
                    const float kx = KVRAW[((size_t)lw * 512 + row) * 512 + h * 64 + lane], vx = KVRAW[((size_t)lw * 512 + row) * 512 + 256 + h * 64 + lane];
                    const float ssq = wave_sum(kx * kx); const size_t o = ((size_t)lw * 512 + row) * 256 + h * 64 + lane;
                    out[O_MEMK + o] = kx * rsqrtf(ssq * (1.f / 64.f) + EPS) * a.in[31][lw * 64 + lane]; out[O_MEMV + o] = vx; }
            }
        }
        PH_NEXT;
        if (PH_ON) { TID_DECL
            for (int gr = wave * G + bid; gr < 588; gr += G * NWAVES) { const int e = gr * 64 + lane;
                if (e < 36864) { const int b = e / 18432, rem = e % 18432, hk = rem / 96; float S = 0.f;
                    const float* __restrict__ Ub = U + (size_t)b * 128 * 18432 + rem; bf16* __restrict__ Sb = S0G + (size_t)b * 128 * 18432 + rem; const float* __restrict__ Db = DEC + (size_t)b * 128 * 192 + hk;
#pragma unroll 1
                    for (int c0 = 0; c0 < 128; c0 += 16) { float uv[16], dv[16];
#pragma unroll
                        for (int j = 0; j < 16; ++j) { uv[j] = Ub[(size_t)(c0 + j) * 18432]; dv[j] = Db[(c0 + j) * 192]; }
#pragma unroll
                        for (int j = 0; j < 16; ++j) { Sb[(size_t)(c0 + j) * 18432] = (bf16)f2bf(S); S = dv[j] * S + uv[j]; } }
                    out[O_GLAP + (size_t)(l * NB + b) * 18432 + rem] = S;
                } else { const int q = e - 36864, b = q / 384, ch = q % 384; float cr = 0.f;
#pragma unroll 1
                    for (int c0 = 0; c0 < 128; c0 += 16) { float hv[16], av[16];
#pragma unroll
                        for (int j = 0; j < 16; ++j) { hv[j] = HEND[(b * 128 + c0 + j) * 384 + ch]; av[j] = AEND[(b * 128 + c0 + j) * 384 + ch]; }
#pragma unroll
                        for (int j = 0; j < 16; ++j) { CARRY[(b * 128 + c0 + j) * 384 + ch] = cr; cr = av[j] * cr + hv[j]; } }
                    out[O_RGHP + (size_t)(l * NB + b) * 384 + ch] = cr;
#pragma unroll
                    for (int j = 0; j < 3; ++j) out[O_RGCP + ((size_t)(l * NB + b) * 3 + j) * 384 + ch] = bf2f(H[((size_t)b * T + T - 3 + j) * HW + C_RX + ch]);
                }
            }
        }
        PH_NEXT;
        if (PH_ON) { TID_DECL
            for (int u = bid; u < 1024; u += G) {
                const int b = u >> 9, c = (u >> 2) & 127, h = u & 3; const size_t r0 = (size_t)b * T + c * 64;
                LAS bf16* qeb = (LAS bf16*)lds; LAS bf16* keb = (LAS bf16*)(lds + 9216); LAS bf16* Ab = (LAS bf16*)(lds + 18432); LAS bf16* Vt = (LAS bf16*)(lds + 27648); LAS bf16* S0t = (LAS bf16*)(lds + 41472);
                LAS float* o = (LAS float*)(lds + 55296);
                const bf16* Ub = S0G + ((size_t)(b * 128 + c) * 4 + h) * 4608;
                float gg0[8], gg1[8];
#pragma unroll
                for (int q = 0; q < 8; ++q) { const bf16* gp = H + (r0 + (tid >> 6) * 8 + q) * HW + C_GOG + h * 96; gg0[q] = bf2f(gp[lane]); gg1[q] = bf2f(gp[64 + (lane & 31)]); }
                if (tid < 384) { const int t = tid / 6, k0 = (tid % 6) * 8;
                    const v4u qr = *(const v4u*)(H + (r0 + t) * HW + C_GQ + h * 48 + k0), kr = *(const v4u*)(H + (r0 + t) * HW + C_GK + h * 48 + k0);
                    const f32x4 c0 = *(const f32x4*)(CUM + (r0 + t) * 192 + h * 48 + k0), c1 = *(const f32x4*)(CUM + (r0 + t) * 192 + h * 48 + k0 + 4);
                    float cu[8] = {c0.x, c0.y, c0.z, c0.w, c1.x, c1.y, c1.z, c1.w}; float qe[8], ke[8];
#pragma unroll
                    for (int e = 0; e < 4; ++e) { const float q0 = __uint_as_float(qr[e] << 16), q1 = __uint_as_float(qr[e] & 0xffff0000u), k0_ = __uint_as_float(kr[e] << 16), k1_ = __uint_as_float(kr[e] & 0xffff0000u);
                        const float e0 = __expf(cu[2 * e]), e1 = __expf(cu[2 * e + 1]);
                        qe[2 * e] = q0 * 0.14433756729740643f * e0; qe[2 * e + 1] = q1 * 0.14433756729740643f * e1; ke[2 * e] = k0_ / e0; ke[2 * e + 1] = k1_ / e1; }
                    v4u w; w.x = pg8::cvt_pk_bf16(qe[0], qe[1]); w.y = pg8::cvt_pk_bf16(qe[2], qe[3]); w.z = pg8::cvt_pk_bf16(qe[4], qe[5]); w.w = pg8::cvt_pk_bf16(qe[6], qe[7]); *(LAS v4u*)(qeb + t * 72 + k0) = w;
                    w.x = pg8::cvt_pk_bf16(ke[0], ke[1]); w.y = pg8::cvt_pk_bf16(ke[2], ke[3]); w.z = pg8::cvt_pk_bf16(ke[4], ke[5]); w.w = pg8::cvt_pk_bf16(ke[6], ke[7]); *(LAS v4u*)(keb + t * 72 + k0) = w;
                } else {
                    for (int i = tid - 384; i < 448; i += 128) { LAS bf16* base = i < 128 ? qeb : (i < 256 ? keb : S0t); const int r = i < 128 ? i : (i < 256 ? i - 128 : i - 256);
                        *(LAS v4u*)(base + (r >> 1) * 72 + 48 + (r & 1) * 8) = (v4u){0u, 0u, 0u, 0u}; } }
#pragma unroll
                for (int i = 0; i < 2; ++i) { const int v = tid + NTHR * i; if (v < 768) { const int t = v & 63, c8 = (v >> 6) * 8;
                    const v4u raw = *(const v4u*)(H + (r0 + t) * HW + C_GV + h * 96 + c8);
#pragma unroll
                    for (int e = 0; e < 4; ++e) { Vt[(c8 + 2 * e) * 72 + t] = (bf16)(raw[e] & 0xffffu); Vt[(c8 + 2 * e + 1) * 72 + t] = (bf16)(raw[e] >> 16); } } }
#pragma unroll
                for (int i = 0; i < 3; ++i) { const int idx = tid + NTHR * i; if (idx < 1152) { const int k = idx % 48, v4 = (idx / 48) * 4;
                    typedef unsigned u32x2v __attribute__((ext_vector_type(2))); const u32x2v sv = *(const u32x2v*)(Ub + k * 96 + v4);
                    S0t[(v4 + 0) * 72 + k] = (bf16)(sv.x & 0xffffu); S0t[(v4 + 1) * 72 + k] = (bf16)(sv.x >> 16); S0t[(v4 + 2) * 72 + k] = (bf16)(sv.y & 0xffffu); S0t[(v4 + 3) * 72 + k] = (bf16)(sv.y >> 16); } }
                __syncthreads();
                for (int tile = wave; tile < 16; tile += 8) { const int ti = tile >> 2, tj = tile & 3; f32x4 acc = (f32x4){0.f, 0.f, 0.f, 0.f};
                    if (tj <= ti) acc = mmb16(qeb + ti * 16 * 72, 72, keb + tj * 16 * 72, 72, 64, acc, lane);
#pragma unroll
                    for (int r = 0; r < 4; ++r) { const int tr = ti * 16 + 4 * fq + r, sc_ = tj * 16 + fr; Ab[tr * 72 + sc_] = (bf16)f2bf((sc_ <= tr) ? acc[r] : 0.f); } }
                __syncthreads();
                for (int tile = wave; tile < 24; tile += 8) { const int ti = tile / 6, tj = tile % 6;
                    f32x4 acc = mmb16(qeb + ti * 16 * 72, 72, S0t + tj * 16 * 72, 72, 64, (f32x4){0.f, 0.f, 0.f, 0.f}, lane);
                    acc = mmb16(Ab + ti * 16 * 72, 72, Vt + tj * 16 * 72, 72, 64, acc, lane);
#pragma unroll
                    for (int r = 0; r < 4; ++r) o[(ti * 16 + 4 * fq + r) * 98 + tj * 16 + fr] = acc[r]; }
                __syncthreads();
                const float go0 = a.in[14][l * 96 + lane], go1 = a.in[14][l * 96 + 64 + (lane & 31)];
#pragma unroll
                for (int q = 0; q < 8; ++q) { const int t = wave * 8 + q; const float x0 = o[t * 98 + lane], x1 = lane < 32 ? o[t * 98 + 64 + lane] : 0.f;
                    const float rs = rsqrtf(wave_sum(x0 * x0 + x1 * x1) * (1.f / 96.f) + EPS);
                    OMIX[(r0 + t) * D + h * 96 + lane] = (bf16)f2bf(x0 * rs * go0 * siluf_(gg0[q]));
                    if (lane < 32) OMIX[(r0 + t) * D + h * 96 + 64 + lane] = (bf16)f2bf(x1 * rs * go1 * siluf_(gg1[q])); }
                __syncthreads();
            }
            SUB_PROF(14);
            for (int e4 = bid * NTHR + tid; e4 < MP * 96; e4 += G * NTHR) { const int row = e4 / 96, ch = (e4 % 96) * 4; const int bc = row >> 6;
                typedef unsigned u32x2v __attribute__((ext_vector_type(2)));
                const u32x2v hlr = *(const u32x2v*)(HLOC + (size_t)row * 384 + ch), acr = *(const u32x2v*)(ACUM + (size_t)row * 384 + ch); const f32x4 cr = *(const f32x4*)(CARRY + (size_t)bc * 384 + ch);
                const f32x4 hl = (f32x4){__uint_as_float(hlr.x << 16), __uint_as_float(hlr.x & 0xffff0000u), __uint_as_float(hlr.y << 16), __uint_as_float(hlr.y & 0xffff0000u)}, ac = (f32x4){__uint_as_float(acr.x << 16), __uint_as_float(acr.x & 0xffff0000u), __uint_as_float(acr.y << 16), __uint_as_float(acr.y & 0xffff0000u)};
                const u32x2v ry = *(const u32x2v*)(H + (size_t)row * HW + C_RY + ch);
                const f32x4 hv = hl + ac * cr;
                u32x2v w; w.x = pg8::cvt_pk_bf16(hv.x * gelu_tanh(__uint_as_float(ry.x << 16)), hv.y * gelu_tanh(__uint_as_float(ry.x & 0xffff0000u)));
                w.y = pg8::cvt_pk_bf16(hv.z * gelu_tanh(__uint_as_float(ry.y << 16)), hv.w * gelu_tanh(__uint_as_float(ry.y & 0xffff0000u)));
                *(u32x2v*)(OMIX + (size_t)row * D + 384 + ch) = w; }
        }
        PH_NEXT;
        if (PH_ON) { TID_DECL
            pg8::Gemm g{OMIX, (const bf16*)(wl + WO_OUT), MP, D, D}; pg8::StaticOrder S; S.init(MP, D, G, bid);
            pg8::EpiResid E{out, XB, ss1, MR};
            pg8::gemm_phase<pg8::EpiResid, pg8::StaticOrder, true, true>(lds, g, S, E);
            for (int u = G - 1 - bid; u < 256; u += G) small_gemm_sk<3>(OMIX + (size_t)MP * D, (const bf16*)(wl + WO_OUT), D, u, L, nullptr, 0, nullptr, ss1, out, XB, lane, wave);
            __syncthreads();
        }
        PH_NEXT;
        if (PH_ON) { TID_DECL
            for (int rep_ = 0; rep_ < REP_G6; ++rep_) {
            pg8::Gemm g{XB, (const bf16*)(wl + WO_Q), MP, 256, D}; pg8::StaticOrder S; S.init(MP, 256, G, bid);
            pg8::EpiScaleF32 E{QM, 256, ss1};
            pg8::gemm_phase<pg8::EpiScaleF32, pg8::StaticOrder, true, true>(lds, g, S, E);
            for (int u = G - 1 - bid; u < 64; u += G) small_gemm_sk<2>(XB + (size_t)MP * D, (const bf16*)(wl + WO_Q), D, u, L, QM, 256, ss1, nullptr, nullptr, nullptr, lane, wave);
            __syncthreads(); }
            __syncthreads();
        }
        PH_NEXT;
        if (PH_ON) { TID_DECL
            const float* gmq = a.in[30] + l * 64;
            int staged_bh = -1;
            for (int u = bid; u < 1024 + NS; u += G) {
                if (u < 1024) { int b = u >> 9, rb = (u >> 2) & 127, h = u & 3; if (G == 256) { const int k_ = u >> 8, w_ = u & 255; b = w_ >> 7; h = w_ & 3; rb = ((w_ >> 2) & 31) * 4 + k_; }     const size_t r0 = (size_t)b * T + rb * 64;
                    LAS bf16* Kb = (LAS bf16*)lds; LAS bf16* Vt = (LAS bf16*)(lds + 36864); LAS bf16* Qb = (LAS bf16*)(lds + 70656); LAS float* S = (LAS float*)(lds + 79872);
                    const float* mk = out + O_MEMK + (size_t)(l * NB + b) * 256 * 256 + h * 64; const float* mv = out + O_MEMV + (size_t)(l * NB + b) * 256 * 256 + h * 64;
                    const bool restage = (b * 4 + h) != staged_bh; staged_bh = b * 4 + h;
#pragma unroll
                    for (int i = 0; i < 2; ++i) { const int v = tid + NTHR * i; const int r = v >> 4, c4 = (v & 15) * 4;
                        f32x4 x = *(const f32x4*)(QM + (r0 + r) * 256 + h * 64 + c4); float ssq = (x.x * x.x + x.y * x.y) + (x.z * x.z + x.w * x.w);
                        ssq = sum16(ssq);
                        const float sc = rsqrtf(ssq * (1.f / 64.f) + EPS) * 0.125f; const f32x4 g4 = *(const f32x4*)(gmq + c4);
                        typedef unsigned u32x2v __attribute__((ext_vector_type(2)));
                        u32x2v w; w.x = pg8::cvt_pk_bf16(x.x * sc * g4.x, x.y * sc * g4.y); w.y = pg8::cvt_pk_bf16(x.z * sc * g4.z, x.w * sc * g4.w); *(LAS u32x2v*)(Qb + r * 72 + c4) = w; }
                    if (restage)
#pragma unroll
                    for (int i = 0; i < 8; ++i) { const int v = tid + NTHR * i; const int j = v >> 4, c4 = (v & 15) * 4;
                        const int j2 = v & 255, c2 = (v >> 8) * 4;
                        const f32x4 kx = *(const f32x4*)(mk + (size_t)j * 256 + c4); const f32x4 vx = *(const f32x4*)(mv + (size_t)j2 * 256 + c2);
                        typedef unsigned u32x2v __attribute__((ext_vector_type(2)));
                        u32x2v w; w.x = pg8::cvt_pk_bf16(kx.x, kx.y); w.y = pg8::cvt_pk_bf16(kx.z, kx.w); *(LAS u32x2v*)(Kb + j * 72 + c4) = w;
                        Vt[(c2 + 0) * 264 + j2] = (bf16)f2bf(vx.x); Vt[(c2 + 1) * 264 + j2] = (bf16)f2bf(vx.y); Vt[(c2 + 2) * 264 + j2] = (bf16)f2bf(vx.z); Vt[(c2 + 3) * 264 + j2] = (bf16)f2bf(vx.w); }
                    __syncthreads();
                    for (int tile = wave; tile < 64; tile += 8) { const int ti = tile >> 4, tj = tile & 15;
                        f32x4 acc = mmb16(Qb + ti * 16 * 72, 72, Kb + tj * 16 * 72, 72, 64, (f32x4){0.f, 0.f, 0.f, 0.f}, lane);
#pragma unroll
                        for (int r = 0; r < 4; ++r) S[(ti * 16 + 4 * fq + r) * 260 + tj * 16 + fr] = acc[r]; }
                    __syncthreads();
#pragma unroll
                    for (int q = 0; q < 8; ++q) { const int rr = wave * 8 + q; float x[4]; float mx = -INFINITY;
#pragma unroll
                        for (int j = 0; j < 4; ++j) { x[j] = S[rr * 260 + lane + 64 * j]; mx = fmaxf(mx, x[j]); }
                        mx = wave_max(mx); float sum = 0.f;
#pragma unroll
                        for (int j = 0; j < 4; ++j) { x[j] = __expf(x[j] - mx); sum += x[j]; }
                        const float inv = 1.f / wave_sum(sum); LAS bf16* pr = (LAS bf16*)(S + rr * 260);
#pragma unroll
                        for (int j = 0; j < 4; ++j) pr[lane + 64 * j] = (bf16)f2bf(x[j] * inv); }
                    __syncthreads();
                    for (int tile = wave; tile < 16; tile += 8) { const int ti = tile >> 2, tj = tile & 3;
                      f32x4 acc = mmb16((LAS bf16*)S + ti * 16 * 520, 520, Vt + tj * 16 * 264, 264, 256, (f32x4){0.f, 0.f, 0.f, 0.f}, lane);
#pragma unroll
                      for (int r = 0; r < 4; ++r) OMEM[(r0 + ti * 16 + 4 * fq + r) * 256 + h * 64 + tj * 16 + fr] = (bf16)f2bf(acc[r]); }
                    __syncthreads();
                } else { SUB_PROF(15); TID_UNIT const int n = u - 1024; const size_t row = (size_t)MP + n; const size_t ln = (size_t)l * NS + n;
                    LAS float* qn = L; LAS float* sc = L + 256; LAS float* red = L + 1296;
                    if (wave < 4) { const float qx = QM[row * 256 + wave * 64 + lane]; const float ssq = wave_sum(qx * qx); qn[wave * 64 + lane] = qx * rsqrtf(ssq * (1.f / 64.f) + EPS) * gmq[lane] * 0.125f; }
                    __syncthreads();
                    const int hh = lane >> 4; const f32x4 qv = *(const LAS f32x4*)(qn + lane * 4);
                    const float* ck = a.in[8] + ln * 256 * 256; const float* cv = a.in[9] + ln * 256 * 256;
#pragma unroll 1
                    for (int ib = 0; ib < 32; ib += 16) { f32x4 kr[16];
#pragma unroll
                        for (int jj = 0; jj < 16; ++jj) kr[jj] = __builtin_nontemporal_load((const f32x4*)(ck + (size_t)((tid >> 6) + 8 * (ib + jj)) * 256 + lane * 4));
#pragma unroll
                        for (int jj = 0; jj < 16; ++jj) { float s = (kr[jj].x * qv.x + kr[jj].y * qv.y) + (kr[jj].z * qv.z + kr[jj].w * qv.w);
                            s = sum16(s);
                            if ((lane & 15) == 0) sc[hh * 260 + (tid >> 6) + 8 * (ib + jj)] = s; } }
                    __syncthreads();
                    if (wave < 4) { float x[4]; float mx = -INFINITY;
#pragma unroll
                        for (int j = 0; j < 4; ++j) { x[j] = sc[wave * 260 + lane + 64 * j]; mx = fmaxf(mx, x[j]); }
                        mx = wave_max(mx); float sum = 0.f;
#pragma unroll
                        for (int j = 0; j < 4; ++j) { x[j] = __expf(x[j] - mx); sum += x[j]; }
                        const float inv = 1.f / wave_sum(sum);
#pragma unroll
                        for (int j = 0; j < 4; ++j) sc[wave * 260 + lane + 64 * j] = x[j] * inv; }
                    __syncthreads();
                    f32x4 acc = (f32x4){0.f, 0.f, 0.f, 0.f};
#pragma unroll 1
                    for (int ib = 0; ib < 32; ib += 16) { f32x4 vr[16];
#pragma unroll
                        for (int jj = 0; jj < 16; ++jj) vr[jj] = __builtin_nontemporal_load((const f32x4*)(cv + (size_t)((tid >> 6) + 8 * (ib + jj)) * 256 + lane * 4));
#pragma unroll
                        for (int jj = 0; jj < 16; ++jj) acc += vr[jj] * sc[hh * 260 + (tid >> 6) + 8 * (ib + jj)]; }
                    *(LAS f32x4*)(red + wave * 256 + lane * 4) = acc;
                    __syncthreads();
                    if (tid < 256) { float s = 0.f;
#pragma unroll
                        for (int w = 0; w < 8; ++w) s += red[w * 256 + tid];
                        OMEM[row * 256 + tid] = (bf16)f2bf(s); }
                    __syncthreads();
                }
            }
        }
        PH_NEXT;
        if (PH_ON) { TID_DECL
            pg8::Gemm g{OMEM, (const bf16*)(wl + WO_O), MP, D, 256}; pg8::StaticOrder S; S.init(MP, D, G, bid);
            pg8::EpiResid E{out, XB, ss2, MR};
            pg8::gemm_phase<pg8::EpiResid, pg8::StaticOrder, true, true>(lds, g, S, E);
            for (int u = G - 1 - bid; u < 256; u += G) small_gemm_sk<3>(OMEM + (size_t)MP * 256, (const bf16*)(wl + WO_O), 256, u, L, nullptr, 0, nullptr, ss2, out, XB, lane, wave);
            __syncthreads();
        }
        PH_NEXT;
        if (PH_ON) { TID_DECL
            for (int rep_ = 0; rep_ < REP_G9; ++rep_) {
            pg8::Gemm g{XB, (const bf16*)(wl + WO_1), MP, FF, D}; pg8::StaticOrder S; S.init(MP, FF, G, bid);
            pg8::EpiScaleBf16<1> E{HF, FF, ss2};
            pg8::gemm_phase<pg8::EpiScaleBf16<1>, pg8::StaticOrder, true, true>(lds, g, S, E);
            for (int u = G - 1 - bid; u < FF / 32; u += G) small_gemm<1>(XB + (size_t)MP * D, (const bf16*)(wl + WO_1), D, u, HF, FF, ss2, nullptr, nullptr, nullptr, lane, wave);
            __syncthreads(); }
            __syncthreads();
        }
        PH_NEXT;
        if (PH_ON) { TID_DECL
            pg8::Gemm g{HF, (const bf16*)(wl + WO_2), MP, D, FF}; pg8::StaticOrder S; S.init(MP, D, G, bid);
            unsigned long long* sso = l + 1 < DEPTH ? ssn : SSM + 512;
            for (int rep_ = 1; rep_ < REP_G10; ++rep_) { pg8::Gemm g{HF, (const bf16*)(wl + WO_2), MP, D, FF}; pg8::StaticOrder S; S.init(MP, D, G, bid);
                pg8::EpiResid E{(float*)(ws + WS_DUMX), (bf16*)(ws + WS_DUMB), (unsigned long long*)(ws + WS_DUMS), MR};
                pg8::gemm_phase<pg8::EpiResid, pg8::StaticOrder, true, true>(lds, g, S, E); __syncthreads(); }
            pg8::EpiResid E{out, XB, sso, MR};
            pg8::gemm_phase<pg8::EpiResid, pg8::StaticOrder, true, true>(lds, g, S, E);
            for (int u = G - 1 - bid; u < 256; u += G) small_gemm_sk<3>(HF + (size_t)MP * FF, (const bf16*)(wl + WO_2), FF, u, L, nullptr, 0, nullptr, sso, out, XB, lane, wave);
            __syncthreads();
        }
        PH_NEXT;
    }
#if PROF_MASK
    if (blockIdx.x == 0) { const unsigned long long t_end = rt(); while (rt() - t_end < 4ull * t_acc) __builtin_amdgcn_s_sleep(16); }
#endif
}

#ifndef MK_MULTI
#define MK_MULTI 0
#endif
extern "C" void kernel_launch(void* const* d_in, const int* in_sizes, int n_in, void* d_out, int out_size, void* d_ws, size_t ws_size, hipStream_t stream) {
    static int grid = 0;
    constexpr int NPH = 1 + DEPTH * 10;
    if (grid == 0) {
        if (n_in != 36 || out_size != (int)O_END || ws_size < WS_END) { fprintf(stderr, "kernel_launch: unexpected shapes: n_in %d out %d ws %zu\n", n_in, out_size, ws_size); grid = -1; return; }
        int dev = 0, cus = 0, per_cu = 0;
        (void)hipGetDevice(&dev); (void)hipDeviceGetAttribute(&cus, hipDeviceAttributeMultiprocessorCount, dev);
        if (hipFuncSetAttribute((const void*)mk_fwd, hipFuncAttributeMaxDynamicSharedMemorySize, LDS_BYTES) != hipSuccess) { fprintf(stderr, "kernel_launch: hipFuncSetAttribute failed\n"); grid = -1; return; }
        if (hipOccupancyMaxActiveBlocksPerMultiprocessor(&per_cu, (const void*)mk_fwd, NTHR, LDS_BYTES) != hipSuccess || per_cu < 1) { fprintf(stderr, "kernel_launch: occupancy query says %d\n", per_cu); per_cu = 1; }
        (void)hipGetLastError();
        grid = cus;
        fprintf(stderr, "kernel_launch: grid %d (occupancy %d per CU)\n", grid, per_cu);
    }
    if (grid < 0) return;
    (void)hipMemsetAsync((char*)d_ws + WS_CTL, 0, CTL_ZERO_BYTES, stream);
    (void)hipMemsetAsync((char*)d_ws + WS_SS, 0, SS_BYTES, stream);
    Args a{};
    for (int i = 0; i < 36; ++i) a.in[i] = (const float*)d_in[i];
    a.out = (float*)d_out; a.ws = (unsigned char*)d_ws; a.use_cg = 0; a.pad = 0;
#if MK_MULTI
    for (int p = 0; p < NPH; ++p) { a.ph_lo = p; a.ph_hi = p + 1; hipLaunchKernelGGL(mk_fwd, dim3(grid), dim3(NTHR), LDS_BYTES, stream, a); }
#else
    a.ph_lo = 0; a.ph_hi = NPH; a.use_cg = 1;
    void* args[] = {&a};
    hipError_t e = hipLaunchCooperativeKernel((const void*)mk_fwd, dim3(grid), dim3(NTHR), args, LDS_BYTES, stream);
    if (e != hipSuccess) fprintf(stderr, "cooperative launch failed: %s (grid %d)\n", hipGetErrorString(e), grid);
#endif
}
```

```cpp
#include <hip/hip_runtime.h>
#include <hip/hip_cooperative_groups.h>
#include <cstdio>
#include <cstdint>
namespace cg = cooperative_groups;
namespace pg8 {
#define PG8_LAS __attribute__((address_space(3)))
typedef unsigned short bf16_t;
typedef short bf16x8 __attribute__((ext_vector_type(8)));
typedef float f32x4 __attribute__((ext_vector_type(4)));
typedef unsigned u32x4 __attribute__((ext_vector_type(4)));
constexpr int BM = 256, BK = 64, HALF = 128, HTB = HALF * BK * 2  , STAGE_BYTES = 8 * HTB, NXCD = 8, WGM = 8;

__host__ __device__ __forceinline__ int lds_byte(int r, int c) { const int st = (r >> 4) * 2 + (c >> 5), rr = r & 15, cc = c & 31, ob = rr * 64 + cc * 2; return st * 1024 + (ob ^ (((ob >> 9) & 1) << 5)); }
__host__ __device__ __forceinline__ void stage_rc(int b, int& R, int& C) { const int st = b / 1024, sb = b % 1024, swz = sb ^ (((sb >> 9) & 1) << 5); R = (st >> 1) * 16 + swz / 64; C = (st & 1) * 32 + (swz % 64) / 2; }
__host__ __device__ __forceinline__ int perm32(int rho) { const int n = rho >> 4, i = rho & 15; return 8 * (i >> 2) + 4 * n + (i & 3); }

struct Unit { int pm, pn; };
struct Gemm { const bf16_t* A; const bf16_t* Bt; int M, N, K; };

struct StaticOrder {
    int nM, nN, nwg, G, c;
    __host__ __device__ void init(int M, int N, int G_, int c_) { nM = M / BM; nN = N / BM; nwg = nM * nN; G = G_; c = c_; }
    __host__ __device__ bool next(int i, Unit& u) const {
        const long L = (long)i * G + c; if (L >= nwg) return false;
        int wgid = (int)L; { const int q = nwg / NXCD, r = nwg % NXCD, xcd = wgid % NXCD, off = wgid / NXCD; wgid = (xcd < r ? xcd * (q + 1) : r * (q + 1) + (xcd - r) * q) + off; }
        const int nig = WGM * nN, gid = wgid / nig, fm = gid * WGM, gsz = (nM - fm) < WGM ? (nM - fm) : WGM;
        u.pm = fm + ((wgid % nig) % gsz); u.pn = (wgid % nig) / gsz; return true;
    }
    __device__ __forceinline__ void a_ready(const Unit&) const {}
    __device__ __forceinline__ void done(const Unit&) const {}
};

__device__ __forceinline__ unsigned cvt_pk_bf16(float lo, float hi) { unsigned r; asm volatile("v_cvt_pk_bf16_f32 %0, %1, %2" : "=v"(r) : "v"(lo), "v"(hi)); return r; }
template <class Epi, class Sched, bool ALIGN_EPI = false, bool SP2 = false>
__device__ __forceinline__ void gemm_phase(PG8_LAS unsigned char* lds, const Gemm g, const Sched& S, const Epi& E) {
    int tid_l = threadIdx.x; asm volatile("" : "+v"(tid_l)); const int tid = tid_l, wid = __builtin_amdgcn_readfirstlane(tid >> 6), lane = tid & 63, wr = wid >> 2, wc = wid & 3, fr = lane & 15, fq = lane >> 4;
    const int K = g.K, nt = K / BK;
    unsigned voffA[2], voffB[2];
#pragma unroll
    for (int i = 0; i < 2; ++i) { int R, C; stage_rc(tid * 16 + i * 8192, R, C); const int Rb = Epi::PERM ? ((R & ~31) + perm32(R & 31)) : R;
        voffA[i] = (unsigned)(R * K + C) * 2u; voffB[i] = (unsigned)(Rb * K + C) * 2u; }
    const size_t kstep = (size_t)(BK * 2);
    const size_t hstep = (size_t)HALF * K * 2;
    const size_t tstep = 2 * hstep;
    const unsigned ldsw = (unsigned)wid * 1024u;
    const int aoff = lds_byte(wr * 64 + fr, fq * 8), boff = lds_byte(wc * 32 + fr, fq * 8);
#define PG8_SA(b, h) (((b) * 2 + (h)) * HTB)
#define PG8_SB(b, h) ((4 + (b) * 2 + (h)) * HTB)
#define PG8_STAGE(bufoff, gbase, voff) do { _Pragma("unroll") for (int _i = 0; _i < 2; ++_i) \
        __builtin_amdgcn_global_load_lds((const unsigned*)((const char*)(gbase) + (voff)[_i]), (PG8_LAS unsigned*)(lds + (bufoff) + ldsw + _i * 8192), 16, 0, 0); } while (0)
#define PG8_LDA(dst, b, h) do { _Pragma("unroll") for (int m = 0; m < 4; ++m) _Pragma("unroll") for (int k = 0; k < 2; ++k) dst[m][k] = *(const PG8_LAS bf16x8*)(lds + PG8_SA(b, h) + aoff + m * 2048 + k * 1024); } while (0)
#define PG8_LDB(dst, b, h) do { _Pragma("unroll") for (int n = 0; n < 2; ++n) _Pragma("unroll") for (int k = 0; k < 2; ++k) dst[n][k] = *(const PG8_LAS bf16x8*)(lds + PG8_SB(b, h) + boff + n * 2048 + k * 1024); } while (0)
#define PG8_MMA(ai, bj, At, Bt) do { __builtin_amdgcn_s_setprio(1); _Pragma("unroll") for (int m = 0; m < 4; ++m) _Pragma("unroll") for (int n = 0; n < 2; ++n) _Pragma("unroll") for (int k = 0; k < 2; ++k) \
        acc[ai][bj][m][n] = __builtin_amdgcn_mfma_f32_16x16x32_bf16(Bt[n][k], At[m][k], acc[ai][bj][m][n], 0, 0, 0); __builtin_amdgcn_s_setprio(0); } while (0)
#define PG8_WAIT_V(n) asm volatile("s_waitcnt vmcnt(" #n ")" ::: "memory")
#define PG8_WAIT_L(n) asm volatile("s_waitcnt lgkmcnt(" #n ")" ::: "memory")
#define PG8_BAR __builtin_amdgcn_s_barrier()
#define PG8_SCHED __builtin_amdgcn_sched_barrier(0)
    Unit cur, nxt; int ui = 0;
    if (!S.next(0, cur)) return;
    f32x4 acc[2][2][4][2];
#pragma unroll
    for (int a = 0; a < 2; ++a)
#pragma unroll
        for (int b = 0; b < 2; ++b)
#pragma unroll
            for (int m = 0; m < 4; ++m)
#pragma unroll
                for (int n = 0; n < 2; ++n) acc[a][b][m][n] = (f32x4){0.f, 0.f, 0.f, 0.f};
    bf16x8 At[4][2], B0[2][2], B1[2][2];
    const char* cA = (const char*)g.A + (size_t)cur.pm * tstep; const char* cB = (const char*)g.Bt + (size_t)cur.pn * tstep;
    S.a_ready(cur);
    if constexpr (SP2) {
        PG8_STAGE(PG8_SB(0, 0), cB, voffB); PG8_STAGE(PG8_SB(0, 1), cB + hstep, voffB); PG8_STAGE(PG8_SA(0, 0), cA, voffA); PG8_STAGE(PG8_SA(0, 1), cA + hstep, voffA);
        if (wr == 1) PG8_BAR;
        PG8_WAIT_V(2); PG8_BAR;
        PG8_STAGE(PG8_SB(1, 0), cB + kstep, voffB); PG8_STAGE(PG8_SA(1, 0), cA + kstep, voffA); PG8_STAGE(PG8_SB(1, 1), cB + hstep + kstep, voffB);
        PG8_WAIT_V(6); PG8_BAR;
    } else {
        PG8_STAGE(PG8_SB(0, 0), cB, voffB); PG8_STAGE(PG8_SA(0, 0), cA, voffA); PG8_STAGE(PG8_SB(0, 1), cB + hstep, voffB); PG8_STAGE(PG8_SA(0, 1), cA + hstep, voffA);
        if (wr == 1) PG8_BAR;
        PG8_WAIT_V(4); PG8_BAR;
        PG8_STAGE(PG8_SB(1, 0), cB + kstep, voffB); PG8_STAGE(PG8_SA(1, 0), cA + kstep, voffA); PG8_STAGE(PG8_SB(1, 1), cB + hstep + kstep, voffB);
        PG8_WAIT_V(6); PG8_BAR;
    }
    for (;;) {
        const bool has_next = S.next(ui + 1, nxt);
        const char* nA = has_next ? (const char*)g.A + (size_t)nxt.pm * tstep : cA; const char* nB = has_next ? (const char*)g.Bt + (size_t)nxt.pn * tstep : cB;
        for (int t = 0; t < nt; t += 2) {
            const bool last = (t == nt - 2);
            const char* a1 = cA + (size_t)(t + 1) * kstep;
            const char* a2 = last ? nA : cA + (size_t)(t + 2) * kstep; const char* b2 = last ? nB : cB + (size_t)(t + 2) * kstep;
            const char* a3 = a2 + kstep; const char* b3 = b2 + kstep;
            if (last && has_next) S.a_ready(nxt);
            if constexpr (SP2) {
            PG8_LDB(B0, 0, 0); PG8_LDB(B1, 0, 1); PG8_SCHED; PG8_LDA(At, 0, 0); PG8_STAGE(PG8_SA(1, 1), a1 + hstep, voffA);
            PG8_WAIT_V(8); PG8_WAIT_L(0); PG8_BAR; PG8_MMA(0, 0, At, B0); PG8_MMA(0, 1, At, B1); PG8_BAR; PG8_SCHED;
            PG8_LDA(At, 0, 1); PG8_STAGE(PG8_SB(0, 0), b2, voffB); PG8_STAGE(PG8_SB(0, 1), b2 + hstep, voffB); PG8_STAGE(PG8_SA(0, 0), a2, voffA);
            PG8_WAIT_V(8); PG8_WAIT_L(0); PG8_BAR; PG8_MMA(1, 0, At, B0); PG8_MMA(1, 1, At, B1); PG8_BAR; PG8_SCHED;
            PG8_LDB(B0, 1, 0); PG8_LDB(B1, 1, 1); PG8_SCHED; PG8_LDA(At, 1, 0); PG8_STAGE(PG8_SA(0, 1), a2 + hstep, voffA);
            PG8_WAIT_V(8); PG8_WAIT_L(0); PG8_BAR; PG8_MMA(0, 0, At, B0); PG8_MMA(0, 1, At, B1); PG8_BAR; PG8_SCHED;
            PG8_LDA(At, 1, 1); PG8_STAGE(PG8_SB(1, 0), b3, voffB); PG8_STAGE(PG8_SB(1, 1), b3 + hstep, voffB); PG8_STAGE(PG8_SA(1, 0), a3, voffA);
            PG8_WAIT_V(8); PG8_WAIT_L(0); PG8_BAR; PG8_MMA(1, 0, At, B0); PG8_MMA(1, 1, At, B1); PG8_BAR; PG8_SCHED;
            } else {
            PG8_LDB(B0, 0, 0); PG8_SCHED; PG8_LDA(At, 0, 0); PG8_STAGE(PG8_SA(1, 1), a1 + hstep, voffA);
            PG8_WAIT_L(8); PG8_BAR; PG8_WAIT_L(0); PG8_MMA(0, 0, At, B0); PG8_BAR; PG8_SCHED;
            PG8_LDB(B1, 0, 1); PG8_STAGE(PG8_SB(0, 0), b2, voffB);
            PG8_BAR; PG8_WAIT_L(0); PG8_MMA(0, 1, At, B1); PG8_BAR;
            PG8_LDA(At, 0, 1); PG8_STAGE(PG8_SA(0, 0), a2, voffA);
            PG8_BAR; PG8_WAIT_L(0); PG8_MMA(1, 0, At, B0); PG8_BAR; PG8_SCHED;
            PG8_STAGE(PG8_SB(0, 1), b2 + hstep, voffB);
            PG8_WAIT_V(6); PG8_BAR; PG8_MMA(1, 1, At, B1); PG8_BAR;
            PG8_LDB(B0, 1, 0); PG8_SCHED; PG8_LDA(At, 1, 0); PG8_STAGE(PG8_SA(0, 1), a2 + hstep, voffA);
            PG8_WAIT_L(8); PG8_BAR; PG8_WAIT_L(0); PG8_MMA(0, 0, At, B0); PG8_BAR; PG8_SCHED;
            PG8_LDB(B1, 1, 1); PG8_STAGE(PG8_SB(1, 0), b3, voffB);
            PG8_BAR; PG8_WAIT_L(0); PG8_MMA(0, 1, At, B1); PG8_BAR;
            PG8_LDA(At, 1, 1); PG8_STAGE(PG8_SA(1, 0), a3, voffA);
            PG8_BAR; PG8_WAIT_L(0); PG8_MMA(1, 0, At, B0); PG8_BAR; PG8_SCHED;
            PG8_STAGE(PG8_SB(1, 1), b3 + hstep, voffB);
            PG8_WAIT_V(6); PG8_BAR; PG8_MMA(1, 1, At, B1); PG8_BAR;
            }
        }
        if constexpr (ALIGN_EPI) { if (wr == 0) PG8_BAR; }
        if constexpr (!Epi::AFTER_DRAIN) { E(acc, cur, wr, wc, fr, fq); S.done(cur); }
        if (!has_next) break;
#pragma unroll
        for (int a = 0; a < 2; ++a)
#pragma unroll
            for (int b = 0; b < 2; ++b)
#pragma unroll
                for (int m = 0; m < 4; ++m)
#pragma unroll
                    for (int n = 0; n < 2; ++n) acc[a][b][m][n] = (f32x4){0.f, 0.f, 0.f, 0.f};
        cur = nxt; cA = nA; cB = nB; ++ui;
        if constexpr (ALIGN_EPI) { if (wr == 1) PG8_BAR; }
    }
    PG8_WAIT_V(0);
    if constexpr (!ALIGN_EPI) { if (wr == 0) PG8_BAR; }
    PG8_BAR;
    if constexpr (Epi::AFTER_DRAIN) { E.fused(acc, cur, wr, wc, fr, fq, lds, wid, lane); S.done(cur); }
#undef PG8_SA
#undef PG8_SB
#undef PG8_STAGE
#undef PG8_LDA
#undef PG8_LDB
#undef PG8_MMA
#undef PG8_WAIT_V
#undef PG8_WAIT_L
#undef PG8_BAR
#undef PG8_SCHED
}
}
#define GAS __attribute__((address_space(1)))
#define LAS __attribute__((address_space(3)))
typedef unsigned short bf16;
typedef unsigned v4u __attribute__((ext_vector_type(4)));
typedef float f32x4 __attribute__((ext_vector_type(4)));
typedef short bf16x8 __attribute__((ext_vector_type(8)));
typedef GAS unsigned gu32;
typedef GAS unsigned long long gu64;
#define RLX_AGENT __ATOMIC_RELAXED, __HIP_MEMORY_SCOPE_AGENT
#define LDS_WAIT() asm volatile("s_waitcnt lgkmcnt(0)" ::: "memory")
#define VM_WAIT() asm volatile("s_waitcnt vmcnt(0)" ::: "memory")
__device__ __forceinline__ unsigned long long rt() { return __builtin_amdgcn_s_memrealtime(); }
__device__ __forceinline__ unsigned f2bf(float f) { unsigned u = __builtin_bit_cast(unsigned, f); return (u + 0x7fffu + ((u >> 16) & 1u)) >> 16; }
__device__ __forceinline__ unsigned pk2(float lo, float hi) { return f2bf(lo) | (f2bf(hi) << 16); }

#define XB_TMO      128
#define XB_XCNT(j)  (256  + 64 * (j))
#define XB_XSUB(j)  (1280 + 64 * (j))
#define XB_XGEN(j)  (2304 + 64 * (j))
#define XB_TOP      3328
#define XB_TOPGEN   3392
#define XCD_BAR_WORDS 3456
#define XB_SPIN_CAP (1u << 18)

__device__ __forceinline__ unsigned xb_ld(unsigned* p)              { return __hip_atomic_load(p, __ATOMIC_RELAXED, __HIP_MEMORY_SCOPE_AGENT); }
__device__ __forceinline__ unsigned xb_add(unsigned* p, unsigned v) { return __hip_atomic_fetch_add(p, v, __ATOMIC_RELAXED, __HIP_MEMORY_SCOPE_AGENT); }
__device__ __forceinline__ unsigned xb_xcc_id() { return (unsigned)__builtin_amdgcn_s_getreg((3 << 11) | 20) & 0xFu; }
#define XB_SPIN(cond, bar) do { unsigned _sp = 0; while (cond) { __builtin_amdgcn_s_sleep(1); \
    if ((++_sp & 255u) == 0u) { if (xb_ld(&(bar)[XB_TMO])) break; if (_sp > XB_SPIN_CAP) { atomicAdd(&(bar)[XB_TMO], 1u); break; } } } } while (0)

struct XcdBarrier {
    unsigned* bar; unsigned x;
    volatile LAS unsigned* st;
};

__device__ __forceinline__ XcdBarrier xcd_barrier_post(unsigned* bar, volatile LAS unsigned* st) {
    XcdBarrier b; b.bar = bar; b.x = xb_xcc_id(); b.st = st;
    if (threadIdx.x == 0) (void)xb_add(&bar[XB_XCNT(b.x)], 1u);
    return b;
}
__device__ __forceinline__ void xcd_barrier_complete(unsigned* bar, unsigned x, unsigned& nloc, unsigned& nx) {
    const unsigned G = gridDim.x * gridDim.y * gridDim.z;
    unsigned sum, cnt, mine, sp = 0u;
    for (;;) {
        sum = 0u; cnt = 0u; mine = 0u;
#pragma unroll
        for (unsigned j = 0; j < 16; ++j) { const unsigned c = xb_ld(&bar[XB_XCNT(j)]); sum += c; cnt += (c > 0u) ? 1u : 0u; mine = (j == x) ? c : mine; }
        if (sum == G) break;
        __builtin_amdgcn_s_sleep(1);
        if ((++sp & 255u) == 0u) { if (xb_ld(&bar[XB_TMO])) break; if (sp > XB_SPIN_CAP) { atomicAdd(&bar[XB_TMO], 1u); break; } }
    }
    nloc = mine > 0u ? mine : 1u; nx = cnt > 0u ? cnt : 1u;
}

__device__ __forceinline__ void xcd_barrier(const XcdBarrier& b) {
    asm volatile("s_waitcnt vmcnt(0)" ::: "memory");
    __syncthreads();
    if (threadIdx.x == 0) {
        unsigned* bar = b.bar;
        __builtin_amdgcn_s_waitcnt(0);
        unsigned nloc = b.st[0], nx = b.st[1];
        if (nloc == 0u) { xcd_barrier_complete(bar, b.x, nloc, nx); b.st[0] = nloc; b.st[1] = nx; }
        const unsigned old = xb_add(&bar[XB_XSUB(b.x)], 1u);
        const unsigned gen = old / nloc;
        if (old + 1u == (gen + 1u) * nloc) {
            __builtin_amdgcn_fence(__ATOMIC_RELEASE, "agent");
            asm volatile("s_waitcnt vmcnt(0)" ::: "memory");
            const unsigned og = xb_add(&bar[XB_TOP], 1u);
            const unsigned tg = og / nx;
            if (og + 1u == (tg + 1u) * nx) xb_add(&bar[XB_TOPGEN], 1u);
            else XB_SPIN(xb_ld(&bar[XB_TOPGEN]) == tg, bar);
            __builtin_amdgcn_fence(__ATOMIC_ACQUIRE, "agent");
            xb_add(&bar[XB_XGEN(b.x)], 1u);
            asm volatile("s_waitcnt vmcnt(0)" ::: "memory");
        } else {
            XB_SPIN(xb_ld(&bar[XB_XGEN(b.x)]) == gen, bar);
            __builtin_amdgcn_fence(__ATOMIC_ACQUIRE, "agent");
            asm volatile("s_waitcnt vmcnt(0)" ::: "memory");
        }
    }
    __syncthreads();
}


constexpr int D = 1024, T = 8192, NB = 2, MP = NB * T, NS = 128, MR = MP + NS, M = 16640, HW = 2560, FF = 4096, DEPTH = 4, INW = 2448;
constexpr int C_GQ = 0, C_GK = 192, C_GV = 384, C_GOG = 768, C_RX = 1152, C_RY = 1536, C_SQ = 1920, C_SK = 2176, C_SV = 2304, C_GLR = 2432;
constexpr float EPS = 1e-6f;
constexpr int NTHR = 512, NWAVES = 8;
constexpr size_t O_Y = 0, O_YS = (size_t)MP * D, O_GLAP = O_YS + (size_t)NS * D, O_GLAS = O_GLAP + (size_t)DEPTH * NB * 4 * 48 * 96,
    O_RGHP = O_GLAS + (size_t)DEPTH * NS * 4 * 48 * 96, O_RGHS = O_RGHP + (size_t)DEPTH * NB * 384, O_RGCP = O_RGHS + (size_t)DEPTH * NS * 384,
    O_RGCS = O_RGCP + (size_t)DEPTH * NB * 3 * 384, O_SWKP = O_RGCS + (size_t)DEPTH * NS * 3 * 384, O_SWKS = O_SWKP + (size_t)DEPTH * NB * 128 * 128,
    O_SWVP = O_SWKS + (size_t)DEPTH * NS * 128 * 128, O_SWVS = O_SWVP + (size_t)DEPTH * NB * 128 * 128, O_MEMK = O_SWVS + (size_t)DEPTH * NS * 128 * 128,
    O_MEMV = O_MEMK + (size_t)DEPTH * NB * 256 * 256, O_END = O_MEMV + (size_t)DEPTH * NB * 256 * 256;
static_assert(O_END == 45379584, "output size");
constexpr size_t MiB = 1u << 20;
constexpr size_t WS_CTL = 0, CTL_ZERO_BYTES = 1 * MiB, WS_SS = 377 * MiB, SS_BYTES = 2 * MiB;
constexpr size_t WS_W = 2 * MiB, W_LAYER = 25 * MiB, WO_IN = 0, WO_OUT = 5 * MiB, WO_Q = 7 * MiB, WO_KV = 7 * MiB + MiB / 2, WO_O = 8 * MiB + MiB / 2, WO_1 = 9 * MiB, WO_2 = 17 * MiB;
constexpr size_t WS_XB = 102 * MiB, WS_MEMB = 135 * MiB, WS_KVRAW = 136 * MiB, WS_QM = 140 * MiB, WS_OMEM = 157 * MiB, WS_HF = 166 * MiB, WS_H = 166 * MiB, WS_OMIX = 248 * MiB;
constexpr size_t WS_CUM = 296 * MiB, WS_U = 308 * MiB, WS_DEC = 326 * MiB, WS_HLOC = 327 * MiB, WS_ACUM = 351 * MiB, WS_RGC = 375 * MiB, WS_WRG = 379 * MiB, WS_S0 = 380 * MiB, WS_DUMX = 400 * MiB, WS_DUMB = 470 * MiB, WS_DUMS = 510 * MiB, WS_END = 512 * MiB;
static_assert(WS_XB + (size_t)M * D * 2 <= WS_MEMB && WS_QM + (size_t)M * 256 * 4 <= WS_OMEM && WS_OMEM + (size_t)M * 256 * 2 <= WS_HF && WS_HF + (size_t)M * FF * 2 <= WS_CUM, "ws map");
static_assert(WS_H + (size_t)M * HW * 2 <= WS_OMIX && WS_OMIX + (size_t)M * D * 2 <= WS_CUM && (size_t)(13 * M + 512) * 8 <= SS_BYTES, "ws map 2");
constexpr int RGC_N = NB * 128 * 384;
constexpr int LDS_BYTES = 163840;
constexpr int CW_BAR = 4096;

#ifndef REP_SWA
#define REP_SWA 1
#endif
#ifndef REP_RG
#define REP_RG 1
#endif
#ifndef REP_GLA
#define REP_GLA 1
#endif
#ifndef REP_SMP
#define REP_SMP 1
#endif
#ifndef REP_P4
#define REP_P4 1
#endif
#ifndef REP_P7
#define REP_P7 1
#endif
#ifndef REP_P7S
#define REP_P7S 1
#endif
#ifndef REP_SYNC
#define REP_SYNC 1
#endif
#ifndef REP_P0
#define REP_P0 1
#endif
#ifndef REP_RGO
#define REP_RGO 1
#endif
#ifndef REP_G1
#define REP_G1 1
#endif
#ifndef REP_G6
#define REP_G6 1
#endif
#ifndef REP_G9
#define REP_G9 1
#endif
#ifndef REP_P3
#define REP_P3 1
#endif
#ifndef REP_G10
#define REP_G10 1
#endif
#ifndef PROF_MASK
#define PROF_MASK 0
#endif
#define REP_MAX 3
struct Args { const float* in[36]; float* out; unsigned char* ws; int ph_lo, ph_hi, use_cg, pad; };

__device__ __forceinline__ unsigned f2bf_hw(float f) { unsigned r; asm volatile("v_cvt_pk_bf16_f32 %0, %1, %1" : "=v"(r) : "v"(f)); return r & 0xffffu; }
__device__ __forceinline__ float bf2f(bf16 b) { return __uint_as_float(((unsigned)b) << 16); }
__device__ __forceinline__ float wave_sum(float x) {
    int v = __float_as_int(x);
#define WS_STEP(ctrl, rm) { const int t_ = __builtin_amdgcn_update_dpp(0, v, ctrl, rm, 0xf, false); v = __float_as_int(__int_as_float(v) + __int_as_float(t_)); }
    WS_STEP(0x111, 0xf) WS_STEP(0x112, 0xf) WS_STEP(0x114, 0xf) WS_STEP(0x118, 0xf) WS_STEP(0x142, 0xa) WS_STEP(0x143, 0xc)
#undef WS_STEP
    return __int_as_float(__builtin_amdgcn_readlane(v, 63));
}
__device__ __forceinline__ float wave_max(float x) {
    int v = __float_as_int(x);
#define WM_STEP(ctrl, rm) { const int t_ = __builtin_amdgcn_update_dpp((int)0xff800000u, v, ctrl, rm, 0xf, false); v = __float_as_int(fmaxf(__int_as_float(v), __int_as_float(t_))); }
    WM_STEP(0x111, 0xf) WM_STEP(0x112, 0xf) WM_STEP(0x114, 0xf) WM_STEP(0x118, 0xf) WM_STEP(0x142, 0xa) WM_STEP(0x143, 0xc)
#undef WM_STEP
    return __int_as_float(__builtin_amdgcn_readlane(v, 63));
}
#define DPP_ADD(x, ctrl) ((x) + __int_as_float(__builtin_amdgcn_update_dpp(0, __float_as_int(x), ctrl, 0xf, 0xf, false)))
__device__ __forceinline__ float sum8(float x) { x = DPP_ADD(x, 0xB1); x = DPP_ADD(x, 0x4E); x = DPP_ADD(x, 0x141); return x; }
__device__ __forceinline__ float sum16(float x) { x = sum8(x); x = DPP_ADD(x, 0x140); return x; }
__device__ __forceinline__ float sum32_hi(float x) { x = sum16(x); return x + __int_as_float(__builtin_amdgcn_update_dpp(0, __float_as_int(x), 0x142, 0xa, 0xf, false)); }
__device__ __forceinline__ float sigmoidf_(float x) { return __builtin_amdgcn_rcpf(1.f + __expf(-x)); }
__device__ __forceinline__ float neg_expm1_(float y) { if (fabsf(y) < 0.25f) { const float p = y * (1.f + y * (0.5f + y * (0.16666667f + y * (0.041666668f + y * (0.0083333338f + y * 0.0013888889f))))); return -p; } return -expm1f(y); }
__device__ __forceinline__ float softplusf_(float x) { return fmaxf(x, 0.f) + log1pf(__expf(-fabsf(x))); }
__device__ __forceinline__ float logsigf_(float x) { return fminf(x, 0.f) - __logf(1.f + __expf(-fabsf(x))); }
__device__ __forceinline__ float gelu_tanh(float x) { const float u2 = 1.5957691216057308f * (x + 0.044715f * x * x * x); return x * __builtin_amdgcn_rcpf(1.f + __expf(-u2)); }
__device__ __forceinline__ float siluf_(float x) { return x * __builtin_amdgcn_rcpf(1.f + __expf(-x)); }

__device__ __forceinline__ f32x4 mm16(const LAS float* A, int sai, int sak, const LAS float* B, int sbk, int sbj, int K, f32x4 acc, int lane) {
    const int i = lane & 15, q = lane >> 4;
    const LAS float* pa = A + i * sai + q * sak; const LAS float* pb = B + q * sbk + i * sbj;
#pragma unroll 4
    for (int k = 0; k < K; k += 4) acc = __builtin_amdgcn_mfma_f32_16x16x4f32(pa[k * sak], pb[k * sbk], acc, 0, 0, 0);
    return acc;
}

__device__ __forceinline__ f32x4 mmb16(const LAS bf16* A, int lda, const LAS bf16* B, int ldb, int K, f32x4 acc, int lane) {
    const LAS bf16* pa = A + (lane & 15) * lda + 8 * (lane >> 4); const LAS bf16* pb = B + (lane & 15) * ldb + 8 * (lane >> 4);
#pragma unroll 2
    for (int k = 0; k < K; k += 32) acc = __builtin_amdgcn_mfma_f32_16x16x32_bf16(*(const LAS bf16x8*)(pa + k), *(const LAS bf16x8*)(pb + k), acc, 0, 0, 0);
    return acc;
}

__device__ __forceinline__ void swa_issue(v4u (&raw)[6], const bf16* H, int u, int tid) {
    const int b = u >> 9, qb = (u >> 1) & 255, kv = u & 1, t0 = qb * 32;
#pragma unroll
    for (int i = 0; i < 6; ++i) { const int v = tid + NTHR * i; size_t row; int col;
        if (v >= 2560) { const int j = (v - 2560) >> 3, c = v & 7; row = (size_t)b * T + t0 + (j & 31); col = C_SQ + (kv * 2 + (j >> 5)) * 64 + c * 8; }
        else { const int vv_ = v < 1280 ? v : v - 1280; const int j = vv_ >> 3, c = vv_ & 7; const int sp = t0 - 128 + j; row = (size_t)b * T + (sp >= 0 ? sp : 0); col = (v < 1280 ? C_SK : C_SV) + kv * 64 + c * 8; }
        raw[i] = *(const v4u*)(H + row * HW + col); }
}
__device__ __forceinline__ void rg_issue(v4u (&cr)[2][4], const bf16* H, int uu, int tid) {
    const int b = uu >> 9, c = (uu >> 2) & 127, blk = uu & 3, t0 = c * 64;
#pragma unroll
    for (int i = 0; i < 2; ++i) { const int it0 = tid + NTHR * i; const int it = it0 < 768 ? it0 : 767; const int t = it / 12, c8 = (it % 12) * 8;
#pragma unroll
        for (int j = 0; j < 4; ++j) { const int tt = t0 + t - 3 + j; cr[i][j] = *(const v4u*)(H + ((size_t)b * T + (tt >= 0 ? tt : 0)) * HW + C_RX + blk * 96 + c8); } }
}

namespace pg8 {
template <int ACT> struct EpiScaleBf16 {
    static constexpr bool PERM = true, AFTER_DRAIN = false;
    bf16_t* O; int ldc; const unsigned long long* ss;
    __device__ __forceinline__ void operator()(const f32x4 (&acc)[2][2][4][2], const Unit& u, int wr, int wc, int fr, int fq) const {
        const int row0 = u.pm * BM + wr * 64 + fr; const int col0 = u.pn * BM + wc * 32 + 8 * fq;
#pragma unroll
        for (int ai = 0; ai < 2; ++ai)
#pragma unroll
            for (int m = 0; m < 4; ++m) { const int row = row0 + ai * HALF + m * 16; const float sc = rsqrtf((float)ss[row] * (1.f / (1024.f * 16777216.f)) + 1e-6f); bf16_t* rowp = O + (size_t)row * ldc + col0;
#pragma unroll
                for (int bj = 0; bj < 2; ++bj) { f32x4 v0 = acc[ai][bj][m][0] * sc, v1 = acc[ai][bj][m][1] * sc;
                    if (ACT == 1) {
#pragma unroll
                        for (int e = 0; e < 4; ++e) { float a = fmaxf(v0[e], 0.f), b = fmaxf(v1[e], 0.f); v0[e] = a * a; v1[e] = b * b; } }
                    u32x4 w; w.x = cvt_pk_bf16(v0[0], v0[1]); w.y = cvt_pk_bf16(v0[2], v0[3]); w.z = cvt_pk_bf16(v1[0], v1[1]); w.w = cvt_pk_bf16(v1[2], v1[3]);
                    *(u32x4*)(rowp + bj * HALF) = w; } }
    }
};
struct EpiScaleF32 {
    static constexpr bool PERM = false, AFTER_DRAIN = false;
    float* O; int ldc; const unsigned long long* ss;
    __device__ __forceinline__ void operator()(const f32x4 (&acc)[2][2][4][2], const Unit& u, int wr, int wc, int fr, int fq) const {
        const int row0 = u.pm * BM + wr * 64 + fr; const int col0 = u.pn * BM + wc * 32 + 4 * fq;
#pragma unroll
        for (int ai = 0; ai < 2; ++ai)
#pragma unroll
            for (int m = 0; m < 4; ++m) { const int row = row0 + ai * HALF + m * 16; const float sc = rsqrtf((float)ss[row] * (1.f / (1024.f * 16777216.f)) + 1e-6f); float* rowp = O + (size_t)row * ldc + col0;
#pragma unroll
                for (int bj = 0; bj < 2; ++bj)
#pragma unroll
                    for (int n = 0; n < 2; ++n) *(f32x4*)(rowp + bj * HALF + n * 16) = acc[ai][bj][m][n] * sc; }
    }
};
struct EpiResid {
    static constexpr bool PERM = false, AFTER_DRAIN = false;
    float* X; bf16_t* XB; unsigned long long* ssout; int mreal; const float* Xin;
    __device__ __forceinline__ void operator()(const f32x4 (&acc)[2][2][4][2], const Unit& u, int wr, int wc, int fr, int fq) const {
        typedef unsigned u32x2v __attribute__((ext_vector_type(2)));
        const int row0 = u.pm * BM + wr * 64 + fr; const int col0 = u.pn * BM + wc * 32 + 4 * fq;
#pragma unroll
        for (int ai = 0; ai < 2; ++ai)
#pragma unroll
            for (int m = 0; m < 4; ++m) { const int row = row0 + ai * HALF + m * 16; const bool ok = row < mreal; float s = 0.f;
                if (ok) { float* xr = X + (size_t)row * 1024 + col0; const float* xi = (Xin ? Xin : X) + (size_t)row * 1024 + col0; bf16_t* br = XB + (size_t)row * 1024 + col0;
#pragma unroll
                    for (int bj = 0; bj < 2; ++bj)
#pragma unroll
                        for (int n = 0; n < 2; ++n) { f32x4 v = *(const f32x4*)(xi + bj * HALF + n * 16) + acc[ai][bj][m][n]; *(f32x4*)(xr + bj * HALF + n * 16) = v;
                            u32x2v w; w.x = cvt_pk_bf16(v[0], v[1]); w.y = cvt_pk_bf16(v[2], v[3]); *(u32x2v*)(br + bj * HALF + n * 16) = w;
                            s += (v[0] * v[0] + v[1] * v[1]) + (v[2] * v[2] + v[3] * v[3]); } }
                s += __shfl_xor(s, 16); s += __shfl_xor(s, 32);
                if (ok && fq == 0) __hip_atomic_fetch_add(ssout + row, (unsigned long long)(s * 16777216.f), __ATOMIC_RELAXED, __HIP_MEMORY_SCOPE_AGENT); }
    }
};
}

template <int MODE>
__device__ __forceinline__ void small_gemm(const bf16* A, const bf16* Bt, int K, int u, void* Ov, int ldc, const unsigned long long* ss, unsigned long long* ssout, float* X, bf16* XBo, int lane, int wave) {
    typedef unsigned u32x2v __attribute__((ext_vector_type(2)));
    const int rl = wave * 16 + (lane & 15), kq = 8 * (lane >> 4), n0 = u * 32;
    const bf16* pa = A + (size_t)rl * K + kq; const bf16* pb0 = Bt + (size_t)(n0 + (lane & 15)) * K + kq; const bf16* pb1 = pb0 + (size_t)16 * K;
    f32x4 acc0 = (f32x4){0.f, 0.f, 0.f, 0.f}, acc1 = (f32x4){0.f, 0.f, 0.f, 0.f};
    for (int k = 0; k < K; k += 256) { bf16x8 xa[8], w0[8], w1[8];
#pragma unroll
        for (int j = 0; j < 8; ++j) { xa[j] = *(const bf16x8*)(pa + k + 32 * j); w0[j] = *(const bf16x8*)(pb0 + k + 32 * j); w1[j] = *(const bf16x8*)(pb1 + k + 32 * j); }
#pragma unroll
        for (int j = 0; j < 8; ++j) { acc0 = __builtin_amdgcn_mfma_f32_16x16x32_bf16(w0[j], xa[j], acc0, 0, 0, 0); acc1 = __builtin_amdgcn_mfma_f32_16x16x32_bf16(w1[j], xa[j], acc1, 0, 0, 0); } }
    const int row = MP + rl; const int col = n0 + 4 * (lane >> 4);
    if constexpr (MODE == 3) {
        float* xr = X + (size_t)row * 1024 + col; bf16* br = XBo + (size_t)row * 1024 + col;
        const f32x4 v0 = *(const f32x4*)xr + acc0, v1 = *(const f32x4*)(xr + 16) + acc1; *(f32x4*)xr = v0; *(f32x4*)(xr + 16) = v1;
        u32x2v w; w.x = pg8::cvt_pk_bf16(v0[0], v0[1]); w.y = pg8::cvt_pk_bf16(v0[2], v0[3]); *(u32x2v*)br = w; w.x = pg8::cvt_pk_bf16(v1[0], v1[1]); w.y = pg8::cvt_pk_bf16(v1[2], v1[3]); *(u32x2v*)(br + 16) = w;
        float sq = ((v0[0] * v0[0] + v0[1] * v0[1]) + (v0[2] * v0[2] + v0[3] * v0[3])) + ((v1[0] * v1[0] + v1[1] * v1[1]) + (v1[2] * v1[2] + v1[3] * v1[3]));
        sq += __shfl_xor(sq, 16); sq += __shfl_xor(sq, 32);
        if ((lane >> 4) == 0) __hip_atomic_fetch_add(ssout + row, (unsigned long long)(sq * 16777216.f), __ATOMIC_RELAXED, __HIP_MEMORY_SCOPE_AGENT);
    } else {
        const float sc = rsqrtf((float)ss[row] * (1.f / (1024.f * 16777216.f)) + 1e-6f); f32x4 v0 = acc0 * sc, v1 = acc1 * sc;
        if constexpr (MODE == 1) {
#pragma unroll
            for (int e = 0; e < 4; ++e) { const float p = fmaxf(v0[e], 0.f), q = fmaxf(v1[e], 0.f); v0[e] = p * p; v1[e] = q * q; } }
        if constexpr (MODE == 2) { float* o = (float*)Ov + (size_t)row * ldc + col; *(f32x4*)o = v0; *(f32x4*)(o + 16) = v1; }
        else { bf16* o = (bf16*)Ov + (size_t)row * ldc + col; u32x2v w; w.x = pg8::cvt_pk_bf16(v0[0], v0[1]); w.y = pg8::cvt_pk_bf16(v0[2], v0[3]); *(u32x2v*)o = w;
            w.x = pg8::cvt_pk_bf16(v1[0], v1[1]); w.y = pg8::cvt_pk_bf16(v1[2], v1[3]); *(u32x2v*)(o + 16) = w; }
    }
}

template <int MODE>
__device__ __forceinline__ void small_gemm_sk(const bf16* A, const bf16* Bt, int K, int task, LAS float* red, void* Ov, int ldc, const unsigned long long* ss, unsigned long long* ssout, float* X, bf16* XBo, int lane, int wave, const float* XinS = nullptr) {
    typedef unsigned u32x2v __attribute__((ext_vector_type(2)));
    const int rt = task & 7, n0 = (task >> 3) * 32, kw = K >> 3, kq = 8 * (lane >> 4);
    const bf16* pa = A + (size_t)(rt * 16 + (lane & 15)) * K + wave * kw + kq; const bf16* pb0 = Bt + (size_t)(n0 + (lane & 15)) * K + wave * kw + kq; const bf16* pb1 = pb0 + (size_t)16 * K;
    f32x4 acc0 = (f32x4){0.f, 0.f, 0.f, 0.f}, acc1 = (f32x4){0.f, 0.f, 0.f, 0.f};
#pragma unroll 1
    for (int k = 0; k < kw; k += 256) { bf16x8 xa[8], w0[8], w1[8];
#pragma unroll
        for (int j = 0; j < 8; ++j) if (k + 32 * j < kw) { xa[j] = *(const bf16x8*)(pa + k + 32 * j); w0[j] = *(const bf16x8*)(pb0 + k + 32 * j); w1[j] = *(const bf16x8*)(pb1 + k + 32 * j); }
#pragma unroll
        for (int j = 0; j < 8; ++j) if (k + 32 * j < kw) { acc0 = __builtin_amdgcn_mfma_f32_16x16x32_bf16(w0[j], xa[j], acc0, 0, 0, 0); acc1 = __builtin_amdgcn_mfma_f32_16x16x32_bf16(w1[j], xa[j], acc1, 0, 0, 0); } }
    *(LAS f32x4*)(red + ((wave * 2 + 0) * 64 + lane) * 4) = acc0; *(LAS f32x4*)(red + ((wave * 2 + 1) * 64 + lane) * 4) = acc1;
    __syncthreads();
    if (wave < 2) { f32x4 v = *(const LAS f32x4*)(red + ((0 * 2 + wave) * 64 + lane) * 4);
#pragma unroll
        for (int w = 1; w < 8; ++w) v += *(const LAS f32x4*)(red + ((w * 2 + wave) * 64 + lane) * 4);
        const int row = MP + rt * 16 + (lane & 15); const int col = n0 + 16 * wave + 4 * (lane >> 4);
        if constexpr (MODE == 3) {
            float* xr = X + (size_t)row * 1024 + col; bf16* br = XBo + (size_t)row * 1024 + col;
            const float* xi = XinS ? XinS + (size_t)(rt * 16 + (lane & 15)) * 1024 + col : xr; const f32x4 o = *(const f32x4*)xi + v; *(f32x4*)xr = o;
            u32x2v w; w.x = pg8::cvt_pk_bf16(o[0], o[1]); w.y = pg8::cvt_pk_bf16(o[2], o[3]); *(u32x2v*)br = w;
            float sq = (o[0] * o[0] + o[1] * o[1]) + (o[2] * o[2] + o[3] * o[3]);
            sq += __shfl_xor(sq, 16); sq += __shfl_xor(sq, 32);
            if ((lane >> 4) == 0) __hip_atomic_fetch_add(ssout + row, (unsigned long long)(sq * 16777216.f), __ATOMIC_RELAXED, __HIP_MEMORY_SCOPE_AGENT);
        } else {
            const float sc = rsqrtf((float)ss[row] * (1.f / (1024.f * 16777216.f)) + 1e-6f); *(f32x4*)((float*)Ov + (size_t)row * ldc + col) = v * sc;
        } }
    __syncthreads();
}

__device__ __forceinline__ void q_gemm64(const bf16* XBp, const bf16* Bt, int u, float* QMo, const unsigned long long* ss, int lane, int wave) {
    const int r0 = u * 64, kq = 8 * (lane >> 4), n0 = wave * 32;
    const bf16* pa = XBp + (size_t)(r0 + (lane & 15)) * 1024 + kq; const bf16* pb0 = Bt + (size_t)(n0 + (lane & 15)) * 1024 + kq; const bf16* pb1 = pb0 + (size_t)16 * 1024;
    f32x4 acc[4][2];
#pragma unroll
    for (int m = 0; m < 4; ++m) { acc[m][0] = (f32x4){0.f, 0.f, 0.f, 0.f}; acc[m][1] = (f32x4){0.f, 0.f, 0.f, 0.f}; }
#pragma unroll 1
    for (int k = 0; k < 1024; k += 128) { bf16x8 xa[4][4], w0[4], w1[4];
#pragma unroll
        for (int j = 0; j < 4; ++j) { w0[j] = *(const bf16x8*)(pb0 + k + 32 * j); w1[j] = *(const bf16x8*)(pb1 + k + 32 * j);
#pragma unroll
            for (int m = 0; m < 4; ++m) xa[m][j] = *(const bf16x8*)(pa + (size_t)m * 16 * 1024 + k + 32 * j); }
#pragma unroll
        for (int j = 0; j < 4; ++j)
#pragma unroll
            for (int m = 0; m < 4; ++m) { acc[m][0] = __builtin_amdgcn_mfma_f32_16x16x32_bf16(w0[j], xa[m][j], acc[m][0], 0, 0, 0); acc[m][1] = __builtin_amdgcn_mfma_f32_16x16x32_bf16(w1[j], xa[m][j], acc[m][1], 0, 0, 0); } }
#pragma unroll
    for (int m = 0; m < 4; ++m) { const int row = r0 + m * 16 + (lane & 15); const float sc = rsqrtf((float)ss[row] * (1.f / (1024.f * 16777216.f)) + 1e-6f);
        float* o = QMo + (size_t)row * 256 + n0 + 4 * (lane >> 4); *(f32x4*)o = acc[m][0] * sc; *(f32x4*)(o + 16) = acc[m][1] * sc; }
}

__device__ __forceinline__ int win_map(int n) { return n < 768 ? n : (n < 784 ? n - 768 + C_GLR : n - 16); }
__device__ __forceinline__ void tr_item(const float* W, const float* g, int K, int N, bf16* WT, bool remap, LAS float* scr, int item, int lane) {
    const int nblk = (N + 63) / 64, kb = item / nblk, nb = item % nblk, k0 = 64 * kb, n0 = 64 * nb; const int nn = n0 + lane; const bool okn = nn < N;
    { float wv[64]; const float* wp = W + (size_t)k0 * N + (okn ? nn : 0);
#pragma unroll
      for (int kk = 0; kk < 64; ++kk) wv[kk] = __builtin_nontemporal_load(wp + (size_t)kk * N);
#pragma unroll
      for (int kk = 0; kk < 64; ++kk) { float w = okn ? wv[kk] : 0.f; if (g) w *= g[k0 + kk]; scr[kk * 65 + lane] = w; } }
    LDS_WAIT(); asm volatile("" ::: "memory");
#pragma unroll
    for (int j = 0; j < 8; ++j) { const int id = lane + 64 * j, n = id >> 3, c = id & 7; const LAS float* s = scr + (8 * c) * 65 + n; const int src = n0 + n;
        if (src < N) { const int dst = remap ? win_map(src) : src;
            v4u o; o.x = pk2(s[0 * 65], s[1 * 65]); o.y = pk2(s[2 * 65], s[3 * 65]); o.z = pk2(s[4 * 65], s[5 * 65]); o.w = pk2(s[6 * 65], s[7 * 65]);
            *(v4u*)(WT + (size_t)dst * K + k0 + 8 * c) = o; } }
    LDS_WAIT(); asm volatile("" ::: "memory");
}

__global__ void __launch_bounds__(NTHR, 2) mk_fwd(Args a) {
    extern __shared__ __attribute__((aligned(16))) unsigned char lds_raw[];
    LAS unsigned char* lds = (LAS unsigned char*)lds_raw;
    LAS float* L = (LAS float*)lds;
    const int tid0 = threadIdx.x, wave0 = __builtin_amdgcn_readfirstlane(tid0 >> 6);
#define TID_UNIT int tid_u = tid0; asm volatile("" : "+v"(tid_u)); const int tid = tid_u, lane = tid & 63, fr = lane & 15, fq = lane >> 4; (void)fr; (void)fq; (void)lane;
#define TID_DECL int tid_l = tid0; asm volatile("" : "+v"(tid_l)); const int tid = tid_l, lane = tid & 63, fr = lane & 15, fq = lane >> 4; (void)fr; (void)fq; (void)lane; \
    int l_l = l_it, wv_l = wave0, bid_l = bid0; unsigned char* ws = ws0; float* out = out0; asm volatile("" : "+s"(l_l), "+s"(wv_l), "+s"(bid_l), "+s"(ws), "+s"(out)); const int l = l_l, wave = wv_l, bid = bid_l; (void)l; (void)wave; (void)bid; const int vb = (G % 8 == 0) ? (bid & 7) * (G >> 3) + (bid >> 3) : bid; (void)vb; \
    unsigned long long* SS = (unsigned long long*)(ws + WS_SS); unsigned long long* SSM = SS + 12 * M; (void)SSM; \
    bf16* XB = (bf16*)(ws + WS_XB); bf16* MEMB = (bf16*)(ws + WS_MEMB); float* KVRAW = (float*)(ws + WS_KVRAW); float* QM = (float*)(ws + WS_QM); (void)XB; (void)MEMB; (void)KVRAW; (void)QM; \
    bf16* OMEM = (bf16*)(ws + WS_OMEM); bf16* HF = (bf16*)(ws + WS_HF); bf16* H = (bf16*)(ws + WS_H); bf16* OMIX = (bf16*)(ws + WS_OMIX); (void)OMEM; (void)HF; (void)H; (void)OMIX; \
    float* CUM = (float*)(ws + WS_CUM); float* U = (float*)(ws + WS_U); float* DEC = (float*)(ws + WS_DEC); bf16* HLOC = (bf16*)(ws + WS_HLOC); bf16* ACUM = (bf16*)(ws + WS_ACUM); (void)CUM; (void)U; (void)DEC; (void)HLOC; (void)ACUM; \
    bf16* WRG = (bf16*)(ws + WS_WRG); bf16* S0G = (bf16*)(ws + WS_S0); (void)WRG; (void)S0G; \
    float* HEND = (float*)(ws + WS_RGC); float* AEND = HEND + RGC_N; float* CARRY = AEND + RGC_N; (void)HEND; (void)AEND; (void)CARRY; \
    unsigned char* wl = ws + WS_W + (size_t)l * W_LAYER; (void)wl; \
    unsigned long long* ss0 = SS + (size_t)(l * 3 + 0) * M; unsigned long long* ss1 = SS + (size_t)(l * 3 + 1) * M; unsigned long long* ss2 = SS + (size_t)(l * 3 + 2) * M; unsigned long long* ssn = SS + (size_t)((l + 1) * 3) * M; (void)ss0; (void)ss1; (void)ss2; (void)ssn;
    const int G = gridDim.x, bid0 = blockIdx.x;
    unsigned char* ws0 = a.ws; float* out0 = a.out;
    int l_it = 0;
    cg::grid_group grid = cg::this_grid();
    volatile LAS unsigned* MISC = (volatile LAS unsigned*)(lds + LDS_BYTES - 64);
    if (tid0 < 16) MISC[tid0] = 0u;
    __syncthreads();
    XcdBarrier xbar = xcd_barrier_post((unsigned*)(ws0 + WS_CTL) + CW_BAR, MISC + 8);
    int ph = 0;
#define PH_ON (ph >= a.ph_lo && ph < a.ph_hi)
#if PROF_MASK
    unsigned long long t_acc = 0ull, t_prev = rt();
#define PH_PROF do { const unsigned long long now_ = rt(); const int pil_ = (ph == 1) ? 0 : ((ph - 2) % 10) + 1; if ((PROF_MASK >> pil_) & 1) t_acc += now_ - t_prev; t_prev = now_; } while (0)
#else
#define PH_PROF do { } while (0)
#endif
#if PROF_MASK
#define SUB_PROF(bit_) do { const unsigned long long now_ = rt(); if ((PROF_MASK >> (bit_)) & 1) t_acc += now_ - t_prev; t_prev = now_; } while (0)
#else
#define SUB_PROF(bit_) do { } while (0)
#endif
#define PH_NEXT do { ++ph; if (ph > a.ph_lo && ph < a.ph_hi) { for (int r_ = 0; r_ < REP_SYNC; ++r_) { if (ph == 1) grid.sync(); else xcd_barrier(xbar); } } PH_PROF; } while (0)

    if (PH_ON) { TID_DECL
        for (int rep_ = 0; rep_ < REP_P0; ++rep_) {
        LAS float* scr = L + wave * 4160;
        const int gw = bid * NWAVES + wave, NGW = G * NWAVES;
        constexpr int I_IN = 16 * 39, I_OUT = 16 * 16, I_Q = 16 * 4, I_KV = 16 * 8, I_O = 4 * 16, I_1 = 16 * 64, I_2 = 64 * 16;
        constexpr int I_L = I_IN + I_OUT + I_Q + I_KV + I_O + I_1 + I_2;
        for (int it = gw; it < DEPTH * I_L; it += NGW) {
            const int l = it / I_L; int r = it % I_L; unsigned char* wl = ws + WS_W + (size_t)l * W_LAYER;
            if (r < I_IN) { tr_item(a.in[11] + (size_t)l * D * INW, a.in[10] + l * D, D, INW, (bf16*)(wl + WO_IN), true, scr, r, lane); continue; } r -= I_IN;
            if (r < I_OUT) { tr_item(a.in[25] + (size_t)l * D * D, nullptr, D, D, (bf16*)(wl + WO_OUT), false, scr, r, lane); continue; } r -= I_OUT;
            if (r < I_Q) { tr_item(a.in[28] + (size_t)l * D * 256, a.in[26] + l * D, D, 256, (bf16*)(wl + WO_Q), false, scr, r, lane); continue; } r -= I_Q;
            if (r < I_KV) { tr_item(a.in[29] + (size_t)l * D * 512, a.in[27] + l * D, D, 512, (bf16*)(wl + WO_KV), false, scr, r, lane); continue; } r -= I_KV;
            if (r < I_O) { tr_item(a.in[32] + (size_t)l * 256 * D, nullptr, 256, D, (bf16*)(wl + WO_O), false, scr, r, lane); continue; } r -= I_O;
            if (r < I_1) { tr_item(a.in[34] + (size_t)l * D * FF, a.in[33] + l * D, D, FF, (bf16*)(wl + WO_1), false, scr, r, lane); continue; } r -= I_1;
            tr_item(a.in[35] + (size_t)l * FF * D, nullptr, FF, D, (bf16*)(wl + WO_2), false, scr, r, lane);
        }
        for (int i = bid * NTHR + tid; i < DEPTH * 112 * 128; i += G * NTHR) { const int l = i / (112 * 128), r = i % (112 * 128);
            *(v4u*)(ws + WS_W + (size_t)l * W_LAYER + WO_IN + (size_t)INW * 2048 + (size_t)r * 16) = (v4u){0u, 0u, 0u, 0u}; }
        for (int i = bid * NTHR + tid; i < DEPTH * 2 * 36864; i += G * NTHR) { const int l = i / 73728, gate = (i / 36864) & 1, r = i % 36864, blk = r / 9216, d = (r % 9216) / 96, c = r % 96;
            WRG[i] = (bf16)f2bf(a.in[gate ? 19 : 17][(size_t)l * 36864 + blk * 9216 + c * 96 + d]); }
        for (int m = gw; m < M + 512; m += NGW) {
            if (m < MR) { const float* src = m < MP ? a.in[0] + (size_t)m * D : a.in[1] + (size_t)(m - MP) * D;
                f32x4 v[4]; float s = 0.f;
#pragma unroll
                for (int j = 0; j < 4; ++j) { v[j] = ((const f32x4*)src)[lane + 64 * j]; s += (v[j].x * v[j].x + v[j].y * v[j].y) + (v[j].z * v[j].z + v[j].w * v[j].w); }
                s = wave_sum(s); if (lane == 0) SS[m] = (unsigned long long)(s * 16777216.f);
#pragma unroll
                for (int j = 0; j < 4; ++j) {
                    ((unsigned long long*)(XB + (size_t)m * D))[lane + 64 * j] = (unsigned long long)pk2(v[j].x, v[j].y) | ((unsigned long long)pk2(v[j].z, v[j].w) << 32); }
            } else if (m < M) {
#pragma unroll
                for (int j = 0; j < 4; ++j) ((unsigned long long*)(XB + (size_t)m * D))[lane + 64 * j] = 0ull;
            } else { const int r = m - M; const float* src = a.in[2] + (size_t)r * D; f32x4 v[4]; float s = 0.f;
#pragma unroll
                for (int j = 0; j < 4; ++j) { v[j] = ((const f32x4*)src)[lane + 64 * j]; s += (v[j].x * v[j].x + v[j].y * v[j].y) + (v[j].z * v[j].z + v[j].w * v[j].w); }
                s = wave_sum(s); if (lane == 0) SSM[r] = (unsigned long long)(s * 16777216.f);
#pragma unroll
                for (int j = 0; j < 4; ++j) ((unsigned long long*)(MEMB + (size_t)r * D))[lane + 64 * j] = (unsigned long long)pk2(v[j].x, v[j].y) | ((unsigned long long)pk2(v[j].z, v[j].w) << 32);
            }
        }
        }
        __syncthreads();
    }
    PH_NEXT;

#pragma unroll 1
    for (l_it = 0; l_it < DEPTH; ++l_it) {
        if (PH_ON) { TID_DECL
            for (int rep_ = 0; rep_ < REP_G1; ++rep_)
            { pg8::Gemm g{XB, (const bf16*)(wl + WO_IN), MP, HW, D}; pg8::StaticOrder S; S.init(MP, HW, G, bid);
              pg8::EpiScaleBf16<0> E{H, HW, ss0};
              pg8::gemm_phase<pg8::EpiScaleBf16<0>, pg8::StaticOrder, true, true>(lds, g, S, E);
              for (int u = G - 1 - bid; u < HW / 32; u += G) small_gemm<0>(XB + (size_t)MP * D, (const bf16*)(wl + WO_IN), D, u, H, HW, ss0, nullptr, nullptr, nullptr, lane, wave); }
            if (l == 0) { const int rb = G - 1 - bid; const int lw = rb >> 2; const int c = (lw < DEPTH) ? (rb & 3) : 1000000; const int lwc = lw < DEPTH ? lw : 0;
              __syncthreads();
              pg8::Gemm g{MEMB, (const bf16*)(ws + WS_W + (size_t)lwc * W_LAYER + WO_KV), 512, 512, D}; pg8::StaticOrder S; S.init(512, 512, G, c);
              pg8::EpiScaleF32 E{KVRAW + (size_t)lwc * 512 * 512, 512, SSM};
              pg8::gemm_phase<pg8::EpiScaleF32, pg8::StaticOrder, true, true>(lds, g, S, E); }
            __syncthreads();
        }
        PH_NEXT;
        if (PH_ON) { TID_DECL
            const float* gk_ = a.in[23] + l * 64; const float* gq_ = a.in[22] + l * 64;
            {
                TID_UNIT
                LAS bf16* Kb = (LAS bf16*)lds; LAS bf16* Vt = (LAS bf16*)(lds + 27648); LAS bf16* Qb = (LAS bf16*)(lds + 53248); LAS float* S = (LAS float*)(lds + 71680);
                for (int u = bid; u < 512; u += G) {
                    const int b = u >> 8, qb = (u >> 1) & 127, kv = u & 1, t0 = qb * 64;
                    const bool lastblk = t0 >= T - 128;
                    v4u raw[8];
#pragma unroll
                    for (int i = 0; i < 8; ++i) { const int v = tid + NTHR * i; size_t row; int col;
                        if (i >= 6) { const int j = (v - 3072) >> 3, c = v & 7; row = (size_t)b * T + t0 + (j & 63); col = C_SQ + (kv * 2 + (j >> 6)) * 64 + c * 8; }
                        else { const int vv_ = i < 3 ? v : v - 1536; const int j = vv_ >> 3, c = vv_ & 7; const int sp = t0 - 128 + j; row = (size_t)b * T + (sp >= 0 ? sp : 0); col = (i < 3 ? C_SK : C_SV) + kv * 64 + c * 8; }
                        raw[i] = *(const v4u*)(H + row * HW + col); }
#pragma unroll
                    for (int i = 0; i < 8; ++i) { const int v = tid + NTHR * i;
                        if (i < 3 || i >= 6) {
                            const bool isq = i >= 6; const int vv_ = isq ? v - 3072 : v; const int j = vv_ >> 3, c = vv_ & 7; const int sp = t0 - 128 + j;
                            v4u rw = raw[i]; if (!isq && sp < 0) rw = (v4u){0u, 0u, 0u, 0u};
                            float x[8];
#pragma unroll
                            for (int e = 0; e < 4; ++e) { x[2 * e] = __uint_as_float(rw[e] << 16); x[2 * e + 1] = __uint_as_float(rw[e] & 0xffff0000u); }
                            float ssq = 0.f;
#pragma unroll
                            for (int e = 0; e < 8; ++e) ssq += x[e] * x[e];
                            ssq = sum8(ssq);
                            const float sc = rsqrtf(ssq * (1.f / 64.f) + EPS) * (isq ? 0.125f : 1.f); const float* gp = (isq ? gq_ : gk_) + c * 8;
#pragma unroll
                            for (int e = 0; e < 8; ++e) x[e] *= sc * gp[e];
                            v4u w; w.x = pg8::cvt_pk_bf16(x[0], x[1]); w.y = pg8::cvt_pk_bf16(x[2], x[3]); w.z = pg8::cvt_pk_bf16(x[4], x[5]); w.w = pg8::cvt_pk_bf16(x[6], x[7]);
                            *(LAS v4u*)((isq ? Qb : Kb) + j * 72 + c * 8) = w;
                            if (!isq && lastblk && j >= 128) { float* o = out + O_SWKP + ((size_t)(l * NB + b) * 128 + (sp - (T - 128))) * 128 + kv * 64 + c * 8;
                                *(f32x4*)o = (f32x4){x[0], x[1], x[2], x[3]}; *(f32x4*)(o + 4) = (f32x4){x[4], x[5], x[6], x[7]}; }
                        } else {
                            const int vv_ = v - 1536; const int j = vv_ >> 3, c = vv_ & 7; const int sp = t0 - 128 + j;
                            v4u rw = raw[i]; if (sp < 0) rw = (v4u){0u, 0u, 0u, 0u};
#pragma unroll
                            for (int e = 0; e < 4; ++e) { Vt[(c * 8 + 2 * e) * 200 + j] = (bf16)(rw[e] & 0xffffu); Vt[(c * 8 + 2 * e + 1) * 200 + j] = (bf16)(rw[e] >> 16); }
                            if (lastblk && j >= 128) { float* o = out + O_SWVP + ((size_t)(l * NB + b) * 128 + (sp - (T - 128))) * 128 + kv * 64 + c * 8;
                                *(f32x4*)o = (f32x4){__uint_as_float(rw[0] << 16), __uint_as_float(rw[0] & 0xffff0000u), __uint_as_float(rw[1] << 16), __uint_as_float(rw[1] & 0xffff0000u)};
                                *(f32x4*)(o + 4) = (f32x4){__uint_as_float(rw[2] << 16), __uint_as_float(rw[2] & 0xffff0000u), __uint_as_float(rw[3] << 16), __uint_as_float(rw[3] & 0xffff0000u)}; }
                        } }
                    __syncthreads();
#pragma unroll 1
                    for (int g = 0; g < 2; ++g) {
                        const float slope = exp2f(-2.f * (float)(kv * 2 + g + 1)); const float sink = a.in[24][l * 4 + kv * 2 + g];
#pragma unroll 1
                        for (int tile = wave; tile < 48; tile += 8) { const int ti = tile / 12, tj = tile % 12;
                            f32x4 acc = mmb16(Qb + (g * 64 + ti * 16) * 72, 72, Kb + tj * 16 * 72, 72, 64, (f32x4){0.f, 0.f, 0.f, 0.f}, lane);
#pragma unroll
                            for (int r = 0; r < 4; ++r) { const int i = ti * 16 + 4 * fq + r, j = tj * 16 + fr, dist = 128 + i - j, sp = t0 - 128 + j;
                                const bool ok = dist >= 0 && dist <= 128 && sp >= 0; S[i * 196 + j] = ok ? acc[r] - slope * (float)dist : -INFINITY; } }
                        __syncthreads();
#pragma unroll
                        for (int q = 0; q < 8; ++q) { const int rr = wave * 8 + q;
                            const float x0 = S[rr * 196 + lane], x1 = S[rr * 196 + 64 + lane], x2 = S[rr * 196 + 128 + lane];
                            const float mx = fmaxf(wave_max(fmaxf(fmaxf(x0, x1), x2)), sink);
                            const float e0 = __expf(x0 - mx), e1 = __expf(x1 - mx), e2 = __expf(x2 - mx); const float inv = __builtin_amdgcn_rcpf(wave_sum(e0 + e1 + e2) + __expf(sink - mx));
                            LAS bf16* pr = (LAS bf16*)(S + rr * 196); pr[lane] = (bf16)f2bf(e0 * inv); pr[64 + lane] = (bf16)f2bf(e1 * inv); pr[128 + lane] = (bf16)f2bf(e2 * inv); }
                        __syncthreads();
#pragma unroll 1
                        for (int tile = wave; tile < 16; tile += 8) { const int ti = tile >> 2, tj = tile & 3;
                            f32x4 acc = mmb16((LAS bf16*)S + ti * 16 * 392, 392, Vt + tj * 16 * 200, 200, 192, (f32x4){0.f, 0.f, 0.f, 0.f}, lane);
#pragma unroll
                            for (int r = 0; r < 4; ++r) { const int i = ti * 16 + 4 * fq + r, d = tj * 16 + fr;
                                OMIX[((size_t)b * T + t0 + i) * D + 768 + (kv * 2 + g) * 64 + d] = (bf16)f2bf(acc[r]); } }
                        __syncthreads();
                    }
                }
            }
            SUB_PROF(11);
            {
                TID_UNIT
                LAS float* xcf = (LAS float*)lds; LAS bf16* xcb = (LAS bf16*)(lds + 25600); LAS bf16* Wa = (LAS bf16*)(lds + 38912); LAS bf16* Wx = (LAS bf16*)(lds + 58880);
                LAS float* aa = (LAS float*)(lds + 78848); LAS float* bb = (LAS float*)(lds + 103680);
                LAS float* toth = xcf; LAS float* tota = xcf + 512;
                int staged_blk = -1;
                for (int uu = bid; uu < 1024; uu += G) {
                    const int b = uu >> 9, c = (uu >> 2) & 127, blk = uu & 3, t0 = c * 64; const size_t r0 = (size_t)b * T + t0;
                    const float* cw = a.in[15] + l * 4 * 384 + blk * 96; const float* cb = a.in[16] + l * 384 + blk * 96;
                    v4u cr[2][4]; rg_issue(cr, H, uu, tid);
                    if (blk != staged_blk) { staged_blk = blk; const bf16* wsrc = WRG + (size_t)l * 73728 + blk * 9216;
                        for (int v = tid; v < 2304; v += NTHR) { const int gate = v / 1152, rem = v % 1152, d = rem / 12, c8 = (rem % 12) * 8;
                            *(LAS v4u*)((gate ? Wx : Wa) + d * 104 + c8) = *(const v4u*)(wsrc + (size_t)gate * 36864 + d * 96 + c8); } }
#pragma unroll
                    for (int i = 0; i < 2; ++i) { const int it = tid + NTHR * i;
                        if (it < 768) { const int t = it / 12, c8 = (it % 12) * 8; float acc[8];
                            { const f32x4 b0 = *(const f32x4*)(cb + c8), b1 = *(const f32x4*)(cb + c8 + 4); acc[0] = b0.x; acc[1] = b0.y; acc[2] = b0.z; acc[3] = b0.w; acc[4] = b1.x; acc[5] = b1.y; acc[6] = b1.z; acc[7] = b1.w; }
#pragma unroll
                            for (int j = 0; j < 4; ++j) { const int tt = t0 + t - 3 + j;
                                v4u rw = cr[i][j]; if (tt < 0) rw = (v4u){0u, 0u, 0u, 0u};
                                const f32x4 w0 = *(const f32x4*)(cw + j * 384 + c8), w1 = *(const f32x4*)(cw + j * 384 + c8 + 4);
                                acc[0] += w0.x * __uint_as_float(rw[0] << 16); acc[1] += w0.y * __uint_as_float(rw[0] & 0xffff0000u); acc[2] += w0.z * __uint_as_float(rw[1] << 16); acc[3] += w0.w * __uint_as_float(rw[1] & 0xffff0000u);
                                acc[4] += w1.x * __uint_as_float(rw[2] << 16); acc[5] += w1.y * __uint_as_float(rw[2] & 0xffff0000u); acc[6] += w1.z * __uint_as_float(rw[3] << 16); acc[7] += w1.w * __uint_as_float(rw[3] & 0xffff0000u); }
                            *(LAS f32x4*)(xcf + t * 100 + c8) = (f32x4){acc[0], acc[1], acc[2], acc[3]}; *(LAS f32x4*)(xcf + t * 100 + c8 + 4) = (f32x4){acc[4], acc[5], acc[6], acc[7]};
                            v4u w; w.x = pg8::cvt_pk_bf16(acc[0], acc[1]); w.y = pg8::cvt_pk_bf16(acc[2], acc[3]); w.z = pg8::cvt_pk_bf16(acc[4], acc[5]); w.w = pg8::cvt_pk_bf16(acc[6], acc[7]);
                            *(LAS v4u*)(xcb + t * 104 + c8) = w; } }
                    __syncthreads();
#pragma unroll 1
                    for (int tile = wave; tile < 24; tile += 8) { const int ti = tile / 6, tj = tile % 6;
                        f32x4 ar = mmb16(xcb + ti * 16 * 104, 104, Wa + tj * 16 * 104, 104, 96, (f32x4){0.f, 0.f, 0.f, 0.f}, lane);
                        f32x4 ai_ = mmb16(xcb + ti * 16 * 104, 104, Wx + tj * 16 * 104, 104, 96, (f32x4){0.f, 0.f, 0.f, 0.f}, lane);
                        const int d = tj * 16 + fr, gd = blk * 96 + d; const float ba = a.in[18][l * 384 + gd], bx_ = a.in[20][l * 384 + gd], sp = softplusf_(-a.in[21][l * 384 + gd]);
#pragma unroll
                        for (int r = 0; r < 4; ++r) { const int t = ti * 16 + 4 * fq + r; const float rr = sigmoidf_(ar[r] + ba), ii = sigmoidf_(ai_[r] + bx_); const float la = -8.f * rr * sp;
                            aa[t * 97 + d] = __expf(la); bb[t * 97 + d] = sqrtf(neg_expm1_(2.f * la)) * ii * xcf[t * 100 + d]; } }
                    __syncthreads();
                    {
                        const int seg = tid / 96, d = tid % 96, gch = blk * 96 + d;
                        if (tid < 384) { float hh = 0.f, ap = 1.f;
#pragma unroll 4
                            for (int j = 0; j < 16; ++j) { const float av = aa[(seg * 16 + j) * 97 + d]; hh = av * hh + bb[(seg * 16 + j) * 97 + d]; ap *= av; }
                            toth[seg * 96 + d] = hh; tota[seg * 96 + d] = ap; }
                        __syncthreads();
                        if (tid < 384) { float hh = 0.f, ap = 1.f;
                            for (int s2 = 0; s2 < seg; ++s2) { const float ta = tota[s2 * 96 + d]; hh = ta * hh + toth[s2 * 96 + d]; ap *= ta; }
#pragma unroll 4
                            for (int j = 0; j < 16; ++j) { const float av = aa[(seg * 16 + j) * 97 + d]; hh = av * hh + bb[(seg * 16 + j) * 97 + d]; ap *= av;
                                HLOC[(r0 + seg * 16 + j) * 384 + gch] = (bf16)f2bf(hh); ACUM[(r0 + seg * 16 + j) * 384 + gch] = (bf16)f2bf(ap); }
                            if (seg == 3) { HEND[(b * 128 + c) * 384 + gch] = hh; AEND[(b * 128 + c) * 384 + gch] = ap; } }
                    }
                    __syncthreads();
                }
            }
            SUB_PROF(12);
            for (int u = 2048 + bid; u < 3072; u += G) {
                    TID_UNIT
                    const int uu = u - 2048, b = uu >> 9, c = (uu >> 2) & 127, h = uu & 3; const size_t r0 = (size_t)b * T + c * 64;
                    LAS float* glr = L; LAS float* wg = L + 1024; LAS float* bg = L + 1792; LAS float* cum = L + 1856; LAS bf16* Kt = (LAS bf16*)(lds + 19968); LAS bf16* Vt = (LAS bf16*)(lds + 26880);
                    const int kt_t = tid / 6, kt_k0 = (tid % 6) * 8;
                    v4u kraw = (v4u){0u, 0u, 0u, 0u}; if (tid < 384) kraw = *(const v4u*)(H + (r0 + kt_t) * HW + C_GK + h * 48 + kt_k0);
                    if (tid < 128) { const v4u g = *(const v4u*)(H + (r0 + (tid >> 1)) * HW + C_GLR + (tid & 1) * 8);
#pragma unroll
                        for (int e = 0; e < 4; ++e) { glr[tid * 8 + 2 * e] = __uint_as_float(g[e] << 16); glr[tid * 8 + 2 * e + 1] = __uint_as_float(g[e] & 0xffff0000u); } }
                    for (int i = tid; i < 768; i += NTHR) wg[i] = a.in[12][l * 3072 + (i / 48) * 192 + h * 48 + (i % 48)];
                    if (tid < 48) bg[tid] = a.in[13][l * 192 + h * 48 + tid];
#pragma unroll
                    for (int i = 0; i < 2; ++i) { const int v = tid + NTHR * i; if (v < 768) { const int t = v / 12, c8 = (v % 12) * 8;
                        const v4u raw = *(const v4u*)(H + (r0 + t) * HW + C_GV + h * 96 + c8);
#pragma unroll
                        for (int e = 0; e < 4; ++e) { Vt[(c8 + 2 * e) * 72 + t] = (bf16)(raw[e] & 0xffffu); Vt[(c8 + 2 * e + 1) * 72 + t] = (bf16)(raw[e] >> 16); } } }
                    __syncthreads();
                    for (int tile = wave; tile < 12; tile += 8) { const int ti = tile / 3, tj = tile % 3;
                        f32x4 acc = mm16(glr + ti * 16 * 16, 16, 1, wg + tj * 16, 48, 1, 16, (f32x4){0.f, 0.f, 0.f, 0.f}, lane); const float bz = bg[tj * 16 + fr];
#pragma unroll
                        for (int r = 0; r < 4; ++r) cum[(ti * 16 + 4 * fq + r) * 49 + tj * 16 + fr] = logsigf_(acc[r] + bz) * (1.f / 16.f); }
                    __syncthreads();
                    if (tid < 48) { float s = 0.f;
#pragma unroll 1
                        for (int tb = 0; tb < 64; tb += 16) { float cv_[16];
#pragma unroll
                            for (int j = 0; j < 16; ++j) cv_[j] = cum[(tb + j) * 49 + tid];
#pragma unroll
                            for (int j = 0; j < 16; ++j) { s += cv_[j]; cum[(tb + j) * 49 + tid] = s; } } }
                    __syncthreads();
                    if (tid < 384) { float cu[8], kt[8];
#pragma unroll
                        for (int e = 0; e < 8; ++e) cu[e] = cum[kt_t * 49 + kt_k0 + e];
                        *(f32x4*)(CUM + (r0 + kt_t) * 192 + h * 48 + kt_k0) = (f32x4){cu[0], cu[1], cu[2], cu[3]}; *(f32x4*)(CUM + (r0 + kt_t) * 192 + h * 48 + kt_k0 + 4) = (f32x4){cu[4], cu[5], cu[6], cu[7]};
#pragma unroll
                        for (int e = 0; e < 4; ++e) { kt[2 * e] = __uint_as_float(kraw[e] << 16) * __expf(cum[63 * 49 + kt_k0 + 2 * e] - cu[2 * e]); kt[2 * e + 1] = __uint_as_float(kraw[e] & 0xffff0000u) * __expf(cum[63 * 49 + kt_k0 + 2 * e + 1] - cu[2 * e + 1]); }
#pragma unroll
                        for (int e = 0; e < 8; ++e) Kt[(kt_k0 + e) * 72 + kt_t] = (bf16)f2bf(kt[e]); }
                    if (tid < 48) DEC[((b * 128 + c) * 4 + h) * 48 + tid] = __expf(cum[63 * 49 + tid]);
                    __syncthreads();
                    float* Ub = U + ((size_t)(b * 128 + c) * 4 + h) * 4608;
                    for (int tile = wave; tile < 18; tile += 8) { const int ti = tile / 6, tj = tile % 6;
                        f32x4 acc = mmb16(Kt + ti * 16 * 72, 72, Vt + tj * 16 * 72, 72, 64, (f32x4){0.f, 0.f, 0.f, 0.f}, lane);
#pragma unroll
                        for (int r = 0; r < 4; ++r) Ub[(ti * 16 + 4 * fq + r) * 96 + tj * 16 + fr] = acc[r]; }
                    __syncthreads();
            }
            SUB_PROF(13);
            for (int u2 = bid; u2 < 2 * NS; u2 += G) {
                    TID_UNIT
                    const int n = u2 >> 1, part = u2 & 1; const size_t row = (size_t)MP + n; const size_t ln = (size_t)l * NS + n;
                    LAS float* hrow = L; LAS float* eg = L + 2560; LAS float* qk = L + 2752; LAS float* og = L + 2760; LAS float* xcs = L + 3144; LAS float* qn = L + 3528; LAS float* knew = L + 3784;
                    LAS float* vnew = L + 3912; LAS float* sc = L + 4040; LAS float* red = L + 4600;
                    for (int i = tid; i < INW; i += NTHR) hrow[i] = bf2f(H[row * HW + i]);
                    __syncthreads();
                    const float qscale = 0.14433756729740643f;
                    if (part == 0 && tid < 192) { float z = a.in[13][l * 192 + tid];
#pragma unroll
                        for (int j = 0; j < 16; ++j) z += hrow[C_GLR + j] * a.in[12][l * 3072 + j * 192 + tid];
                        eg[tid] = __expf(logsigf_(z) * (1.f / 16.f)); }
                    if (part == 0 && wave < 4) { float p = lane < 48 ? hrow[C_GQ + wave * 48 + lane] * qscale * hrow[C_GK + wave * 48 + lane] : 0.f; p = wave_sum(p); if (lane == 0) qk[wave] = p; }
                    else if (part == 1 && wave >= 4) { const int hq = wave - 4; const float qx = hrow[C_SQ + hq * 64 + lane]; const float ssq = wave_sum(qx * qx); qn[hq * 64 + lane] = qx * rsqrtf(ssq * (1.f / 64.f) + EPS) * gq_[lane] * 0.125f; }
                    __syncthreads();
                    if (part == 1 && wave < 2) { const float kx = hrow[C_SK + wave * 64 + lane]; const float ssq = wave_sum(kx * kx); knew[wave * 64 + lane] = kx * rsqrtf(ssq * (1.f / 64.f) + EPS) * gk_[lane]; vnew[wave * 64 + lane] = hrow[C_SV + wave * 64 + lane]; }
                    if (part == 0 && tid >= 128 && tid < 512) { const int e = tid - 128, h = e / 96, v = e % 96; const float* S0 = a.in[3] + (ln * 4 + h) * 4608; float* So = out + O_GLAS + (ln * 4 + h) * 4608;
                        const float vvv = hrow[C_GV + e]; float o = qk[h] * vvv;
#pragma unroll 1
                        for (int kb = 0; kb < 48; kb += 16) { float sv[16];
#pragma unroll
                            for (int j = 0; j < 16; ++j) sv[j] = __builtin_nontemporal_load(S0 + (kb + j) * 96 + v);
#pragma unroll
                            for (int j = 0; j < 16; ++j) { const int k = kb + j; const float s0 = sv[j], e_ = eg[h * 48 + k]; o += hrow[C_GQ + h * 48 + k] * qscale * e_ * s0; __builtin_nontemporal_store(e_ * s0 + hrow[C_GK + h * 48 + k] * vvv, So + k * 96 + v); } }
                        og[e] = o; }
                    __syncthreads();
                    if (part == 0 && wave < 4) { const int h = wave; const float x0 = og[h * 96 + lane], x1 = lane < 32 ? og[h * 96 + 64 + lane] : 0.f; const float ssq = wave_sum(x0 * x0 + x1 * x1); const float rs = rsqrtf(ssq * (1.f / 96.f) + EPS);
                        OMIX[row * D + h * 96 + lane] = (bf16)f2bf(x0 * rs * a.in[14][l * 96 + lane] * siluf_(hrow[C_GOG + h * 96 + lane]));
                        if (lane < 32) OMIX[row * D + h * 96 + 64 + lane] = (bf16)f2bf(x1 * rs * a.in[14][l * 96 + 64 + lane] * siluf_(hrow[C_GOG + h * 96 + 64 + lane])); }
                    if (part == 0 && tid >= 128 && tid < 512) { const int ch = tid - 128; const float* cw = a.in[15] + l * 4 * 384; const float* bufp = a.in[5] + ln * 3 * 384;
                        const float b0 = bufp[ch], b1 = bufp[384 + ch], b2 = bufp[768 + ch], rx = hrow[C_RX + ch];
                        xcs[ch] = a.in[16][l * 384 + ch] + cw[ch] * b0 + cw[384 + ch] * b1 + cw[768 + ch] * b2 + cw[1152 + ch] * rx;
                        float* co = out + O_RGCS + ln * 3 * 384; co[ch] = b1; co[384 + ch] = b2; co[768 + ch] = rx; }
                    __syncthreads();
                    if (part == 0 && tid < 384) { const int ch = tid, blk = ch / 96, d = ch % 96; const float* wsa = a.in[17] + (size_t)l * 36864 + blk * 9216 + d; const float* wsx = a.in[19] + (size_t)l * 36864 + blk * 9216 + d;
                        float ra = a.in[18][l * 384 + ch], rxx = a.in[20][l * 384 + ch];
#pragma unroll 1
                        for (int cb_ = 0; cb_ < 96; cb_ += 16) { float wa_[16], wx_[16];
#pragma unroll
                            for (int j = 0; j < 16; ++j) { wa_[j] = wsa[(cb_ + j) * 96]; wx_[j] = wsx[(cb_ + j) * 96]; }
#pragma unroll
                            for (int j = 0; j < 16; ++j) { const float xv = xcs[blk * 96 + cb_ + j]; ra += xv * wa_[j]; rxx += xv * wx_[j]; } }
                        const float rr = sigmoidf_(ra), ii = sigmoidf_(rxx); const float la = -8.f * rr * softplusf_(-a.in[21][l * 384 + ch]);
                        const float hv = __expf(la) * a.in[4][ln * 384 + ch] + sqrtf(neg_expm1_(2.f * la)) * ii * xcs[ch];
                        out[O_RGHS + ln * 384 + ch] = hv; OMIX[row * D + 384 + ch] = (bf16)f2bf(hv * gelu_tanh(hrow[C_RY + ch])); }
                    if (part == 1) { typedef float f32x2v __attribute__((ext_vector_type(2)));
                      const int kvh = lane >> 5, dd = (lane & 31) * 2; const float* ck = a.in[6] + ln * 128 * 128; const float* cv = a.in[7] + ln * 128 * 128;
                      float* ko = out + O_SWKS + ln * 128 * 128; float* vo = out + O_SWVS + ln * 128 * 128;
                      const float q00 = qn[(kvh * 2) * 64 + dd], q01 = qn[(kvh * 2) * 64 + dd + 1], q10 = qn[(kvh * 2 + 1) * 64 + dd], q11 = qn[(kvh * 2 + 1) * 64 + dd + 1];
                      const float sl0 = exp2f(-2.f * (float)(kvh * 2 + 1)), sl1 = exp2f(-2.f * (float)(kvh * 2 + 2));
#pragma unroll 1
                      for (int ib = 0; ib < 17; ib += 8) { f32x2v kr[8];
#pragma unroll
                          for (int jj = 0; jj < 8; ++jj) { const int j = (tid >> 6) + 8 * (ib + jj); kr[jj] = (f32x2v){0.f, 0.f}; if (j < 128) kr[jj] = __builtin_nontemporal_load((const f32x2v*)(ck + j * 128 + lane * 2)); else if (j == 128) { kr[jj].x = knew[lane * 2]; kr[jj].y = knew[lane * 2 + 1]; } }
#pragma unroll
                          for (int jj = 0; jj < 8; ++jj) { const int j = (tid >> 6) + 8 * (ib + jj);
                              if (j >= 1 && j < 129) __builtin_nontemporal_store(kr[jj], (f32x2v*)(ko + (j - 1) * 128 + lane * 2));
                              float s0 = kr[jj].x * q00 + kr[jj].y * q01, s1 = kr[jj].x * q10 + kr[jj].y * q11;
                              s0 = sum32_hi(s0); s1 = sum32_hi(s1);
                              const float dist = (float)(128 - j);
                              if ((lane & 31) == 16 && j < 129) { sc[(kvh * 2) * 132 + j] = s0 - sl0 * dist; sc[(kvh * 2 + 1) * 132 + j] = s1 - sl1 * dist; } }
                      }
                      __syncthreads();
                      if (wave < 4) { const int h = wave; const float sink = a.in[24][l * 4 + h]; const float x0 = sc[h * 132 + lane], x1 = sc[h * 132 + 64 + lane], x2 = lane == 0 ? sc[h * 132 + 128] : -INFINITY;
                          const float mx = fmaxf(wave_max(fmaxf(fmaxf(x0, x1), x2)), sink); const float e0 = __expf(x0 - mx), e1 = __expf(x1 - mx), e2 = __expf(x2 - mx);
                          const float inv = 1.f / (wave_sum(e0 + e1 + e2) + __expf(sink - mx)); sc[h * 132 + lane] = e0 * inv; sc[h * 132 + 64 + lane] = e1 * inv; if (lane == 0) sc[h * 132 + 128] = e2 * inv; }
                      __syncthreads();
                      float a00 = 0.f, a01 = 0.f, a10 = 0.f, a11 = 0.f;
#pragma unroll 1
                      for (int ib = 0; ib < 17; ib += 8) { f32x2v vr[8];
#pragma unroll
                          for (int jj = 0; jj < 8; ++jj) { const int j = (tid >> 6) + 8 * (ib + jj); vr[jj] = (f32x2v){0.f, 0.f}; if (j < 128) vr[jj] = __builtin_nontemporal_load((const f32x2v*)(cv + j * 128 + lane * 2)); else if (j == 128) { vr[jj].x = vnew[lane * 2]; vr[jj].y = vnew[lane * 2 + 1]; } }
#pragma unroll
                          for (int jj = 0; jj < 8; ++jj) { const int j = (tid >> 6) + 8 * (ib + jj);
                              if (j >= 1 && j < 129) __builtin_nontemporal_store(vr[jj], (f32x2v*)(vo + (j - 1) * 128 + lane * 2));
                              if (j < 129) { const float p0 = sc[(kvh * 2) * 132 + j], p1 = sc[(kvh * 2 + 1) * 132 + j]; a00 += p0 * vr[jj].x; a01 += p0 * vr[jj].y; a10 += p1 * vr[jj].x; a11 += p1 * vr[jj].y; } } }
                      red[wave * 256 + (kvh * 2) * 64 + dd] = a00; red[wave * 256 + (kvh * 2) * 64 + dd + 1] = a01; red[wave * 256 + (kvh * 2 + 1) * 64 + dd] = a10; red[wave * 256 + (kvh * 2 + 1) * 64 + dd + 1] = a11;
                      __syncthreads();
                      if (tid < 256) { float s = 0.f;
#pragma unroll
                          for (int w = 0; w < 8; ++w) s += red[w * 256 + tid];
                          OMIX[row * D + 768 + tid] = (bf16)f2bf(s); }
                      __syncthreads(); }
            }
            if (l == 0) {
                for (int w = bid * NWAVES + wave; w < DEPTH * 512 * 4; w += G * NWAVES) { const int lw = w / 2048, row = (w >> 2) & 511, h = w & 3;
                    const float kx = KVRAW[((size_t)lw * 512 + row) * 512 + h * 64 + lane], vx = KVRAW[((size_t)lw * 512 + row) * 512 + 256 + h * 64 + lane];
                    const float ssq = wave_sum(kx * kx); const size_t o = ((size_t)lw * 512 + row) * 256 + h * 64 + lane;
                    out[O_MEMK + o] = kx * rsqrtf(ssq * (1.f / 64.f) + EPS) * a.in[31][lw * 64 + lane]; out[O_MEMV + o] = vx; }
            }
        }
        PH_NEXT;
        if (PH_ON) { TID_DECL
            for (int gr = wave * G + bid; gr < 588; gr += G * NWAVES) { const int e = gr * 64 + lane;
                if (e < 36864) { const int b = e / 18432, rem = e % 18432, hk = rem / 96; float S = 0.f;
                    const float* __restrict__ Ub = U + (size_t)b * 128 * 18432 + rem; bf16* __restrict__ Sb = S0G + (size_t)b * 128 * 18432 + rem; const float* __restrict__ Db = DEC + (size_t)b * 128 * 192 + hk;
#pragma unroll 1
                    for (int c0 = 0; c0 < 128; c0 += 16) { float uv[16], dv[16];
#pragma unroll
                        for (int j = 0; j < 16; ++j) { uv[j] = Ub[(size_t)(c0 + j) * 18432]; dv[j] = Db[(c0 + j) * 192]; }
#pragma unroll
                        for (int j = 0; j < 16; ++j) { Sb[(size_t)(c0 + j) * 18432] = (bf16)f2bf(S); S = dv[j] * S + uv[j]; } }
                    out[O_GLAP + (size_t)(l * NB + b) * 18432 + rem] = S;
                } else { const int q = e - 36864, b = q / 384, ch = q % 384; float cr = 0.f;
#pragma unroll 1
                    for (int c0 = 0; c0 < 128; c0 += 16) { float hv[16], av[16];
#pragma unroll
                        for (int j = 0; j < 16; ++j) { hv[j] = HEND[(b * 128 + c0 + j) * 384 + ch]; av[j] = AEND[(b * 128 + c0 + j) * 384 + ch]; }
#pragma unroll
                        for (int j = 0; j < 16; ++j) { CARRY[(b * 128 + c0 + j) * 384 + ch] = cr; cr = av[j] * cr + hv[j]; } }
                    out[O_RGHP + (size_t)(l * NB + b) * 384 + ch] = cr;
#pragma unroll
                    for (int j = 0; j < 3; ++j) out[O_RGCP + ((size_t)(l * NB + b) * 3 + j) * 384 + ch] = bf2f(H[((size_t)b * T + T - 3 + j) * HW + C_RX + ch]);
                }
            }
        }
        PH_NEXT;
        if (PH_ON) { TID_DECL
            for (int u = bid; u < 1024; u += G) {
                const int b = u >> 9, c = (u >> 2) & 127, h = u & 3; const size_t r0 = (size_t)b * T + c * 64;
                LAS bf16* qeb = (LAS bf16*)lds; LAS bf16* keb = (LAS bf16*)(lds + 9216); LAS bf16* Ab = (LAS bf16*)(lds + 18432); LAS bf16* Vt = (LAS bf16*)(lds + 27648); LAS bf16* S0t = (LAS bf16*)(lds + 41472);
                LAS float* o = (LAS float*)(lds + 55296);
                const bf16* Ub = S0G + ((size_t)(b * 128 + c) * 4 + h) * 4608;
                float gg0[8], gg1[8];
#pragma unroll
                for (int q = 0; q < 8; ++q) { const bf16* gp = H + (r0 + (tid >> 6) * 8 + q) * HW + C_GOG + h * 96; gg0[q] = bf2f(gp[lane]); gg1[q] = bf2f(gp[64 + (lane & 31)]); }
                if (tid < 384) { const int t = tid / 6, k0 = (tid % 6) * 8;
                    const v4u qr = *(const v4u*)(H + (r0 + t) * HW + C_GQ + h * 48 + k0), kr = *(const v4u*)(H + (r0 + t) * HW + C_GK + h * 48 + k0);
                    const f32x4 c0 = *(const f32x4*)(CUM + (r0 + t) * 192 + h * 48 + k0), c1 = *(const f32x4*)(CUM + (r0 + t) * 192 + h * 48 + k0 + 4);
                    float cu[8] = {c0.x, c0.y, c0.z, c0.w, c1.x, c1.y, c1.z, c1.w}; float qe[8], ke[8];
#pragma unroll
                    for (int e = 0; e < 4; ++e) { const float q0 = __uint_as_float(qr[e] << 16), q1 = __uint_as_float(qr[e] & 0xffff0000u), k0_ = __uint_as_float(kr[e] << 16), k1_ = __uint_as_float(kr[e] & 0xffff0000u);
                        const float e0 = __expf(cu[2 * e]), e1 = __expf(cu[2 * e + 1]);
                        qe[2 * e] = q0 * 0.14433756729740643f * e0; qe[2 * e + 1] = q1 * 0.14433756729740643f * e1; ke[2 * e] = k0_ / e0; ke[2 * e + 1] = k1_ / e1; }
                    v4u w; w.x = pg8::cvt_pk_bf16(qe[0], qe[1]); w.y = pg8::cvt_pk_bf16(qe[2], qe[3]); w.z = pg8::cvt_pk_bf16(qe[4], qe[5]); w.w = pg8::cvt_pk_bf16(qe[6], qe[7]); *(LAS v4u*)(qeb + t * 72 + k0) = w;
                    w.x = pg8::cvt_pk_bf16(ke[0], ke[1]); w.y = pg8::cvt_pk_bf16(ke[2], ke[3]); w.z = pg8::cvt_pk_bf16(ke[4], ke[5]); w.w = pg8::cvt_pk_bf16(ke[6], ke[7]); *(LAS v4u*)(keb + t * 72 + k0) = w;
                } else {
                    for (int i = tid - 384; i < 448; i += 128) { LAS bf16* base = i < 128 ? qeb : (i < 256 ? keb : S0t); const int r = i < 128 ? i : (i < 256 ? i - 128 : i - 256);
                        *(LAS v4u*)(base + (r >> 1) * 72 + 48 + (r & 1) * 8) = (v4u){0u, 0u, 0u, 0u}; } }
#pragma unroll
                for (int i = 0; i < 2; ++i) { const int v = tid + NTHR * i; if (v < 768) { const int t = v / 12, c8 = (v % 12) * 8;
                    const v4u raw = *(const v4u*)(H + (r0 + t) * HW + C_GV + h * 96 + c8);
#pragma unroll
                    for (int e = 0; e < 4; ++e) { Vt[(c8 + 2 * e) * 72 + t] = (bf16)(raw[e] & 0xffffu); Vt[(c8 + 2 * e + 1) * 72 + t] = (bf16)(raw[e] >> 16); } } }
#pragma unroll
                for (int i = 0; i < 3; ++i) { const int idx = tid + NTHR * i; if (idx < 1152) { const int k = idx / 24, v4 = (idx % 24) * 4;
                    typedef unsigned u32x2v __attribute__((ext_vector_type(2))); const u32x2v sv = *(const u32x2v*)(Ub + k * 96 + v4);
                    S0t[(v4 + 0) * 72 + k] = (bf16)(sv.x & 0xffffu); S0t[(v4 + 1) * 72 + k] = (bf16)(sv.x >> 16); S0t[(v4 + 2) * 72 + k] = (bf16)(sv.y & 0xffffu); S0t[(v4 + 3) * 72 + k] = (bf16)(sv.y >> 16); } }
                __syncthreads();
                for (int tile = wave; tile < 16; tile += 8) { const int ti = tile >> 2, tj = tile & 3; f32x4 acc = (f32x4){0.f, 0.f, 0.f, 0.f};
                    if (tj <= ti) acc = mmb16(qeb + ti * 16 * 72, 72, keb + tj * 16 * 72, 72, 64, acc, lane);
#pragma unroll
                    for (int r = 0; r < 4; ++r) { const int tr = ti * 16 + 4 * fq + r, sc_ = tj * 16 + fr; Ab[tr * 72 + sc_] = (bf16)f2bf((sc_ <= tr) ? acc[r] : 0.f); } }
                __syncthreads();
                for (int tile = wave; tile < 24; tile += 8) { const int ti = tile / 6, tj = tile % 6;
                    f32x4 acc = mmb16(qeb + ti * 16 * 72, 72, S0t + tj * 16 * 72, 72, 64, (f32x4){0.f, 0.f, 0.f, 0.f}, lane);
                    acc = mmb16(Ab + ti * 16 * 72, 72, Vt + tj * 16 * 72, 72, 64, acc, lane);
#pragma unroll
                    for (int r = 0; r < 4; ++r) o[(ti * 16 + 4 * fq + r) * 98 + tj * 16 + fr] = acc[r]; }
                __syncthreads();
                const float go0 = a.in[14][l * 96 + lane], go1 = a.in[14][l * 96 + 64 + (lane & 31)];
#pragma unroll
                for (int q = 0; q < 8; ++q) { const int t = wave * 8 + q; const float x0 = o[t * 98 + lane], x1 = lane < 32 ? o[t * 98 + 64 + lane] : 0.f;
                    const float rs = rsqrtf(wave_sum(x0 * x0 + x1 * x1) * (1.f / 96.f) + EPS);
                    OMIX[(r0 + t) * D + h * 96 + lane] = (bf16)f2bf(x0 * rs * go0 * siluf_(gg0[q]));
                    if (lane < 32) OMIX[(r0 + t) * D + h * 96 + 64 + lane] = (bf16)f2bf(x1 * rs * go1 * siluf_(gg1[q])); }
                __syncthreads();
            }
            SUB_PROF(14);
            for (int e4 = bid * NTHR + tid; e4 < MP * 96; e4 += G * NTHR) { const int row = e4 / 96, ch = (e4 % 96) * 4; const int bc = row >> 6;
                typedef unsigned u32x2v __attribute__((ext_vector_type(2)));
                const u32x2v hlr = *(const u32x2v*)(HLOC + (size_t)row * 384 + ch), acr = *(const u32x2v*)(ACUM + (size_t)row * 384 + ch); const f32x4 cr = *(const f32x4*)(CARRY + (size_t)bc * 384 + ch);
                const f32x4 hl = (f32x4){__uint_as_float(hlr.x << 16), __uint_as_float(hlr.x & 0xffff0000u), __uint_as_float(hlr.y << 16), __uint_as_float(hlr.y & 0xffff0000u)}, ac = (f32x4){__uint_as_float(acr.x << 16), __uint_as_float(acr.x & 0xffff0000u), __uint_as_float(acr.y << 16), __uint_as_float(acr.y & 0xffff0000u)};
                const u32x2v ry = *(const u32x2v*)(H + (size_t)row * HW + C_RY + ch);
                const f32x4 hv = hl + ac * cr;
                u32x2v w; w.x = pg8::cvt_pk_bf16(hv.x * gelu_tanh(__uint_as_float(ry.x << 16)), hv.y * gelu_tanh(__uint_as_float(ry.x & 0xffff0000u)));
                w.y = pg8::cvt_pk_bf16(hv.z * gelu_tanh(__uint_as_float(ry.y << 16)), hv.w * gelu_tanh(__uint_as_float(ry.y & 0xffff0000u)));
                *(u32x2v*)(OMIX + (size_t)row * D + 384 + ch) = w; }
        }
        PH_NEXT;
        if (PH_ON) { TID_DECL
            pg8::Gemm g{OMIX, (const bf16*)(wl + WO_OUT), MP, D, D}; pg8::StaticOrder S; S.init(MP, D, G, bid);
            pg8::EpiResid E{out, XB, ss1, MR, l == 0 ? a.in[0] : nullptr};
            pg8::gemm_phase<pg8::EpiResid, pg8::StaticOrder, true, true>(lds, g, S, E);
            for (int u = G - 1 - bid; u < 256; u += G) small_gemm_sk<3>(OMIX + (size_t)MP * D, (const bf16*)(wl + WO_OUT), D, u, L, nullptr, 0, nullptr, ss1, out, XB, lane, wave, l == 0 ? a.in[1] : nullptr);
            __syncthreads();
        }
        PH_NEXT;
        if (PH_ON) { TID_DECL
            for (int rep_ = 0; rep_ < REP_G6; ++rep_) {
            pg8::Gemm g{XB, (const bf16*)(wl + WO_Q), MP, 256, D}; pg8::StaticOrder S; S.init(MP, 256, G, bid);
            pg8::EpiScaleF32 E{QM, 256, ss1};
            pg8::gemm_phase<pg8::EpiScaleF32, pg8::StaticOrder, true, true>(lds, g, S, E);
            for (int u = G - 1 - bid; u < 64; u += G) small_gemm_sk<2>(XB + (size_t)MP * D, (const bf16*)(wl + WO_Q), D, u, L, QM, 256, ss1, nullptr, nullptr, nullptr, lane, wave);
            __syncthreads(); }
            __syncthreads();
        }
        PH_NEXT;
        if (PH_ON) { TID_DECL
            const float* gmq = a.in[30] + l * 64;
            int staged_bh = -1;
            for (int u = bid; u < 1024 + 2 * NS; u += G) {
                if (u < 1024) { int b = u >> 9, rb = (u >> 2) & 127, h = u & 3; if (G == 256) { const int k_ = u >> 8, w_ = u & 255; b = w_ >> 7; h = w_ & 3; rb = ((w_ >> 2) & 31) * 4 + k_; }     const size_t r0 = (size_t)b * T + rb * 64;
                    LAS bf16* Kb = (LAS bf16*)lds; LAS bf16* Vt = (LAS bf16*)(lds + 36864); LAS bf16* Qb = (LAS bf16*)(lds + 70656); LAS float* S = (LAS float*)(lds + 79872);
                    const float* mk = out + O_MEMK + (size_t)(l * NB + b) * 256 * 256 + h * 64; const float* mv = out + O_MEMV + (size_t)(l * NB + b) * 256 * 256 + h * 64;
                    const bool restage = (b * 4 + h) != staged_bh; staged_bh = b * 4 + h;
#pragma unroll
                    for (int i = 0; i < 2; ++i) { const int v = tid + NTHR * i; const int r = v >> 4, c4 = (v & 15) * 4;
                        f32x4 x = *(const f32x4*)(QM + (r0 + r) * 256 + h * 64 + c4); float ssq = (x.x * x.x + x.y * x.y) + (x.z * x.z + x.w * x.w);
                        ssq = sum16(ssq);
                        const float sc = rsqrtf(ssq * (1.f / 64.f) + EPS) * 0.125f; const f32x4 g4 = *(const f32x4*)(gmq + c4);
                        typedef unsigned u32x2v __attribute__((ext_vector_type(2)));
                        u32x2v w; w.x = pg8::cvt_pk_bf16(x.x * sc * g4.x, x.y * sc * g4.y); w.y = pg8::cvt_pk_bf16(x.z * sc * g4.z, x.w * sc * g4.w); *(LAS u32x2v*)(Qb + r * 72 + c4) = w; }
                    if (restage)
#pragma unroll
                    for (int i = 0; i < 8; ++i) { const int v = tid + NTHR * i; const int j = v >> 4, c4 = (v & 15) * 4;
                        const f32x4 kx = *(const f32x4*)(mk + (size_t)j * 256 + c4); const f32x4 vx = *(const f32x4*)(mv + (size_t)j * 256 + c4);
                        typedef unsigned u32x2v __attribute__((ext_vector_type(2)));
                        u32x2v w; w.x = pg8::cvt_pk_bf16(kx.x, kx.y); w.y = pg8::cvt_pk_bf16(kx.z, kx.w); *(LAS u32x2v*)(Kb + j * 72 + c4) = w;
                        Vt[(c4 + 0) * 264 + j] = (bf16)f2bf(vx.x); Vt[(c4 + 1) * 264 + j] = (bf16)f2bf(vx.y); Vt[(c4 + 2) * 264 + j] = (bf16)f2bf(vx.z); Vt[(c4 + 3) * 264 + j] = (bf16)f2bf(vx.w); }
                    __syncthreads();
                    for (int tile = wave; tile < 64; tile += 8) { const int ti = tile >> 4, tj = tile & 15;
                        f32x4 acc = mmb16(Qb + ti * 16 * 72, 72, Kb + tj * 16 * 72, 72, 64, (f32x4){0.f, 0.f, 0.f, 0.f}, lane);
#pragma unroll
                        for (int r = 0; r < 4; ++r) S[(ti * 16 + 4 * fq + r) * 260 + tj * 16 + fr] = acc[r]; }
                    __syncthreads();
#pragma unroll
                    for (int q = 0; q < 8; ++q) { const int rr = wave * 8 + q; float x[4]; float mx = -INFINITY;
#pragma unroll
                        for (int j = 0; j < 4; ++j) { x[j] = S[rr * 260 + lane + 64 * j]; mx = fmaxf(mx, x[j]); }
                        mx = wave_max(mx); float sum = 0.f;
#pragma unroll
                        for (int j = 0; j < 4; ++j) { x[j] = __expf(x[j] - mx); sum += x[j]; }
                        const float inv = 1.f / wave_sum(sum); LAS bf16* pr = (LAS bf16*)(S + rr * 260);
#pragma unroll
                        for (int j = 0; j < 4; ++j) pr[lane + 64 * j] = (bf16)f2bf(x[j] * inv); }
                    __syncthreads();
                    for (int tile = wave; tile < 16; tile += 8) { const int ti = tile >> 2, tj = tile & 3;
                      f32x4 acc = mmb16((LAS bf16*)S + ti * 16 * 520, 520, Vt + tj * 16 * 264, 264, 256, (f32x4){0.f, 0.f, 0.f, 0.f}, lane);
#pragma unroll
                      for (int r = 0; r < 4; ++r) OMEM[(r0 + ti * 16 + 4 * fq + r) * 256 + h * 64 + tj * 16 + fr] = (bf16)f2bf(acc[r]); }
                    __syncthreads();
                } else { SUB_PROF(15); TID_UNIT const int idx = u - 1024, n = idx >> 1, part = idx & 1; const size_t row = (size_t)MP + n; const size_t ln = (size_t)l * NS + n;
                    typedef float f32x2v __attribute__((ext_vector_type(2)));
                    LAS float* qn = L; LAS float* sc = L + 128; LAS float* red = L + 648;
                    if (wave < 2) { const int hq = part * 2 + wave; const float qx = QM[row * 256 + hq * 64 + lane]; const float ssq = wave_sum(qx * qx); qn[wave * 64 + lane] = qx * rsqrtf(ssq * (1.f / 64.f) + EPS) * gmq[lane] * 0.125f; }
                    __syncthreads();
                    const int hl = lane >> 5, dd = (lane & 31) * 2; const float q0 = qn[hl * 64 + dd], q1 = qn[hl * 64 + dd + 1];
                    const float* ck = a.in[8] + ln * 256 * 256 + part * 128; const float* cv = a.in[9] + ln * 256 * 256 + part * 128;
#pragma unroll 1
                    for (int ib = 0; ib < 32; ib += 16) { f32x2v kr[16];
#pragma unroll
                        for (int jj = 0; jj < 16; ++jj) kr[jj] = __builtin_nontemporal_load((const f32x2v*)(ck + (size_t)((tid >> 6) + 8 * (ib + jj)) * 256 + lane * 2));
#pragma unroll
                        for (int jj = 0; jj < 16; ++jj) { float s_ = kr[jj].x * q0 + kr[jj].y * q1; s_ = sum32_hi(s_);
                            if ((lane & 31) == 16) sc[hl * 260 + (tid >> 6) + 8 * (ib + jj)] = s_; } }
                    __syncthreads();
                    if (wave < 2) { float x[4]; float mx = -INFINITY;
#pragma unroll
                        for (int j = 0; j < 4; ++j) { x[j] = sc[wave * 260 + lane + 64 * j]; mx = fmaxf(mx, x[j]); }
                        mx = wave_max(mx); float sum = 0.f;
#pragma unroll
                        for (int j = 0; j < 4; ++j) { x[j] = __expf(x[j] - mx); sum += x[j]; }
                        const float inv = 1.f / wave_sum(sum);
#pragma unroll
                        for (int j = 0; j < 4; ++j) sc[wave * 260 + lane + 64 * j] = x[j] * inv; }
                    __syncthreads();
                    float a0 = 0.f, a1 = 0.f;
#pragma unroll 1
                    for (int ib = 0; ib < 32; ib += 16) { f32x2v vr[16];
#pragma unroll
                        for (int jj = 0; jj < 16; ++jj) vr[jj] = __builtin_nontemporal_load((const f32x2v*)(cv + (size_t)((tid >> 6) + 8 * (ib + jj)) * 256 + lane * 2));
#pragma unroll
                        for (int jj = 0; jj < 16; ++jj) { const float p_ = sc[hl * 260 + (tid >> 6) + 8 * (ib + jj)]; a0 += p_ * vr[jj].x; a1 += p_ * vr[jj].y; } }
                    red[wave * 128 + lane * 2] = a0; red[wave * 128 + lane * 2 + 1] = a1;
                    __syncthreads();
                    if (tid < 128) { float s_ = 0.f;
#pragma unroll
                        for (int w = 0; w < 8; ++w) s_ += red[w * 128 + tid];
                        OMEM[row * 256 + part * 128 + tid] = (bf16)f2bf(s_); }
                    __syncthreads();
                }
            }
        }
        PH_NEXT;
        if (PH_ON) { TID_DECL
            pg8::Gemm g{OMEM, (const bf16*)(wl + WO_O), MP, D, 256}; pg8::StaticOrder S; S.init(MP, D, G, bid);
            pg8::EpiResid E{out, XB, ss2, MR};
            pg8::gemm_phase<pg8::EpiResid, pg8::StaticOrder, true, true>(lds, g, S, E);
            for (int u = G - 1 - bid; u < 256; u += G) small_gemm_sk<3>(OMEM + (size_t)MP * 256, (const bf16*)(wl + WO_O), 256, u, L, nullptr, 0, nullptr, ss2, out, XB, lane, wave);
            __syncthreads();
        }
        PH_NEXT;
        if (PH_ON) { TID_DECL
            for (int rep_ = 0; rep_ < REP_G9; ++rep_) {
            pg8::Gemm g{XB, (const bf16*)(wl + WO_1), MP, FF, D}; pg8::StaticOrder S; S.init(MP, FF, G, bid);
            pg8::EpiScaleBf16<1> E{HF, FF, ss2};
            pg8::gemm_phase<pg8::EpiScaleBf16<1>, pg8::StaticOrder, true, true>(lds, g, S, E);
            for (int u = G - 1 - bid; u < FF / 32; u += G) small_gemm<1>(XB + (size_t)MP * D, (const bf16*)(wl + WO_1), D, u, HF, FF, ss2, nullptr, nullptr, nullptr, lane, wave);
            __syncthreads(); }
            __syncthreads();
        }
        PH_NEXT;
        if (PH_ON) { TID_DECL
            pg8::Gemm g{HF, (const bf16*)(wl + WO_2), MP, D, FF}; pg8::StaticOrder S; S.init(MP, D, G, bid);
            unsigned long long* sso = l + 1 < DEPTH ? ssn : SSM + 512;
            for (int rep_ = 1; rep_ < REP_G10; ++rep_) { pg8::Gemm g{HF, (const bf16*)(wl + WO_2), MP, D, FF}; pg8::StaticOrder S; S.init(MP, D, G, bid);
                pg8::EpiResid E{(float*)(ws + WS_DUMX), (bf16*)(ws + WS_DUMB), (unsigned long long*)(ws + WS_DUMS), MR};
                pg8::gemm_phase<pg8::EpiResid, pg8::StaticOrder, true, true>(lds, g, S, E); __syncthreads(); }
            pg8::EpiResid E{out, XB, sso, MR};
            pg8::gemm_phase<pg8::EpiResid, pg8::StaticOrder, true, true>(lds, g, S, E);
            for (int u = G - 1 - bid; u < 256; u += G) small_gemm_sk<3>(HF + (size_t)MP * FF, (const bf16*)(wl + WO_2), FF, u, L, nullptr, 0, nullptr, sso, out, XB, lane, wave);
            __syncthreads();
        }
        PH_NEXT;
    }
#if PROF_MASK
    if (blockIdx.x == 0) { const unsigned long long t_end = rt(); while (rt() - t_end < 4ull * t_acc) __builtin_amdgcn_s_sleep(16); }
#endif
}

#ifndef MK_MULTI
#define MK_MULTI 0
#endif
extern "C" void kernel_launch(void* const* d_in, const int* in_sizes, int n_in, void* d_out, int out_size, void* d_ws, size_t ws_size, hipStream_t stream) {
    static int grid = 0;
    constexpr int NPH = 1 + DEPTH * 10;
    if (grid == 0) {
        if (n_in != 36 || out_size != (int)O_END || ws_size < WS_END) { fprintf(stderr, "kernel_launch: unexpected shapes: n_in %d out %d ws %zu\n", n_in, out_size, ws_size); grid = -1; return; }
        int dev = 0, cus = 0, per_cu = 0;
        (void)hipGetDevice(&dev); (void)hipDeviceGetAttribute(&cus, hipDeviceAttributeMultiprocessorCount, dev);
        if (hipFuncSetAttribute((const void*)mk_fwd, hipFuncAttributeMaxDynamicSharedMemorySize, LDS_BYTES) != hipSuccess) { fprintf(stderr, "kernel_launch: hipFuncSetAttribute failed\n"); grid = -1; return; }
        if (hipOccupancyMaxActiveBlocksPerMultiprocessor(&per_cu, (const void*)mk_fwd, NTHR, LDS_BYTES) != hipSuccess || per_cu < 1) { fprintf(stderr, "kernel_launch: occupancy query says %d\n", per_cu); per_cu = 1; }
        (void)hipGetLastError();
        grid = cus;
        fprintf(stderr, "kernel_launch: grid %d (occupancy %d per CU)\n", grid, per_cu);
    }
    if (grid < 0) return;
    (void)hipMemsetAsync((char*)d_ws + WS_CTL, 0, CTL_ZERO_BYTES, stream);
    (void)hipMemsetAsync((char*)d_ws + WS_SS, 0, SS_BYTES, stream);
    Args a{};
    for (int i = 0; i < 36; ++i) a.in[i] = (const float*)d_in[i];
    a.out = (float*)d_out; a.ws = (unsigned char*)d_ws; a.use_cg = 0; a.pad = 0;
#if MK_MULTI
    for (int p = 0; p < NPH; ++p) { a.ph_lo = p; a.ph_hi = p + 1; hipLaunchKernelGGL(mk_fwd, dim3(grid), dim3(NTHR), LDS_BYTES, stream, a); }
#else
    a.ph_lo = 0; a.ph_hi = NPH; a.use_cg = 1;
    void* args[] = {&a};
    hipError_t e = hipLaunchCooperativeKernel((const void*)mk_fwd, dim3(grid), dim3(NTHR), args, LDS_BYTES, stream);
    if (e != hipSuccess) fprintf(stderr, "cooperative launch failed: %s (grid %d)\n", hipGetErrorString(e), grid);
#endif
}
```

```cpp
#include <hip/hip_runtime.h>
#include <hip/hip_cooperative_groups.h>
#include <cstdio>
#include <cstdint>
namespace cg = cooperative_groups;
namespace pg8 {
#define PG8_LAS __attribute__((address_space(3)))
typedef unsigned short bf16_t;
typedef short bf16x8 __attribute__((ext_vector_type(8)));
typedef float f32x4 __attribute__((ext_vector_type(4)));
typedef unsigned u32x4 __attribute__((ext_vector_type(4)));
constexpr int BM = 256, BK = 64, HALF = 128, HTB = HALF * BK * 2  , STAGE_BYTES = 8 * HTB, NXCD = 8, WGM = 8;

__host__ __device__ __forceinline__ int lds_byte(int r, int c) { const int st = (r >> 4) * 2 + (c >> 5), rr = r & 15, cc = c & 31, ob = rr * 64 + cc * 2; return st * 1024 + (ob ^ (((ob >> 9) & 1) << 5)); }
__host__ __device__ __forceinline__ void stage_rc(int b, int& R, int& C) { const int st = b / 1024, sb = b % 1024, swz = sb ^ (((sb >> 9) & 1) << 5); R = (st >> 1) * 16 + swz / 64; C = (st & 1) * 32 + (swz % 64) / 2; }
__host__ __device__ __forceinline__ int perm32(int rho) { const int n = rho >> 4, i = rho & 15; return 8 * (i >> 2) + 4 * n + (i & 3); }

struct Unit { int pm, pn; };
struct Gemm { const bf16_t* A; const bf16_t* Bt; int M, N, K; };

struct StaticOrder {
    int nM, nN, nwg, G, c;
    __host__ __device__ void init(int M, int N, int G_, int c_) { nM = M / BM; nN = N / BM; nwg = nM * nN; G = G_; c = c_; }
    __host__ __device__ bool next(int i, Unit& u) const {
        const long L = (long)i * G + c; if (L >= nwg) return false;
        int wgid = (int)L; { const int q = nwg / NXCD, r = nwg % NXCD, xcd = wgid % NXCD, off = wgid / NXCD; wgid = (xcd < r ? xcd * (q + 1) : r * (q + 1) + (xcd - r) * q) + off; }
        const int nig = WGM * nN, gid = wgid / nig, fm = gid * WGM, gsz = (nM - fm) < WGM ? (nM - fm) : WGM;
        u.pm = fm + ((wgid % nig) % gsz); u.pn = (wgid % nig) / gsz; return true;
    }
    __device__ __forceinline__ void a_ready(const Unit&) const {}
    __device__ __forceinline__ void done(const Unit&) const {}
};

__device__ __forceinline__ unsigned cvt_pk_bf16(float lo, float hi) { unsigned r; asm volatile("v_cvt_pk_bf16_f32 %0, %1, %2" : "=v"(r) : "v"(lo), "v"(hi)); return r; }
template <class Epi, class Sched, bool ALIGN_EPI = false, bool SP2 = false>
__device__ __forceinline__ void gemm_phase(PG8_LAS unsigned char* lds, const Gemm g, const Sched& S, const Epi& E) {
    int tid_l = threadIdx.x; asm volatile("" : "+v"(tid_l)); const int tid = tid_l, wid = __builtin_amdgcn_readfirstlane(tid >> 6), lane = tid & 63, wr = wid >> 2, wc = wid & 3, fr = lane & 15, fq = lane >> 4;
    const int K = g.K, nt = K / BK;
    unsigned voffA[2], voffB[2];
#pragma unroll
    for (int i = 0; i < 2; ++i) { int R, C; stage_rc(tid * 16 + i * 8192, R, C); const int Rb = Epi::PERM ? ((R & ~31) + perm32(R & 31)) : R;
        voffA[i] = (unsigned)(R * K + C) * 2u; voffB[i] = (unsigned)(Rb * K + C) * 2u; }
    const size_t kstep = (size_t)(BK * 2);
    const size_t hstep = (size_t)HALF * K * 2;
    const size_t tstep = 2 * hstep;
    const unsigned ldsw = (unsigned)wid * 1024u;
    const int aoff = lds_byte(wr * 64 + fr, fq * 8), boff = lds_byte(wc * 32 + fr, fq * 8);
#define PG8_SA(b, h) (((b) * 2 + (h)) * HTB)
#define PG8_SB(b, h) ((4 + (b) * 2 + (h)) * HTB)
#define PG8_STAGE(bufoff, gbase, voff) do { _Pragma("unroll") for (int _i = 0; _i < 2; ++_i) \
        __builtin_amdgcn_global_load_lds((const unsigned*)((const char*)(gbase) + (voff)[_i]), (PG8_LAS unsigned*)(lds + (bufoff) + ldsw + _i * 8192), 16, 0, 0); } while (0)
#define PG8_LDA(dst, b, h) do { _Pragma("unroll") for (int m = 0; m < 4; ++m) _Pragma("unroll") for (int k = 0; k < 2; ++k) dst[m][k] = *(const PG8_LAS bf16x8*)(lds + PG8_SA(b, h) + aoff + m * 2048 + k * 1024); } while (0)
#define PG8_LDB(dst, b, h) do { _Pragma("unroll") for (int n = 0; n < 2; ++n) _Pragma("unroll") for (int k = 0; k < 2; ++k) dst[n][k] = *(const PG8_LAS bf16x8*)(lds + PG8_SB(b, h) + boff + n * 2048 + k * 1024); } while (0)
#define PG8_MMA(ai, bj, At, Bt) do { __builtin_amdgcn_s_setprio(1); _Pragma("unroll") for (int m = 0; m < 4; ++m) _Pragma("unroll") for (int n = 0; n < 2; ++n) _Pragma("unroll") for (int k = 0; k < 2; ++k) \
        acc[ai][bj][m][n] = __builtin_amdgcn_mfma_f32_16x16x32_bf16(Bt[n][k], At[m][k], acc[ai][bj][m][n], 0, 0, 0); __builtin_amdgcn_s_setprio(0); } while (0)
#define PG8_WAIT_V(n) asm volatile("s_waitcnt vmcnt(" #n ")" ::: "memory")
#define PG8_WAIT_L(n) asm volatile("s_waitcnt lgkmcnt(" #n ")" ::: "memory")
#define PG8_BAR __builtin_amdgcn_s_barrier()
#define PG8_SCHED __builtin_amdgcn_sched_barrier(0)
    Unit cur, nxt; int ui = 0;
    if (!S.next(0, cur)) return;
    f32x4 acc[2][2][4][2];
#pragma unroll
    for (int a = 0; a < 2; ++a)
#pragma unroll
        for (int b = 0; b < 2; ++b)
#pragma unroll
            for (int m = 0; m < 4; ++m)
#pragma unroll
                for (int n = 0; n < 2; ++n) acc[a][b][m][n] = (f32x4){0.f, 0.f, 0.f, 0.f};
    bf16x8 At[4][2], B0[2][2], B1[2][2];
    const char* cA = (const char*)g.A + (size_t)cur.pm * tstep; const char* cB = (const char*)g.Bt + (size_t)cur.pn * tstep;
    S.a_ready(cur);
    if constexpr (SP2) {
        PG8_STAGE(PG8_SB(0, 0), cB, voffB); PG8_STAGE(PG8_SB(0, 1), cB + hstep, voffB); PG8_STAGE(PG8_SA(0, 0), cA, voffA); PG8_STAGE(PG8_SA(0, 1), cA + hstep, voffA);
        if (wr == 1) PG8_BAR;
        PG8_WAIT_V(2); PG8_BAR;
        PG8_STAGE(PG8_SB(1, 0), cB + kstep, voffB); PG8_STAGE(PG8_SA(1, 0), cA + kstep, voffA); PG8_STAGE(PG8_SB(1, 1), cB + hstep + kstep, voffB);
        PG8_WAIT_V(6); PG8_BAR;
    } else {
        PG8_STAGE(PG8_SB(0, 0), cB, voffB); PG8_STAGE(PG8_SA(0, 0), cA, voffA); PG8_STAGE(PG8_SB(0, 1), cB + hstep, voffB); PG8_STAGE(PG8_SA(0, 1), cA + hstep, voffA);
        if (wr == 1) PG8_BAR;
        PG8_WAIT_V(4); PG8_BAR;
        PG8_STAGE(PG8_SB(1, 0), cB + kstep, voffB); PG8_STAGE(PG8_SA(1, 0), cA + kstep, voffA); PG8_STAGE(PG8_SB(1, 1), cB + hstep + kstep, voffB);
        PG8_WAIT_V(6); PG8_BAR;
    }
    for (;;) {
        const bool has_next = S.next(ui + 1, nxt);
        const char* nA = has_next ? (const char*)g.A + (size_t)nxt.pm * tstep : cA; const char* nB = has_next ? (const char*)g.Bt + (size_t)nxt.pn * tstep : cB;
        for (int t = 0; t < nt; t += 2) {
            const bool last = (t == nt - 2);
            const char* a1 = cA + (size_t)(t + 1) * kstep;
            const char* a2 = last ? nA : cA + (size_t)(t + 2) * kstep; const char* b2 = last ? nB : cB + (size_t)(t + 2) * kstep;
            const char* a3 = a2 + kstep; const char* b3 = b2 + kstep;
            if (last && has_next) S.a_ready(nxt);
            if constexpr (SP2) {
            PG8_LDB(B0, 0, 0); PG8_LDB(B1, 0, 1); PG8_SCHED; PG8_LDA(At, 0, 0); PG8_STAGE(PG8_SA(1, 1), a1 + hstep, voffA);
            PG8_WAIT_V(8); PG8_WAIT_L(0); PG8_BAR; PG8_MMA(0, 0, At, B0); PG8_MMA(0, 1, At, B1); PG8_BAR; PG8_SCHED;
            PG8_LDA(At, 0, 1); PG8_STAGE(PG8_SB(0, 0), b2, voffB); PG8_STAGE(PG8_SB(0, 1), b2 + hstep, voffB); PG8_STAGE(PG8_SA(0, 0), a2, voffA);
            PG8_WAIT_V(8); PG8_WAIT_L(0); PG8_BAR; PG8_MMA(1, 0, At, B0); PG8_MMA(1, 1, At, B1); PG8_BAR; PG8_SCHED;
            PG8_LDB(B0, 1, 0); PG8_LDB(B1, 1, 1); PG8_SCHED; PG8_LDA(At, 1, 0); PG8_STAGE(PG8_SA(0, 1), a2 + hstep, voffA);
            PG8_WAIT_V(8); PG8_WAIT_L(0); PG8_BAR; PG8_MMA(0, 0, At, B0); PG8_MMA(0, 1, At, B1); PG8_BAR; PG8_SCHED;
            PG8_LDA(At, 1, 1); PG8_STAGE(PG8_SB(1, 0), b3, voffB); PG8_STAGE(PG8_SB(1, 1), b3 + hstep, voffB); PG8_STAGE(PG8_SA(1, 0), a3, voffA);
            PG8_WAIT_V(8); PG8_WAIT_L(0); PG8_BAR; PG8_MMA(1, 0, At, B0); PG8_MMA(1, 1, At, B1); PG8_BAR; PG8_SCHED;
            } else {
            PG8_LDB(B0, 0, 0); PG8_SCHED; PG8_LDA(At, 0, 0); PG8_STAGE(PG8_SA(1, 1), a1 + hstep, voffA);
            PG8_WAIT_L(8); PG8_BAR; PG8_WAIT_L(0); PG8_MMA(0, 0, At, B0); PG8_BAR; PG8_SCHED;
            PG8_LDB(B1, 0, 1); PG8_STAGE(PG8_SB(0, 0), b2, voffB);
            PG8_BAR; PG8_WAIT_L(0); PG8_MMA(0, 1, At, B1); PG8_BAR;
            PG8_LDA(At, 0, 1); PG8_STAGE(PG8_SA(0, 0), a2, voffA);
            PG8_BAR; PG8_WAIT_L(0); PG8_MMA(1, 0, At, B0); PG8_BAR; PG8_SCHED;
            PG8_STAGE(PG8_SB(0, 1), b2 + hstep, voffB);
            PG8_WAIT_V(6); PG8_BAR; PG8_MMA(1, 1, At, B1); PG8_BAR;
            PG8_LDB(B0, 1, 0); PG8_SCHED; PG8_LDA(At, 1, 0); PG8_STAGE(PG8_SA(0, 1), a2 + hstep, voffA);
            PG8_WAIT_L(8); PG8_BAR; PG8_WAIT_L(0); PG8_MMA(0, 0, At, B0); PG8_BAR; PG8_SCHED;
            PG8_LDB(B1, 1, 1); PG8_STAGE(PG8_SB(1, 0), b3, voffB);
            PG8_BAR; PG8_WAIT_L(0); PG8_MMA(0, 1, At, B1); PG8_BAR;
            PG8_LDA(At, 1, 1); PG8_STAGE(PG8_SA(1, 0), a3, voffA);
            PG8_BAR; PG8_WAIT_L(0); PG8_MMA(1, 0, At, B0); PG8_BAR; PG8_SCHED;
            PG8_STAGE(PG8_SB(1, 1), b3 + hstep, voffB);
            PG8_WAIT_V(6); PG8_BAR; PG8_MMA(1, 1, At, B1); PG8_BAR;
            }
        }
        if constexpr (ALIGN_EPI) { if (wr == 0) PG8_BAR; }
        if constexpr (!Epi::AFTER_DRAIN) { E(acc, cur, wr, wc, fr, fq); S.done(cur); }
        if (!has_next) break;
#pragma unroll
        for (int a = 0; a < 2; ++a)
#pragma unroll
            for (int b = 0; b < 2; ++b)
#pragma unroll
                for (int m = 0; m < 4; ++m)
#pragma unroll
                    for (int n = 0; n < 2; ++n) acc[a][b][m][n] = (f32x4){0.f, 0.f, 0.f, 0.f};
        cur = nxt; cA = nA; cB = nB; ++ui;
        if constexpr (ALIGN_EPI) { if (wr == 1) PG8_BAR; }
    }
    PG8_WAIT_V(0);
    if constexpr (!ALIGN_EPI) { if (wr == 0) PG8_BAR; }
    PG8_BAR;
    if constexpr (Epi::AFTER_DRAIN) { E.fused(acc, cur, wr, wc, fr, fq, lds, wid, lane); S.done(cur); }
#undef PG8_SA
#undef PG8_SB
#undef PG8_STAGE
#undef PG8_LDA
#undef PG8_LDB
#undef PG8_MMA
#undef PG8_WAIT_V
#undef PG8_WAIT_L
#undef PG8_BAR
#undef PG8_SCHED
}
}
#define GAS __attribute__((address_space(1)))
#define LAS __attribute__((address_space(3)))
typedef unsigned short bf16;
typedef unsigned v4u __attribute__((ext_vector_type(4)));
typedef float f32x4 __attribute__((ext_vector_type(4)));
typedef short bf16x8 __attribute__((ext_vector_type(8)));
typedef GAS unsigned gu32;
typedef GAS unsigned long long gu64;
#define RLX_AGENT __ATOMIC_RELAXED, __HIP_MEMORY_SCOPE_AGENT
#define LDS_WAIT() asm volatile("s_waitcnt lgkmcnt(0)" ::: "memory")
#define VM_WAIT() asm volatile("s_waitcnt vmcnt(0)" ::: "memory")
__device__ __forceinline__ unsigned long long rt() { return __builtin_amdgcn_s_memrealtime(); }
__device__ __forceinline__ unsigned f2bf(float f) { unsigned u = __builtin_bit_cast(unsigned, f); return (u + 0x7fffu + ((u >> 16) & 1u)) >> 16; }
__device__ __forceinline__ unsigned pk2(float lo, float hi) { return f2bf(lo) | (f2bf(hi) << 16); }

#define XB_TMO      128
#define XB_XCNT(j)  (256  + 64 * (j))
#define XB_XSUB(j)  (1280 + 64 * (j))
#define XB_XGEN(j)  (2304 + 64 * (j))
#define XB_TOP      3328
#define XB_TOPGEN   3392
#define XCD_BAR_WORDS 3456
#define XB_SPIN_CAP (1u << 18)

__device__ __forceinline__ unsigned xb_ld(unsigned* p)              { return __hip_atomic_load(p, __ATOMIC_RELAXED, __HIP_MEMORY_SCOPE_AGENT); }
__device__ __forceinline__ unsigned xb_add(unsigned* p, unsigned v) { return __hip_atomic_fetch_add(p, v, __ATOMIC_RELAXED, __HIP_MEMORY_SCOPE_AGENT); }
__device__ __forceinline__ unsigned xb_xcc_id() { return (unsigned)__builtin_amdgcn_s_getreg((3 << 11) | 20) & 0xFu; }
#define XB_SPIN(cond, bar) do { unsigned _sp = 0; while (cond) { __builtin_amdgcn_s_sleep(1); \
    if ((++_sp & 255u) == 0u) { if (xb_ld(&(bar)[XB_TMO])) break; if (_sp > XB_SPIN_CAP) { atomicAdd(&(bar)[XB_TMO], 1u); break; } } } } while (0)

struct XcdBarrier {
    unsigned* bar; unsigned x;
    volatile LAS unsigned* st;
};

__device__ __forceinline__ XcdBarrier xcd_barrier_post(unsigned* bar, volatile LAS unsigned* st) {
    XcdBarrier b; b.bar = bar; b.x = xb_xcc_id(); b.st = st;
    if (threadIdx.x == 0) (void)xb_add(&bar[XB_XCNT(b.x)], 1u);
    return b;
}
__device__ __forceinline__ void xcd_barrier_complete(unsigned* bar, unsigned x, unsigned& nloc, unsigned& nx) {
    const unsigned G = gridDim.x * gridDim.y * gridDim.z;
    unsigned sum, cnt, mine, sp = 0u;
    for (;;) {
        sum = 0u; cnt = 0u; mine = 0u;
#pragma unroll
        for (unsigned j = 0; j < 16; ++j) { const unsigned c = xb_ld(&bar[XB_XCNT(j)]); sum += c; cnt += (c > 0u) ? 1u : 0u; mine = (j == x) ? c : mine; }
        if (sum == G) break;
        __builtin_amdgcn_s_sleep(1);
        if ((++sp & 255u) == 0u) { if (xb_ld(&bar[XB_TMO])) break; if (sp > XB_SPIN_CAP) { atomicAdd(&bar[XB_TMO], 1u); break; } }
    }
    nloc = mine > 0u ? mine : 1u; nx = cnt > 0u ? cnt : 1u;
}

__device__ __forceinline__ void xcd_barrier(const XcdBarrier& b) {
    asm volatile("s_waitcnt vmcnt(0)" ::: "memory");
    __syncthreads();
    if (threadIdx.x == 0) {
        unsigned* bar = b.bar;
        __builtin_amdgcn_s_waitcnt(0);
        unsigned nloc = b.st[0], nx = b.st[1];
        if (nloc == 0u) { xcd_barrier_complete(bar, b.x, nloc, nx); b.st[0] = nloc; b.st[1] = nx; }
        const unsigned old = xb_add(&bar[XB_XSUB(b.x)], 1u);
        const unsigned gen = old / nloc;
        if (old + 1u == (gen + 1u) * nloc) {
            __builtin_amdgcn_fence(__ATOMIC_RELEASE, "agent");
            asm volatile("s_waitcnt vmcnt(0)" ::: "memory");
            const unsigned og = xb_add(&bar[XB_TOP], 1u);
            const unsigned tg = og / nx;
            if (og + 1u == (tg + 1u) * nx) xb_add(&bar[XB_TOPGEN], 1u);
            else XB_SPIN(xb_ld(&bar[XB_TOPGEN]) == tg, bar);
            __builtin_amdgcn_fence(__ATOMIC_ACQUIRE, "agent");
            xb_add(&bar[XB_XGEN(b.x)], 1u);
            asm volatile("s_waitcnt vmcnt(0)" ::: "memory");
        } else {
            XB_SPIN(xb_ld(&bar[XB_XGEN(b.x)]) == gen, bar);
            __builtin_amdgcn_fence(__ATOMIC_ACQUIRE, "agent");
            asm volatile("s_waitcnt vmcnt(0)" ::: "memory");
        }
    }
    __syncthreads();
}


constexpr int D = 1024, T = 8192, NB = 2, MP = NB * T, NS = 128, MR = MP + NS, M = 16640, HW = 2560, FF = 4096, DEPTH = 4, INW = 2448;
constexpr int C_GQ = 0, C_GK = 192, C_GV = 384, C_GOG = 768, C_RX = 1152, C_RY = 1536, C_SQ = 1920, C_SK = 2176, C_SV = 2304, C_GLR = 2432;
constexpr float EPS = 1e-6f;
constexpr int NTHR = 512, NWAVES = 8;
constexpr size_t O_Y = 0, O_YS = (size_t)MP * D, O_GLAP = O_YS + (size_t)NS * D, O_GLAS = O_GLAP + (size_t)DEPTH * NB * 4 * 48 * 96,
    O_RGHP = O_GLAS + (size_t)DEPTH * NS * 4 * 48 * 96, O_RGHS = O_RGHP + (size_t)DEPTH * NB * 384, O_RGCP = O_RGHS + (size_t)DEPTH * NS * 384,
    O_RGCS = O_RGCP + (size_t)DEPTH * NB * 3 * 384, O_SWKP = O_RGCS + (size_t)DEPTH * NS * 3 * 384, O_SWKS = O_SWKP + (size_t)DEPTH * NB * 128 * 128,
    O_SWVP = O_SWKS + (size_t)DEPTH * NS * 128 * 128, O_SWVS = O_SWVP + (size_t)DEPTH * NB * 128 * 128, O_MEMK = O_SWVS + (size_t)DEPTH * NS * 128 * 128,
    O_MEMV = O_MEMK + (size_t)DEPTH * NB * 256 * 256, O_END = O_MEMV + (size_t)DEPTH * NB * 256 * 256;
static_assert(O_END == 45379584, "output size");
constexpr size_t MiB = 1u << 20;
constexpr size_t WS_CTL = 0, CTL_ZERO_BYTES = 1 * MiB, WS_SS = 377 * MiB, SS_BYTES = 2 * MiB;
constexpr size_t WS_W = 2 * MiB, W_LAYER = 25 * MiB, WO_IN = 0, WO_OUT = 5 * MiB, WO_Q = 7 * MiB, WO_KV = 7 * MiB + MiB / 2, WO_O = 8 * MiB + MiB / 2, WO_1 = 9 * MiB, WO_2 = 17 * MiB;
constexpr size_t WS_XB = 102 * MiB, WS_MEMB = 135 * MiB, WS_KVRAW = 136 * MiB, WS_QM = 140 * MiB, WS_OMEM = 157 * MiB, WS_HF = 166 * MiB, WS_H = 166 * MiB, WS_OMIX = 248 * MiB;
constexpr size_t WS_CUM = 296 * MiB, WS_U = 308 * MiB, WS_DEC = 326 * MiB, WS_HLOC = 327 * MiB, WS_ACUM = 351 * MiB, WS_RGC = 375 * MiB, WS_WRG = 379 * MiB, WS_S0 = 380 * MiB, WS_DUMX = 400 * MiB, WS_DUMB = 470 * MiB, WS_DUMS = 510 * MiB, WS_END = 512 * MiB;
static_assert(WS_XB + (size_t)M * D * 2 <= WS_MEMB && WS_QM + (size_t)M * 256 * 4 <= WS_OMEM && WS_OMEM + (size_t)M * 256 * 2 <= WS_HF && WS_HF + (size_t)M * FF * 2 <= WS_CUM, "ws map");
static_assert(WS_H + (size_t)M * HW * 2 <= WS_OMIX && WS_OMIX + (size_t)M * D * 2 <= WS_CUM && (size_t)(13 * M + 512) * 8 <= SS_BYTES, "ws map 2");
constexpr int RGC_N = NB * 128 * 384;
constexpr int LDS_BYTES = 163840;
constexpr int CW_BAR = 4096;

#ifndef REP_SWA
#define REP_SWA 1
#endif
#ifndef REP_RG
#define REP_RG 1
#endif
#ifndef REP_GLA
#define REP_GLA 1
#endif
#ifndef REP_SMP
#define REP_SMP 1
#endif
#ifndef REP_P4
#define REP_P4 1
#endif
#ifndef REP_P7
#define REP_P7 1
#endif
#ifndef REP_P7S
#define REP_P7S 1
#endif
#ifndef REP_SYNC
#define REP_SYNC 1
#endif
#ifndef REP_P0
#define REP_P0 1
#endif
#ifndef REP_RGO
#define REP_RGO 1
#endif
#ifndef REP_G1
#define REP_G1 1
#endif
#ifndef REP_G6
#define REP_G6 1
#endif
#ifndef REP_G9
#define REP_G9 1
#endif
#ifndef REP_P3
#define REP_P3 1
#endif
#ifndef REP_G10
#define REP_G10 1
#endif
#ifndef PROF_MASK
#define PROF_MASK 0
#endif
#define REP_MAX 3
struct Args { const float* in[36]; float* out; unsigned char* ws; int ph_lo, ph_hi, use_cg, pad; };

__device__ __forceinline__ unsigned f2bf_hw(float f) { unsigned r; asm volatile("v_cvt_pk_bf16_f32 %0, %1, %1" : "=v"(r) : "v"(f)); return r & 0xffffu; }
__device__ __forceinline__ float bf2f(bf16 b) { return __uint_as_float(((unsigned)b) << 16); }
__device__ __forceinline__ float wave_sum(float x) {
    int v = __float_as_int(x);
#define WS_STEP(ctrl, rm) { const int t_ = __builtin_amdgcn_update_dpp(0, v, ctrl, rm, 0xf, false); v = __float_as_int(__int_as_float(v) + __int_as_float(t_)); }
    WS_STEP(0x111, 0xf) WS_STEP(0x112, 0xf) WS_STEP(0x114, 0xf) WS_STEP(0x118, 0xf) WS_STEP(0x142, 0xa) WS_STEP(0x143, 0xc)
#undef WS_STEP
    return __int_as_float(__builtin_amdgcn_readlane(v, 63));
}
__device__ __forceinline__ float wave_max(float x) {
    int v = __float_as_int(x);
#define WM_STEP(ctrl, rm) { const int t_ = __builtin_amdgcn_update_dpp((int)0xff800000u, v, ctrl, rm, 0xf, false); v = __float_as_int(fmaxf(__int_as_float(v), __int_as_float(t_))); }
    WM_STEP(0x111, 0xf) WM_STEP(0x112, 0xf) WM_STEP(0x114, 0xf) WM_STEP(0x118, 0xf) WM_STEP(0x142, 0xa) WM_STEP(0x143, 0xc)
#undef WM_STEP
    return __int_as_float(__builtin_amdgcn_readlane(v, 63));
}
#define DPP_ADD(x, ctrl) ((x) + __int_as_float(__builtin_amdgcn_update_dpp(0, __float_as_int(x), ctrl, 0xf, 0xf, false)))
__device__ __forceinline__ float sum8(float x) { x = DPP_ADD(x, 0xB1); x = DPP_ADD(x, 0x4E); x = DPP_ADD(x, 0x141); return x; }
__device__ __forceinline__ float sum16(float x) { x = sum8(x); x = DPP_ADD(x, 0x140); return x; }
__device__ __forceinline__ float sum32_hi(float x) { x = sum16(x); return x + __int_as_float(__builtin_amdgcn_update_dpp(0, __float_as_int(x), 0x142, 0xa, 0xf, false)); }
__device__ __forceinline__ float sigmoidf_(float x) { return __builtin_amdgcn_rcpf(1.f + __expf(-x)); }
__device__ __forceinline__ float neg_expm1_(float y) { if (fabsf(y) < 0.25f) { const float p = y * (1.f + y * (0.5f + y * (0.16666667f + y * (0.041666668f + y * (0.0083333338f + y * 0.0013888889f))))); return -p; } return -expm1f(y); }
__device__ __forceinline__ float softplusf_(float x) { return fmaxf(x, 0.f) + log1pf(__expf(-fabsf(x))); }
__device__ __forceinline__ float logsigf_(float x) { return fminf(x, 0.f) - __logf(1.f + __expf(-fabsf(x))); }
__device__ __forceinline__ float gelu_tanh(float x) { const float u2 = 1.5957691216057308f * (x + 0.044715f * x * x * x); return x * __builtin_amdgcn_rcpf(1.f + __expf(-u2)); }
__device__ __forceinline__ float siluf_(float x) { return x * __builtin_amdgcn_rcpf(1.f + __expf(-x)); }

__device__ __forceinline__ f32x4 mm16(const LAS float* A, int sai, int sak, const LAS float* B, int sbk, int sbj, int K, f32x4 acc, int lane) {
    const int i = lane & 15, q = lane >> 4;
    const LAS float* pa = A + i * sai + q * sak; const LAS float* pb = B + q * sbk + i * sbj;
#pragma unroll 4
    for (int k = 0; k < K; k += 4) acc = __builtin_amdgcn_mfma_f32_16x16x4f32(pa[k * sak], pb[k * sbk], acc, 0, 0, 0);
    return acc;
}

__device__ __forceinline__ f32x4 mmb16(const LAS bf16* A, int lda, const LAS bf16* B, int ldb, int K, f32x4 acc, int lane) {
    const LAS bf16* pa = A + (lane & 15) * lda + 8 * (lane >> 4); const LAS bf16* pb = B + (lane & 15) * ldb + 8 * (lane >> 4);
#pragma unroll 2
    for (int k = 0; k < K; k += 32) acc = __builtin_amdgcn_mfma_f32_16x16x32_bf16(*(const LAS bf16x8*)(pa + k), *(const LAS bf16x8*)(pb + k), acc, 0, 0, 0);
    return acc;
}

__device__ __forceinline__ void swa_issue(v4u (&raw)[6], const bf16* H, int u, int tid) {
    const int b = u >> 9, qb = (u >> 1) & 255, kv = u & 1, t0 = qb * 32;
#pragma unroll
    for (int i = 0; i < 6; ++i) { const int v = tid + NTHR * i; size_t row; int col;
        if (v >= 2560) { const int j = (v - 2560) >> 3, c = v & 7; row = (size_t)b * T + t0 + (j & 31); col = C_SQ + (kv * 2 + (j >> 5)) * 64 + c * 8; }
        else { const int vv_ = v < 1280 ? v : v - 1280; const int j = vv_ >> 3, c = vv_ & 7; const int sp = t0 - 128 + j; row = (size_t)b * T + (sp >= 0 ? sp : 0); col = (v < 1280 ? C_SK : C_SV) + kv * 64 + c * 8; }
        raw[i] = *(const v4u*)(H + row * HW + col); }
}
__device__ __forceinline__ void rg_issue(v4u (&cr)[2][4], const bf16* H, int uu, int tid) {
    const int b = uu >> 9, c = (uu >> 2) & 127, blk = uu & 3, t0 = c * 64;
#pragma unroll
    for (int i = 0; i < 2; ++i) { const int it0 = tid + NTHR * i; const int it = it0 < 768 ? it0 : 767; const int t = it / 12, c8 = (it % 12) * 8;
#pragma unroll
        for (int j = 0; j < 4; ++j) { const int tt = t0 + t - 3 + j; cr[i][j] = *(const v4u*)(H + ((size_t)b * T + (tt >= 0 ? tt : 0)) * HW + C_RX + blk * 96 + c8); } }
}

namespace pg8 {
template <int ACT> struct EpiScaleBf16 {
    static constexpr bool PERM = true, AFTER_DRAIN = false;
    bf16_t* O; int ldc; const unsigned long long* ss;
    __device__ __forceinline__ void operator()(const f32x4 (&acc)[2][2][4][2], const Unit& u, int wr, int wc, int fr, int fq) const {
        const int row0 = u.pm * BM + wr * 64 + fr; const int col0 = u.pn * BM + wc * 32 + 8 * fq;
#pragma unroll
        for (int ai = 0; ai < 2; ++ai)
#pragma unroll
            for (int m = 0; m < 4; ++m) { const int row = row0 + ai * HALF + m * 16; const float sc = rsqrtf((float)ss[row] * (1.f / (1024.f * 16777216.f)) + 1e-6f); bf16_t* rowp = O + (size_t)row * ldc + col0;
#pragma unroll
                for (int bj = 0; bj < 2; ++bj) { f32x4 v0 = acc[ai][bj][m][0] * sc, v1 = acc[ai][bj][m][1] * sc;
                    if (ACT == 1) {
#pragma unroll
                        for (int e = 0; e < 4; ++e) { float a = fmaxf(v0[e], 0.f), b = fmaxf(v1[e], 0.f); v0[e] = a * a; v1[e] = b * b; } }
                    u32x4 w; w.x = cvt_pk_bf16(v0[0], v0[1]); w.y = cvt_pk_bf16(v0[2], v0[3]); w.z = cvt_pk_bf16(v1[0], v1[1]); w.w = cvt_pk_bf16(v1[2], v1[3]);
                    *(u32x4*)(rowp + bj * HALF) = w; } }
    }
};
struct EpiScaleF32 {
    static constexpr bool PERM = false, AFTER_DRAIN = false;
    float* O; int ldc; const unsigned long long* ss;
    __device__ __forceinline__ void operator()(const f32x4 (&acc)[2][2][4][2], const Unit& u, int wr, int wc, int fr, int fq) const {
        const int row0 = u.pm * BM + wr * 64 + fr; const int col0 = u.pn * BM + wc * 32 + 4 * fq;
#pragma unroll
        for (int ai = 0; ai < 2; ++ai)
#pragma unroll
            for (int m = 0; m < 4; ++m) { const int row = row0 + ai * HALF + m * 16; const float sc = rsqrtf((float)ss[row] * (1.f / (1024.f * 16777216.f)) + 1e-6f); float* rowp = O + (size_t)row * ldc + col0;
#pragma unroll
                for (int bj = 0; bj < 2; ++bj)
#pragma unroll
                    for (int n = 0; n < 2; ++n) *(f32x4*)(rowp + bj * HALF + n * 16) = acc[ai][bj][m][n] * sc; }
    }
};
struct EpiResid {
    static constexpr bool PERM = false, AFTER_DRAIN = false;
    float* X; bf16_t* XB; unsigned long long* ssout; int mreal; const float* Xin;
    __device__ __forceinline__ void operator()(const f32x4 (&acc)[2][2][4][2], const Unit& u, int wr, int wc, int fr, int fq) const {
        typedef unsigned u32x2v __attribute__((ext_vector_type(2)));
        const int row0 = u.pm * BM + wr * 64 + fr; const int col0 = u.pn * BM + wc * 32 + 4 * fq;
#pragma unroll
        for (int ai = 0; ai < 2; ++ai)
#pragma unroll
            for (int m = 0; m < 4; ++m) { const int row = row0 + ai * HALF + m * 16; const bool ok = row < mreal; float s = 0.f;
                if (ok) { float* xr = X + (size_t)row * 1024 + col0; const float* xi = (Xin ? Xin : X) + (size_t)row * 1024 + col0; bf16_t* br = XB + (size_t)row * 1024 + col0;
#pragma unroll
                    for (int bj = 0; bj < 2; ++bj)
#pragma unroll
                        for (int n = 0; n < 2; ++n) { f32x4 v = *(const f32x4*)(xi + bj * HALF + n * 16) + acc[ai][bj][m][n]; *(f32x4*)(xr + bj * HALF + n * 16) = v;
                            u32x2v w; w.x = cvt_pk_bf16(v[0], v[1]); w.y = cvt_pk_bf16(v[2], v[3]); *(u32x2v*)(br + bj * HALF + n * 16) = w;
                            s += (v[0] * v[0] + v[1] * v[1]) + (v[2] * v[2] + v[3] * v[3]); } }
                s += __shfl_xor(s, 16); s += __shfl_xor(s, 32);
                if (ok && fq == 0) __hip_atomic_fetch_add(ssout + row, (unsigned long long)(s * 16777216.f), __ATOMIC_RELAXED, __HIP_MEMORY_SCOPE_AGENT); }
    }
};
}

template <int MODE>
__device__ __forceinline__ void small_gemm(const bf16* A, const bf16* Bt, int K, int u, void* Ov, int ldc, const unsigned long long* ss, unsigned long long* ssout, float* X, bf16* XBo, int lane, int wave) {
    typedef unsigned u32x2v __attribute__((ext_vector_type(2)));
    const int rl = wave * 16 + (lane & 15), kq = 8 * (lane >> 4), n0 = u * 32;
    const bf16* pa = A + (size_t)rl * K + kq; const bf16* pb0 = Bt + (size_t)(n0 + (lane & 15)) * K + kq; const bf16* pb1 = pb0 + (size_t)16 * K;
    f32x4 acc0 = (f32x4){0.f, 0.f, 0.f, 0.f}, acc1 = (f32x4){0.f, 0.f, 0.f, 0.f};
    for (int k = 0; k < K; k += 256) { bf16x8 xa[8], w0[8], w1[8];
#pragma unroll
        for (int j = 0; j < 8; ++j) { xa[j] = *(const bf16x8*)(pa + k + 32 * j); w0[j] = *(const bf16x8*)(pb0 + k + 32 * j); w1[j] = *(const bf16x8*)(pb1 + k + 32 * j); }
#pragma unroll
        for (int j = 0; j < 8; ++j) { acc0 = __builtin_amdgcn_mfma_f32_16x16x32_bf16(w0[j], xa[j], acc0, 0, 0, 0); acc1 = __builtin_amdgcn_mfma_f32_16x16x32_bf16(w1[j], xa[j], acc1, 0, 0, 0); } }
    const int row = MP + rl; const int col = n0 + 4 * (lane >> 4);
    if constexpr (MODE == 3) {
        float* xr = X + (size_t)row * 1024 + col; bf16* br = XBo + (size_t)row * 1024 + col;
        const f32x4 v0 = *(const f32x4*)xr + acc0, v1 = *(const f32x4*)(xr + 16) + acc1; *(f32x4*)xr = v0; *(f32x4*)(xr + 16) = v1;
        u32x2v w; w.x = pg8::cvt_pk_bf16(v0[0], v0[1]); w.y = pg8::cvt_pk_bf16(v0[2], v0[3]); *(u32x2v*)br = w; w.x = pg8::cvt_pk_bf16(v1[0], v1[1]); w.y = pg8::cvt_pk_bf16(v1[2], v1[3]); *(u32x2v*)(br + 16) = w;
        float sq = ((v0[0] * v0[0] + v0[1] * v0[1]) + (v0[2] * v0[2] + v0[3] * v0[3])) + ((v1[0] * v1[0] + v1[1] * v1[1]) + (v1[2] * v1[2] + v1[3] * v1[3]));
        sq += __shfl_xor(sq, 16); sq += __shfl_xor(sq, 32);
        if ((lane >> 4) == 0) __hip_atomic_fetch_add(ssout + row, (unsigned long long)(sq * 16777216.f), __ATOMIC_RELAXED, __HIP_MEMORY_SCOPE_AGENT);
    } else {
        const float sc = rsqrtf((float)ss[row] * (1.f / (1024.f * 16777216.f)) + 1e-6f); f32x4 v0 = acc0 * sc, v1 = acc1 * sc;
        if constexpr (MODE == 1) {
#pragma unroll
            for (int e = 0; e < 4; ++e) { const float p = fmaxf(v0[e], 0.f), q = fmaxf(v1[e], 0.f); v0[e] = p * p; v1[e] = q * q; } }
        if constexpr (MODE == 2) { float* o = (float*)Ov + (size_t)row * ldc + col; *(f32x4*)o = v0; *(f32x4*)(o + 16) = v1; }
        else { bf16* o = (bf16*)Ov + (size_t)row * ldc + col; u32x2v w; w.x = pg8::cvt_pk_bf16(v0[0], v0[1]); w.y = pg8::cvt_pk_bf16(v0[2], v0[3]); *(u32x2v*)o = w;
            w.x = pg8::cvt_pk_bf16(v1[0], v1[1]); w.y = pg8::cvt_pk_bf16(v1[2], v1[3]); *(u32x2v*)(o + 16) = w; }
    }
}

template <int MODE>
__device__ __forceinline__ void small_gemm_sk(const bf16* A, const bf16* Bt, int K, int task, LAS float* red, void* Ov, int ldc, const unsigned long long* ss, unsigned long long* ssout, float* X, bf16* XBo, int lane, int wave, const float* XinS = nullptr) {
    typedef unsigned u32x2v __attribute__((ext_vector_type(2)));
    const int rt = task & 7, n0 = (task >> 3) * 32, kw = K >> 3, kq = 8 * (lane >> 4);
    const bf16* pa = A + (size_t)(rt * 16 + (lane & 15)) * K + wave * kw + kq; const bf16* pb0 = Bt + (size_t)(n0 + (lane & 15)) * K + wave * kw + kq; const bf16* pb1 = pb0 + (size_t)16 * K;
    f32x4 acc0 = (f32x4){0.f, 0.f, 0.f, 0.f}, acc1 = (f32x4){0.f, 0.f, 0.f, 0.f};
#pragma unroll 1
    for (int k = 0; k < kw; k += 256) { bf16x8 xa[8], w0[8], w1[8];
#pragma unroll
        for (int j = 0; j < 8; ++j) if (k + 32 * j < kw) { xa[j] = *(const bf16x8*)(pa + k + 32 * j); w0[j] = *(const bf16x8*)(pb0 + k + 32 * j); w1[j] = *(const bf16x8*)(pb1 + k + 32 * j); }
#pragma unroll
        for (int j = 0; j < 8; ++j) if (k + 32 * j < kw) { acc0 = __builtin_amdgcn_mfma_f32_16x16x32_bf16(w0[j], xa[j], acc0, 0, 0, 0); acc1 = __builtin_amdgcn_mfma_f32_16x16x32_bf16(w1[j], xa[j], acc1, 0, 0, 0); } }
    *(LAS f32x4*)(red + ((wave * 2 + 0) * 64 + lane) * 4) = acc0; *(LAS f32x4*)(red + ((wave * 2 + 1) * 64 + lane) * 4) = acc1;
    __syncthreads();
    if (wave < 2) { f32x4 v = *(const LAS f32x4*)(red + ((0 * 2 + wave) * 64 + lane) * 4);
#pragma unroll
        for (int w = 1; w < 8; ++w) v += *(const LAS f32x4*)(red + ((w * 2 + wave) * 64 + lane) * 4);
        const int row = MP + rt * 16 + (lane & 15); const int col = n0 + 16 * wave + 4 * (lane >> 4);
        if constexpr (MODE == 3) {
            float* xr = X + (size_t)row * 1024 + col; bf16* br = XBo + (size_t)row * 1024 + col;
            const float* xi = XinS ? XinS + (size_t)(rt * 16 + (lane & 15)) * 1024 + col : xr; const f32x4 o = *(const f32x4*)xi + v; *(f32x4*)xr = o;
            u32x2v w; w.x = pg8::cvt_pk_bf16(o[0], o[1]); w.y = pg8::cvt_pk_bf16(o[2], o[3]); *(u32x2v*)br = w;
            float sq = (o[0] * o[0] + o[1] * o[1]) + (o[2] * o[2] + o[3] * o[3]);
            sq += __shfl_xor(sq, 16); sq += __shfl_xor(sq, 32);
            if ((lane >> 4) == 0) __hip_atomic_fetch_add(ssout + row, (unsigned long long)(sq * 16777216.f), __ATOMIC_RELAXED, __HIP_MEMORY_SCOPE_AGENT);
        } else {
            const float sc = rsqrtf((float)ss[row] * (1.f / (1024.f * 16777216.f)) + 1e-6f); const f32x4 o = v * sc; u32x2v w; w.x = pg8::cvt_pk_bf16(o[0], o[1]); w.y = pg8::cvt_pk_bf16(o[2], o[3]); *(u32x2v*)((bf16*)Ov + (size_t)row * ldc + col) = w;
        } }
    __syncthreads();
}

__device__ __forceinline__ void q_gemm64(const bf16* XBp, const bf16* Bt, int u, float* QMo, const unsigned long long* ss, int lane, int wave) {
    const int r0 = u * 64, kq = 8 * (lane >> 4), n0 = wave * 32;
    const bf16* pa = XBp + (size_t)(r0 + (lane & 15)) * 1024 + kq; const bf16* pb0 = Bt + (size_t)(n0 + (lane & 15)) * 1024 + kq; const bf16* pb1 = pb0 + (size_t)16 * 1024;
    f32x4 acc[4][2];
#pragma unroll
    for (int m = 0; m < 4; ++m) { acc[m][0] = (f32x4){0.f, 0.f, 0.f, 0.f}; acc[m][1] = (f32x4){0.f, 0.f, 0.f, 0.f}; }
#pragma unroll 1
    for (int k = 0; k < 1024; k += 128) { bf16x8 xa[4][4], w0[4], w1[4];
#pragma unroll
        for (int j = 0; j < 4; ++j) { w0[j] = *(const bf16x8*)(pb0 + k + 32 * j); w1[j] = *(const bf16x8*)(pb1 + k + 32 * j);
#pragma unroll
            for (int m = 0; m < 4; ++m) xa[m][j] = *(const bf16x8*)(pa + (size_t)m * 16 * 1024 + k + 32 * j); }
#pragma unroll
        for (int j = 0; j < 4; ++j)
#pragma unroll
            for (int m = 0; m < 4; ++m) { acc[m][0] = __builtin_amdgcn_mfma_f32_16x16x32_bf16(w0[j], xa[m][j], acc[m][0], 0, 0, 0); acc[m][1] = __builtin_amdgcn_mfma_f32_16x16x32_bf16(w1[j], xa[m][j], acc[m][1], 0, 0, 0); } }
#pragma unroll
    for (int m = 0; m < 4; ++m) { const int row = r0 + m * 16 + (lane & 15); const float sc = rsqrtf((float)ss[row] * (1.f / (1024.f * 16777216.f)) + 1e-6f);
        float* o = QMo + (size_t)row * 256 + n0 + 4 * (lane >> 4); *(f32x4*)o = acc[m][0] * sc; *(f32x4*)(o + 16) = acc[m][1] * sc; }
}

__device__ __forceinline__ int win_map(int n) { return n < 768 ? n : (n < 784 ? n - 768 + C_GLR : n - 16); }
__device__ __forceinline__ void tr_item(const float* W, const float* g, int K, int N, bf16* WT, bool remap, LAS float* scr, int item, int lane) {
    const int nblk = (N + 63) / 64, kb = item / nblk, nb = item % nblk, k0 = 64 * kb, n0 = 64 * nb; const int nn = n0 + lane; const bool okn = nn < N;
    { float wv[64]; const float* wp = W + (size_t)k0 * N + (okn ? nn : 0);
#pragma unroll
      for (int kk = 0; kk < 64; ++kk) wv[kk] = __builtin_nontemporal_load(wp + (size_t)kk * N);
#pragma unroll
      for (int kk = 0; kk < 64; ++kk) { float w = okn ? wv[kk] : 0.f; if (g) w *= g[k0 + kk]; scr[kk * 65 + lane] = w; } }
    LDS_WAIT(); asm volatile("" ::: "memory");
#pragma unroll
    for (int j = 0; j < 8; ++j) { const int id = lane + 64 * j, n = id >> 3, c = id & 7; const LAS float* s = scr + (8 * c) * 65 + n; const int src = n0 + n;
        if (src < N) { const int dst = remap ? win_map(src) : src;
            v4u o; o.x = pk2(s[0 * 65], s[1 * 65]); o.y = pk2(s[2 * 65], s[3 * 65]); o.z = pk2(s[4 * 65], s[5 * 65]); o.w = pk2(s[6 * 65], s[7 * 65]);
            *(v4u*)(WT + (size_t)dst * K + k0 + 8 * c) = o; } }
    LDS_WAIT(); asm volatile("" ::: "memory");
}

__global__ void __launch_bounds__(NTHR, 2) mk_fwd(Args a) {
    extern __shared__ __attribute__((aligned(16))) unsigned char lds_raw[];
    LAS unsigned char* lds = (LAS unsigned char*)lds_raw;
    LAS float* L = (LAS float*)lds;
    const int tid0 = threadIdx.x, wave0 = __builtin_amdgcn_readfirstlane(tid0 >> 6);
#define TID_UNIT int tid_u = tid0; asm volatile("" : "+v"(tid_u)); const int tid = tid_u, lane = tid & 63, fr = lane & 15, fq = lane >> 4; (void)fr; (void)fq; (void)lane;
#define TID_DECL int tid_l = tid0; asm volatile("" : "+v"(tid_l)); const int tid = tid_l, lane = tid & 63, fr = lane & 15, fq = lane >> 4; (void)fr; (void)fq; (void)lane; \
    int l_l = l_it, wv_l = wave0, bid_l = bid0; unsigned char* ws = ws0; float* out = out0; asm volatile("" : "+s"(l_l), "+s"(wv_l), "+s"(bid_l), "+s"(ws), "+s"(out)); const int l = l_l, wave = wv_l, bid = bid_l; (void)l; (void)wave; (void)bid; const int vb = (G % 8 == 0) ? (bid & 7) * (G >> 3) + (bid >> 3) : bid; (void)vb; \
    unsigned long long* SS = (unsigned long long*)(ws + WS_SS); unsigned long long* SSM = SS + 12 * M; (void)SSM; \
    bf16* XB = (bf16*)(ws + WS_XB); bf16* MEMB = (bf16*)(ws + WS_MEMB); float* KVRAW = (float*)(ws + WS_KVRAW); bf16* QM = (bf16*)(ws + WS_QM); (void)XB; (void)MEMB; (void)KVRAW; (void)QM; \
    bf16* OMEM = (bf16*)(ws + WS_OMEM); bf16* HF = (bf16*)(ws + WS_HF); bf16* H = (bf16*)(ws + WS_H); bf16* OMIX = (bf16*)(ws + WS_OMIX); (void)OMEM; (void)HF; (void)H; (void)OMIX; \
    float* CUM = (float*)(ws + WS_CUM); float* U = (float*)(ws + WS_U); float* DEC = (float*)(ws + WS_DEC); bf16* HLOC = (bf16*)(ws + WS_HLOC); bf16* ACUM = (bf16*)(ws + WS_ACUM); (void)CUM; (void)U; (void)DEC; (void)HLOC; (void)ACUM; \
    bf16* WRG = (bf16*)(ws + WS_WRG); bf16* S0G = (bf16*)(ws + WS_S0); (void)WRG; (void)S0G; \
    float* HEND = (float*)(ws + WS_RGC); float* AEND = HEND + RGC_N; float* CARRY = AEND + RGC_N; (void)HEND; (void)AEND; (void)CARRY; \
    unsigned char* wl = ws + WS_W + (size_t)l * W_LAYER; (void)wl; \
    unsigned long long* ss0 = SS + (size_t)(l * 3 + 0) * M; unsigned long long* ss1 = SS + (size_t)(l * 3 + 1) * M; unsigned long long* ss2 = SS + (size_t)(l * 3 + 2) * M; unsigned long long* ssn = SS + (size_t)((l + 1) * 3) * M; (void)ss0; (void)ss1; (void)ss2; (void)ssn;
    const int G = gridDim.x, bid0 = blockIdx.x;
    unsigned char* ws0 = a.ws; float* out0 = a.out;
    int l_it = 0;
    cg::grid_group grid = cg::this_grid();
    volatile LAS unsigned* MISC = (volatile LAS unsigned*)(lds + LDS_BYTES - 64);
    if (tid0 < 16) MISC[tid0] = 0u;
    __syncthreads();
    XcdBarrier xbar = xcd_barrier_post((unsigned*)(ws0 + WS_CTL) + CW_BAR, MISC + 8);
    int ph = 0;
#define PH_ON (ph >= a.ph_lo && ph < a.ph_hi)
#if PROF_MASK
    unsigned long long t_acc = 0ull, t_prev = rt();
#define PH_PROF do { const unsigned long long now_ = rt(); const int pil_ = (ph == 1) ? 0 : ((ph - 2) % 10) + 1; if ((PROF_MASK >> pil_) & 1) t_acc += now_ - t_prev; t_prev = now_; } while (0)
#else
#define PH_PROF do { } while (0)
#endif
#if PROF_MASK
#define SUB_PROF(bit_) do { const unsigned long long now_ = rt(); if ((PROF_MASK >> (bit_)) & 1) t_acc += now_ - t_prev; t_prev = now_; } while (0)
#else
#define SUB_PROF(bit_) do { } while (0)
#endif
#define PH_NEXT do { ++ph; if (ph > a.ph_lo && ph < a.ph_hi) { for (int r_ = 0; r_ < REP_SYNC; ++r_) { if (ph == 1) grid.sync(); else xcd_barrier(xbar); } } PH_PROF; } while (0)

    if (PH_ON) { TID_DECL
        for (int rep_ = 0; rep_ < REP_P0; ++rep_) {
        LAS float* scr = L + wave * 4160;
        const int gw = bid * NWAVES + wave, NGW = G * NWAVES;
        constexpr int I_IN = 16 * 39, I_OUT = 16 * 16, I_Q = 16 * 4, I_KV = 16 * 8, I_O = 4 * 16, I_1 = 16 * 64, I_2 = 64 * 16;
        constexpr int I_L = I_IN + I_OUT + I_Q + I_KV + I_O + I_1 + I_2;
        for (int it = gw; it < DEPTH * I_L; it += NGW) {
            const int l = it / I_L; int r = it % I_L; unsigned char* wl = ws + WS_W + (size_t)l * W_LAYER;
            if (r < I_IN) { tr_item(a.in[11] + (size_t)l * D * INW, a.in[10] + l * D, D, INW, (bf16*)(wl + WO_IN), true, scr, r, lane); continue; } r -= I_IN;
            if (r < I_OUT) { tr_item(a.in[25] + (size_t)l * D * D, nullptr, D, D, (bf16*)(wl + WO_OUT), false, scr, r, lane); continue; } r -= I_OUT;
            if (r < I_Q) { tr_item(a.in[28] + (size_t)l * D * 256, a.in[26] + l * D, D, 256, (bf16*)(wl + WO_Q), false, scr, r, lane); continue; } r -= I_Q;
            if (r < I_KV) { tr_item(a.in[29] + (size_t)l * D * 512, a.in[27] + l * D, D, 512, (bf16*)(wl + WO_KV), false, scr, r, lane); continue; } r -= I_KV;
            if (r < I_O) { tr_item(a.in[32] + (size_t)l * 256 * D, nullptr, 256, D, (bf16*)(wl + WO_O), false, scr, r, lane); continue; } r -= I_O;
            if (r < I_1) { tr_item(a.in[34] + (size_t)l * D * FF, a.in[33] + l * D, D, FF, (bf16*)(wl + WO_1), false, scr, r, lane); continue; } r -= I_1;
            tr_item(a.in[35] + (size_t)l * FF * D, nullptr, FF, D, (bf16*)(wl + WO_2), false, scr, r, lane);
        }
        for (int i = bid * NTHR + tid; i < DEPTH * 112 * 128; i += G * NTHR) { const int l = i / (112 * 128), r = i % (112 * 128);
            *(v4u*)(ws + WS_W + (size_t)l * W_LAYER + WO_IN + (size_t)INW * 2048 + (size_t)r * 16) = (v4u){0u, 0u, 0u, 0u}; }
        for (int i = bid * NTHR + tid; i < DEPTH * 2 * 36864; i += G * NTHR) { const int l = i / 73728, gate = (i / 36864) & 1, r = i % 36864, blk = r / 9216, d = (r % 9216) / 96, c = r % 96;
            WRG[i] = (bf16)f2bf(a.in[gate ? 19 : 17][(size_t)l * 36864 + blk * 9216 + c * 96 + d]); }
        for (int m = gw; m < M + 512; m += NGW) {
            if (m < MR) { const float* src = m < MP ? a.in[0] + (size_t)m * D : a.in[1] + (size_t)(m - MP) * D;
                f32x4 v[4]; float s = 0.f;
#pragma unroll
                for (int j = 0; j < 4; ++j) { v[j] = ((const f32x4*)src)[lane + 64 * j]; s += (v[j].x * v[j].x + v[j].y * v[j].y) + (v[j].z * v[j].z + v[j].w * v[j].w); }
                s = wave_sum(s); if (lane == 0) SS[m] = (unsigned long long)(s * 16777216.f);
#pragma unroll
                for (int j = 0; j < 4; ++j) {
                    ((unsigned long long*)(XB + (size_t)m * D))[lane + 64 * j] = (unsigned long long)pk2(v[j].x, v[j].y) | ((unsigned long long)pk2(v[j].z, v[j].w) << 32); }
            } else if (m < M) {
#pragma unroll
                for (int j = 0; j < 4; ++j) ((unsigned long long*)(XB + (size_t)m * D))[lane + 64 * j] = 0ull;
            } else { const int r = m - M; const float* src = a.in[2] + (size_t)r * D; f32x4 v[4]; float s = 0.f;
#pragma unroll
                for (int j = 0; j < 4; ++j) { v[j] = ((const f32x4*)src)[lane + 64 * j]; s += (v[j].x * v[j].x + v[j].y * v[j].y) + (v[j].z * v[j].z + v[j].w * v[j].w); }
                s = wave_sum(s); if (lane == 0) SSM[r] = (unsigned long long)(s * 16777216.f);
#pragma unroll
                for (int j = 0; j < 4; ++j) ((unsigned long long*)(MEMB + (size_t)r * D))[lane + 64 * j] = (unsigned long long)pk2(v[j].x, v[j].y) | ((unsigned long long)pk2(v[j].z, v[j].w) << 32);
            }
        }
        }
        __syncthreads();
    }
    PH_NEXT;

#pragma unroll 1
    for (l_it = 0; l_it < DEPTH; ++l_it) {
        if (PH_ON) { TID_DECL
            for (int rep_ = 0; rep_ < REP_G1; ++rep_)
            { pg8::Gemm g{XB, (const bf16*)(wl + WO_IN), MP, HW, D}; pg8::StaticOrder S; S.init(MP, HW, G, bid);
              pg8::EpiScaleBf16<0> E{H, HW, ss0};
              pg8::gemm_phase<pg8::EpiScaleBf16<0>, pg8::StaticOrder, true, true>(lds, g, S, E);
              for (int u = G - 1 - bid; u < HW / 32; u += G) small_gemm<0>(XB + (size_t)MP * D, (const bf16*)(wl + WO_IN), D, u, H, HW, ss0, nullptr, nullptr, nullptr, lane, wave); }
            if (l == 0) { const int rb = G - 1 - bid; const int lw = rb >> 2; const int c = (lw < DEPTH) ? (rb & 3) : 1000000; const int lwc = lw < DEPTH ? lw : 0;
              __syncthreads();
              pg8::Gemm g{MEMB, (const bf16*)(ws + WS_W + (size_t)lwc * W_LAYER + WO_KV), 512, 512, D}; pg8::StaticOrder S; S.init(512, 512, G, c);
              pg8::EpiScaleF32 E{KVRAW + (size_t)lwc * 512 * 512, 512, SSM};
              pg8::gemm_phase<pg8::EpiScaleF32, pg8::StaticOrder, true, true>(lds, g, S, E); }
            __syncthreads();
        }
        PH_NEXT;
        if (PH_ON) { TID_DECL
            const float* gk_ = a.in[23] + l * 64; const float* gq_ = a.in[22] + l * 64;
            {
                TID_UNIT
                LAS bf16* Kb = (LAS bf16*)lds; LAS bf16* Vt = (LAS bf16*)(lds + 27648); LAS bf16* Qb = (LAS bf16*)(lds + 53248); LAS float* S = (LAS float*)(lds + 71680);
                for (int u = bid; u < 512; u += G) {
                    const int b = u >> 8, qb = (u >> 1) & 127, kv = u & 1, t0 = qb * 64;
                    const bool lastblk = t0 >= T - 128;
                    v4u raw[8];
#pragma unroll
                    for (int i = 0; i < 8; ++i) { const int v = tid + NTHR * i; size_t row; int col;
                        if (i >= 6) { const int j = (v - 3072) >> 3, c = v & 7; row = (size_t)b * T + t0 + (j & 63); col = C_SQ + (kv * 2 + (j >> 6)) * 64 + c * 8; }
                        else { const int vv_ = i < 3 ? v : v - 1536; const int j = vv_ >> 3, c = vv_ & 7; const int sp = t0 - 128 + j; row = (size_t)b * T + (sp >= 0 ? sp : 0); col = (i < 3 ? C_SK : C_SV) + kv * 64 + c * 8; }
                        raw[i] = *(const v4u*)(H + row * HW + col); }
#pragma unroll
                    for (int i = 0; i < 8; ++i) { const int v = tid + NTHR * i;
                        if (i < 3 || i >= 6) {
                            const bool isq = i >= 6; const int vv_ = isq ? v - 3072 : v; const int j = vv_ >> 3, c = vv_ & 7; const int sp = t0 - 128 + j;
                            v4u rw = raw[i]; if (!isq && sp < 0) rw = (v4u){0u, 0u, 0u, 0u};
                            float x[8];
#pragma unroll
                            for (int e = 0; e < 4; ++e) { x[2 * e] = __uint_as_float(rw[e] << 16); x[2 * e + 1] = __uint_as_float(rw[e] & 0xffff0000u); }
                            float ssq = 0.f;
#pragma unroll
                            for (int e = 0; e < 8; ++e) ssq += x[e] * x[e];
                            ssq = sum8(ssq);
                            const float sc = rsqrtf(ssq * (1.f / 64.f) + EPS) * (isq ? 0.125f : 1.f); const float* gp = (isq ? gq_ : gk_) + c * 8;
#pragma unroll
                            for (int e = 0; e < 8; ++e) x[e] *= sc * gp[e];
                            v4u w; w.x = pg8::cvt_pk_bf16(x[0], x[1]); w.y = pg8::cvt_pk_bf16(x[2], x[3]); w.z = pg8::cvt_pk_bf16(x[4], x[5]); w.w = pg8::cvt_pk_bf16(x[6], x[7]);
                            *(LAS v4u*)((isq ? Qb : Kb) + j * 72 + c * 8) = w;
                            if (!isq && lastblk && j >= 128) { float* o = out + O_SWKP + ((size_t)(l * NB + b) * 128 + (sp - (T - 128))) * 128 + kv * 64 + c * 8;
                                *(f32x4*)o = (f32x4){x[0], x[1], x[2], x[3]}; *(f32x4*)(o + 4) = (f32x4){x[4], x[5], x[6], x[7]}; }
                        } else {
                            const int vv_ = v - 1536; const int j = vv_ >> 3, c = vv_ & 7; const int sp = t0 - 128 + j;
                            v4u rw = raw[i]; if (sp < 0) rw = (v4u){0u, 0u, 0u, 0u};
#pragma unroll
                            for (int e = 0; e < 4; ++e) { Vt[(c * 8 + 2 * e) * 200 + j] = (bf16)(rw[e] & 0xffffu); Vt[(c * 8 + 2 * e + 1) * 200 + j] = (bf16)(rw[e] >> 16); }
                            if (lastblk && j >= 128) { float* o = out + O_SWVP + ((size_t)(l * NB + b) * 128 + (sp - (T - 128))) * 128 + kv * 64 + c * 8;
                                *(f32x4*)o = (f32x4){__uint_as_float(rw[0] << 16), __uint_as_float(rw[0] & 0xffff0000u), __uint_as_float(rw[1] << 16), __uint_as_float(rw[1] & 0xffff0000u)};
                                *(f32x4*)(o + 4) = (f32x4){__uint_as_float(rw[2] << 16), __uint_as_float(rw[2] & 0xffff0000u), __uint_as_float(rw[3] << 16), __uint_as_float(rw[3] & 0xffff0000u)}; }
                        } }
                    __syncthreads();
#pragma unroll 1
                    for (int g = 0; g < 2; ++g) {
                        const float slope = exp2f(-2.f * (float)(kv * 2 + g + 1)); const float sink = a.in[24][l * 4 + kv * 2 + g];
#pragma unroll 1
                        for (int tile = wave; tile < 48; tile += 8) { const int ti = tile / 12, tj = tile % 12;
                            f32x4 acc = mmb16(Qb + (g * 64 + ti * 16) * 72, 72, Kb + tj * 16 * 72, 72, 64, (f32x4){0.f, 0.f, 0.f, 0.f}, lane);
#pragma unroll
                            for (int r = 0; r < 4; ++r) { const int i = ti * 16 + 4 * fq + r, j = tj * 16 + fr, dist = 128 + i - j, sp = t0 - 128 + j;
                                const bool ok = dist >= 0 && dist <= 128 && sp >= 0; S[i * 196 + j] = ok ? acc[r] - slope * (float)dist : -INFINITY; } }
                        __syncthreads();
#pragma unroll
                        for (int q = 0; q < 8; ++q) { const int rr = wave * 8 + q;
                            const float x0 = S[rr * 196 + lane], x1 = S[rr * 196 + 64 + lane], x2 = S[rr * 196 + 128 + lane];
                            const float mx = fmaxf(wave_max(fmaxf(fmaxf(x0, x1), x2)), sink);
                            const float e0 = __expf(x0 - mx), e1 = __expf(x1 - mx), e2 = __expf(x2 - mx); const float inv = __builtin_amdgcn_rcpf(wave_sum(e0 + e1 + e2) + __expf(sink - mx));
                            LAS bf16* pr = (LAS bf16*)(S + rr * 196); pr[lane] = (bf16)f2bf(e0 * inv); pr[64 + lane] = (bf16)f2bf(e1 * inv); pr[128 + lane] = (bf16)f2bf(e2 * inv); }
                        __syncthreads();
#pragma unroll 1
                        for (int tile = wave; tile < 16; tile += 8) { const int ti = tile >> 2, tj = tile & 3;
                            f32x4 acc = mmb16((LAS bf16*)S + ti * 16 * 392, 392, Vt + tj * 16 * 200, 200, 192, (f32x4){0.f, 0.f, 0.f, 0.f}, lane);
#pragma unroll
                            for (int r = 0; r < 4; ++r) { const int i = ti * 16 + 4 * fq + r, d = tj * 16 + fr;
                                OMIX[((size_t)b * T + t0 + i) * D + 768 + (kv * 2 + g) * 64 + d] = (bf16)f2bf(acc[r]); } }
                        __syncthreads();
                    }
                }
            }
            SUB_PROF(11);
            {
                TID_UNIT
                LAS float* xcf = (LAS float*)lds; LAS bf16* xcb = (LAS bf16*)(lds + 25600); LAS bf16* Wa = (LAS bf16*)(lds + 38912); LAS bf16* Wx = (LAS bf16*)(lds + 58880);
                LAS float* aa = (LAS float*)(lds + 78848); LAS float* bb = (LAS float*)(lds + 103680);
                LAS float* toth = xcf; LAS float* tota = xcf + 512;
                int staged_blk = -1;
                for (int uu = bid; uu < 1024; uu += G) {
                    const int b = uu >> 9, c = (uu >> 2) & 127, blk = uu & 3, t0 = c * 64; const size_t r0 = (size_t)b * T + t0;
                    const float* cw = a.in[15] + l * 4 * 384 + blk * 96; const float* cb = a.in[16] + l * 384 + blk * 96;
                    v4u cr[2][4]; rg_issue(cr, H, uu, tid);
                    if (blk != staged_blk) { staged_blk = blk; const bf16* wsrc = WRG + (size_t)l * 73728 + blk * 9216;
                        for (int v = tid; v < 2304; v += NTHR) { const int gate = v / 1152, rem = v % 1152, d = rem / 12, c8 = (rem % 12) * 8;
                            *(LAS v4u*)((gate ? Wx : Wa) + d * 104 + c8) = *(const v4u*)(wsrc + (size_t)gate * 36864 + d * 96 + c8); } }
#pragma unroll
                    for (int i = 0; i < 2; ++i) { const int it = tid + NTHR * i;
                        if (it < 768) { const int t = it / 12, c8 = (it % 12) * 8; float acc[8];
                            { const f32x4 b0 = *(const f32x4*)(cb + c8), b1 = *(const f32x4*)(cb + c8 + 4); acc[0] = b0.x; acc[1] = b0.y; acc[2] = b0.z; acc[3] = b0.w; acc[4] = b1.x; acc[5] = b1.y; acc[6] = b1.z; acc[7] = b1.w; }
#pragma unroll
                            for (int j = 0; j < 4; ++j) { const int tt = t0 + t - 3 + j;
                                v4u rw = cr[i][j]; if (tt < 0) rw = (v4u){0u, 0u, 0u, 0u};
                                const f32x4 w0 = *(const f32x4*)(cw + j * 384 + c8), w1 = *(const f32x4*)(cw + j * 384 + c8 + 4);
                                acc[0] += w0.x * __uint_as_float(rw[0] << 16); acc[1] += w0.y * __uint_as_float(rw[0] & 0xffff0000u); acc[2] += w0.z * __uint_as_float(rw[1] << 16); acc[3] += w0.w * __uint_as_float(rw[1] & 0xffff0000u);
                                acc[4] += w1.x * __uint_as_float(rw[2] << 16); acc[5] += w1.y * __uint_as_float(rw[2] & 0xffff0000u); acc[6] += w1.z * __uint_as_float(rw[3] << 16); acc[7] += w1.w * __uint_as_float(rw[3] & 0xffff0000u); }
                            *(LAS f32x4*)(xcf + t * 100 + c8) = (f32x4){acc[0], acc[1], acc[2], acc[3]}; *(LAS f32x4*)(xcf + t * 100 + c8 + 4) = (f32x4){acc[4], acc[5], acc[6], acc[7]};
                            v4u w; w.x = pg8::cvt_pk_bf16(acc[0], acc[1]); w.y = pg8::cvt_pk_bf16(acc[2], acc[3]); w.z = pg8::cvt_pk_bf16(acc[4], acc[5]); w.w = pg8::cvt_pk_bf16(acc[6], acc[7]);
                            *(LAS v4u*)(xcb + t * 104 + c8) = w; } }
                    __syncthreads();
#pragma unroll 1
                    for (int tile = wave; tile < 24; tile += 8) { const int ti = tile / 6, tj = tile % 6;
                        f32x4 ar = mmb16(xcb + ti * 16 * 104, 104, Wa + tj * 16 * 104, 104, 96, (f32x4){0.f, 0.f, 0.f, 0.f}, lane);
                        f32x4 ai_ = mmb16(xcb + ti * 16 * 104, 104, Wx + tj * 16 * 104, 104, 96, (f32x4){0.f, 0.f, 0.f, 0.f}, lane);
                        const int d = tj * 16 + fr, gd = blk * 96 + d; const float ba = a.in[18][l * 384 + gd], bx_ = a.in[20][l * 384 + gd], sp = softplusf_(-a.in[21][l * 384 + gd]);
#pragma unroll
                        for (int r = 0; r < 4; ++r) { const int t = ti * 16 + 4 * fq + r; const float rr = sigmoidf_(ar[r] + ba), ii = sigmoidf_(ai_[r] + bx_); const float la = -8.f * rr * sp;
                            aa[t * 97 + d] = __expf(la); bb[t * 97 + d] = sqrtf(neg_expm1_(2.f * la)) * ii * xcf[t * 100 + d]; } }
                    __syncthreads();
                    {
                        const int seg = tid / 96, d = tid % 96, gch = blk * 96 + d;
                        if (tid < 384) { float hh = 0.f, ap = 1.f;
#pragma unroll 4
                            for (int j = 0; j < 16; ++j) { const float av = aa[(seg * 16 + j) * 97 + d]; hh = av * hh + bb[(seg * 16 + j) * 97 + d]; ap *= av; }
                            toth[seg * 96 + d] = hh; tota[seg * 96 + d] = ap; }
                        __syncthreads();
                        if (tid < 384) { float hh = 0.f, ap = 1.f;
                            for (int s2 = 0; s2 < seg; ++s2) { const float ta = tota[s2 * 96 + d]; hh = ta * hh + toth[s2 * 96 + d]; ap *= ta; }
#pragma unroll 4
                            for (int j = 0; j < 16; ++j) { const float av = aa[(seg * 16 + j) * 97 + d]; hh = av * hh + bb[(seg * 16 + j) * 97 + d]; ap *= av;
                                HLOC[(r0 + seg * 16 + j) * 384 + gch] = (bf16)f2bf(hh); ACUM[(r0 + seg * 16 + j) * 384 + gch] = (bf16)f2bf(ap); }
                            if (seg == 3) { HEND[(b * 128 + c) * 384 + gch] = hh; AEND[(b * 128 + c) * 384 + gch] = ap; } }
                    }
                    __syncthreads();
                }
            }
            SUB_PROF(12);
            for (int u = 2048 + bid; u < 3072; u += G) {
                    TID_UNIT
                    const int uu = u - 2048, b = uu >> 9, c = (uu >> 2) & 127, h = uu & 3; const size_t r0 = (size_t)b * T + c * 64;
                    LAS float* glr = L; LAS float* wg = L + 1024; LAS float* bg = L + 1792; LAS float* cum = L + 1856; LAS bf16* Kt = (LAS bf16*)(lds + 19968); LAS bf16* Vt = (LAS bf16*)(lds + 26880);
                    const int kt_t = tid / 6, kt_k0 = (tid % 6) * 8;
                    v4u kraw = (v4u){0u, 0u, 0u, 0u}; if (tid < 384) kraw = *(const v4u*)(H + (r0 + kt_t) * HW + C_GK + h * 48 + kt_k0);
                    if (tid < 128) { const v4u g = *(const v4u*)(H + (r0 + (tid >> 1)) * HW + C_GLR + (tid & 1) * 8);
#pragma unroll
                        for (int e = 0; e < 4; ++e) { glr[tid * 8 + 2 * e] = __uint_as_float(g[e] << 16); glr[tid * 8 + 2 * e + 1] = __uint_as_float(g[e] & 0xffff0000u); } }
                    for (int i = tid; i < 768; i += NTHR) wg[i] = a.in[12][l * 3072 + (i / 48) * 192 + h * 48 + (i % 48)];
                    if (tid < 48) bg[tid] = a.in[13][l * 192 + h * 48 + tid];
#pragma unroll
                    for (int i = 0; i < 2; ++i) { const int v = tid + NTHR * i; if (v < 768) { const int t = v / 12, c8 = (v % 12) * 8;
                        const v4u raw = *(const v4u*)(H + (r0 + t) * HW + C_GV + h * 96 + c8);
#pragma unroll
                        for (int e = 0; e < 4; ++e) { Vt[(c8 + 2 * e) * 72 + t] = (bf16)(raw[e] & 0xffffu); Vt[(c8 + 2 * e + 1) * 72 + t] = (bf16)(raw[e] >> 16); } } }
                    __syncthreads();
                    for (int tile = wave; tile < 12; tile += 8) { const int ti = tile / 3, tj = tile % 3;
                        f32x4 acc = mm16(glr + ti * 16 * 16, 16, 1, wg + tj * 16, 48, 1, 16, (f32x4){0.f, 0.f, 0.f, 0.f}, lane); const float bz = bg[tj * 16 + fr];
#pragma unroll
                        for (int r = 0; r < 4; ++r) cum[(ti * 16 + 4 * fq + r) * 49 + tj * 16 + fr] = logsigf_(acc[r] + bz) * (1.f / 16.f); }
                    __syncthreads();
                    if (tid < 48) { float s = 0.f;
#pragma unroll 1
                        for (int tb = 0; tb < 64; tb += 16) { float cv_[16];
#pragma unroll
                            for (int j = 0; j < 16; ++j) cv_[j] = cum[(tb + j) * 49 + tid];
#pragma unroll
                            for (int j = 0; j < 16; ++j) { s += cv_[j]; cum[(tb + j) * 49 + tid] = s; } } }
                    __syncthreads();
                    if (tid < 384) { float cu[8], kt[8];
#pragma unroll
                        for (int e = 0; e < 8; ++e) cu[e] = cum[kt_t * 49 + kt_k0 + e];
                        *(f32x4*)(CUM + (r0 + kt_t) * 192 + h * 48 + kt_k0) = (f32x4){cu[0], cu[1], cu[2], cu[3]}; *(f32x4*)(CUM + (r0 + kt_t) * 192 + h * 48 + kt_k0 + 4) = (f32x4){cu[4], cu[5], cu[6], cu[7]};
#pragma unroll
                        for (int e = 0; e < 4; ++e) { kt[2 * e] = __uint_as_float(kraw[e] << 16) * __expf(cum[63 * 49 + kt_k0 + 2 * e] - cu[2 * e]); kt[2 * e + 1] = __uint_as_float(kraw[e] & 0xffff0000u) * __expf(cum[63 * 49 + kt_k0 + 2 * e + 1] - cu[2 * e + 1]); }
#pragma unroll
                        for (int e = 0; e < 8; ++e) Kt[(kt_k0 + e) * 72 + kt_t] = (bf16)f2bf(kt[e]); }
                    if (tid < 48) DEC[((b * 128 + c) * 4 + h) * 48 + tid] = __expf(cum[63 * 49 + tid]);
                    __syncthreads();
                    float* Ub = U + ((size_t)(b * 128 + c) * 4 + h) * 4608;
                    for (int tile = wave; tile < 18; tile += 8) { const int ti = tile / 6, tj = tile % 6;
                        f32x4 acc = mmb16(Kt + ti * 16 * 72, 72, Vt + tj * 16 * 72, 72, 64, (f32x4){0.f, 0.f, 0.f, 0.f}, lane);
#pragma unroll
                        for (int r = 0; r < 4; ++r) Ub[(ti * 16 + 4 * fq + r) * 96 + tj * 16 + fr] = acc[r]; }
                    __syncthreads();
            }
            SUB_PROF(13);
            for (int u2 = bid; u2 < 2 * NS; u2 += G) {
                    TID_UNIT
                    const int n = u2 >> 1, part = u2 & 1; const size_t row = (size_t)MP + n; const size_t ln = (size_t)l * NS + n;
                    LAS float* hrow = L; LAS float* eg = L + 2560; LAS float* qk = L + 2752; LAS float* og = L + 2760; LAS float* xcs = L + 3144; LAS float* qn = L + 3528; LAS float* knew = L + 3784;
                    LAS float* vnew = L + 3912; LAS float* sc = L + 4040; LAS float* red = L + 4600;
                    for (int i = tid; i < INW; i += NTHR) hrow[i] = bf2f(H[row * HW + i]);
                    __syncthreads();
                    const float qscale = 0.14433756729740643f;
                    if (part == 0 && tid < 192) { float z = a.in[13][l * 192 + tid];
#pragma unroll
                        for (int j = 0; j < 16; ++j) z += hrow[C_GLR + j] * a.in[12][l * 3072 + j * 192 + tid];
                        eg[tid] = __expf(logsigf_(z) * (1.f / 16.f)); }
                    if (part == 0 && wave < 4) { float p = lane < 48 ? hrow[C_GQ + wave * 48 + lane] * qscale * hrow[C_GK + wave * 48 + lane] : 0.f; p = wave_sum(p); if (lane == 0) qk[wave] = p; }
                    else if (part == 1 && wave >= 4) { const int hq = wave - 4; const float qx = hrow[C_SQ + hq * 64 + lane]; const float ssq = wave_sum(qx * qx); qn[hq * 64 + lane] = qx * rsqrtf(ssq * (1.f / 64.f) + EPS) * gq_[lane] * 0.125f; }
                    __syncthreads();
                    if (part == 1 && wave < 2) { const float kx = hrow[C_SK + wave * 64 + lane]; const float ssq = wave_sum(kx * kx); knew[wave * 64 + lane] = kx * rsqrtf(ssq * (1.f / 64.f) + EPS) * gk_[lane]; vnew[wave * 64 + lane] = hrow[C_SV + wave * 64 + lane]; }
                    if (part == 0 && tid >= 128 && tid < 512) { const int e = tid - 128, h = e / 96, v = e % 96; const float* S0 = a.in[3] + (ln * 4 + h) * 4608; float* So = out + O_GLAS + (ln * 4 + h) * 4608;
                        const float vvv = hrow[C_GV + e]; float o = qk[h] * vvv;
#pragma unroll 1
                        for (int kb = 0; kb < 48; kb += 16) { float sv[16];
#pragma unroll
                            for (int j = 0; j < 16; ++j) sv[j] = __builtin_nontemporal_load(S0 + (kb + j) * 96 + v);
#pragma unroll
                            for (int j = 0; j < 16; ++j) { const int k = kb + j; const float s0 = sv[j], e_ = eg[h * 48 + k]; o += hrow[C_GQ + h * 48 + k] * qscale * e_ * s0; __builtin_nontemporal_store(e_ * s0 + hrow[C_GK + h * 48 + k] * vvv, So + k * 96 + v); } }
                        og[e] = o; }
                    __syncthreads();
                    if (part == 0 && wave < 4) { const int h = wave; const float x0 = og[h * 96 + lane], x1 = lane < 32 ? og[h * 96 + 64 + lane] : 0.f; const float ssq = wave_sum(x0 * x0 + x1 * x1); const float rs = rsqrtf(ssq * (1.f / 96.f) + EPS);
                        OMIX[row * D + h * 96 + lane] = (bf16)f2bf(x0 * rs * a.in[14][l * 96 + lane] * siluf_(hrow[C_GOG + h * 96 + lane]));
                        if (lane < 32) OMIX[row * D + h * 96 + 64 + lane] = (bf16)f2bf(x1 * rs * a.in[14][l * 96 + 64 + lane] * siluf_(hrow[C_GOG + h * 96 + 64 + lane])); }
                    if (part == 0 && tid >= 128 && tid < 512) { const int ch = tid - 128; const float* cw = a.in[15] + l * 4 * 384; const float* bufp = a.in[5] + ln * 3 * 384;
                        const float b0 = bufp[ch], b1 = bufp[384 + ch], b2 = bufp[768 + ch], rx = hrow[C_RX + ch];
                        xcs[ch] = a.in[16][l * 384 + ch] + cw[ch] * b0 + cw[384 + ch] * b1 + cw[768 + ch] * b2 + cw[1152 + ch] * rx;
                        float* co = out + O_RGCS + ln * 3 * 384; co[ch] = b1; co[384 + ch] = b2; co[768 + ch] = rx; }
                    __syncthreads();
                    if (part == 0 && tid < 384) { const int ch = tid, blk = ch / 96, d = ch % 96; const float* wsa = a.in[17] + (size_t)l * 36864 + blk * 9216 + d; const float* wsx = a.in[19] + (size_t)l * 36864 + blk * 9216 + d;
                        float ra = a.in[18][l * 384 + ch], rxx = a.in[20][l * 384 + ch];
#pragma unroll 1
                        for (int cb_ = 0; cb_ < 96; cb_ += 16) { float wa_[16], wx_[16];
#pragma unroll
                            for (int j = 0; j < 16; ++j) { wa_[j] = wsa[(cb_ + j) * 96]; wx_[j] = wsx[(cb_ + j) * 96]; }
#pragma unroll
                            for (int j = 0; j < 16; ++j) { const float xv = xcs[blk * 96 + cb_ + j]; ra += xv * wa_[j]; rxx += xv * wx_[j]; } }
                        const float rr = sigmoidf_(ra), ii = sigmoidf_(rxx); const float la = -8.f * rr * softplusf_(-a.in[21][l * 384 + ch]);
                        const float hv = __expf(la) * a.in[4][ln * 384 + ch] + sqrtf(neg_expm1_(2.f * la)) * ii * xcs[ch];
                        out[O_RGHS + ln * 384 + ch] = hv; OMIX[row * D + 384 + ch] = (bf16)f2bf(hv * gelu_tanh(hrow[C_RY + ch])); }
                    if (part == 1) { typedef float f32x2v __attribute__((ext_vector_type(2)));
                      const int kvh = lane >> 5, dd = (lane & 31) * 2; const float* ck = a.in[6] + ln * 128 * 128; const float* cv = a.in[7] + ln * 128 * 128;
                      float* ko = out + O_SWKS + ln * 128 * 128; float* vo = out + O_SWVS + ln * 128 * 128;
                      const float q00 = qn[(kvh * 2) * 64 + dd], q01 = qn[(kvh * 2) * 64 + dd + 1], q10 = qn[(kvh * 2 + 1) * 64 + dd], q11 = qn[(kvh * 2 + 1) * 64 + dd + 1];
                      const float sl0 = exp2f(-2.f * (float)(kvh * 2 + 1)), sl1 = exp2f(-2.f * (float)(kvh * 2 + 2));
#pragma unroll 1
                      for (int ib = 0; ib < 17; ib += 8) { f32x2v kr[8];
#pragma unroll
                          for (int jj = 0; jj < 8; ++jj) { const int j = (tid >> 6) + 8 * (ib + jj); kr[jj] = (f32x2v){0.f, 0.f}; if (j < 128) kr[jj] = __builtin_nontemporal_load((const f32x2v*)(ck + j * 128 + lane * 2)); else if (j == 128) { kr[jj].x = knew[lane * 2]; kr[jj].y = knew[lane * 2 + 1]; } }
#pragma unroll
                          for (int jj = 0; jj < 8; ++jj) { const int j = (tid >> 6) + 8 * (ib + jj);
                              if (j >= 1 && j < 129) __builtin_nontemporal_store(kr[jj], (f32x2v*)(ko + (j - 1) * 128 + lane * 2));
                              float s0 = kr[jj].x * q00 + kr[jj].y * q01, s1 = kr[jj].x * q10 + kr[jj].y * q11;
                              s0 = sum32_hi(s0); s1 = sum32_hi(s1);
                              const float dist = (float)(128 - j);
                              if ((lane & 31) == 16 && j < 129) { sc[(kvh * 2) * 132 + j] = s0 - sl0 * dist; sc[(kvh * 2 + 1) * 132 + j] = s1 - sl1 * dist; } }
                      }
                      __syncthreads();
                      if (wave < 4) { const int h = wave; const float sink = a.in[24][l * 4 + h]; const float x0 = sc[h * 132 + lane], x1 = sc[h * 132 + 64 + lane], x2 = lane == 0 ? sc[h * 132 + 128] : -INFINITY;
                          const float mx = fmaxf(wave_max(fmaxf(fmaxf(x0, x1), x2)), sink); const float e0 = __expf(x0 - mx), e1 = __expf(x1 - mx), e2 = __expf(x2 - mx);
                          const float inv = 1.f / (wave_sum(e0 + e1 + e2) + __expf(sink - mx)); sc[h * 132 + lane] = e0 * inv; sc[h * 132 + 64 + lane] = e1 * inv; if (lane == 0) sc[h * 132 + 128] = e2 * inv; }
                      __syncthreads();
                      float a00 = 0.f, a01 = 0.f, a10 = 0.f, a11 = 0.f;
#pragma unroll 1
                      for (int ib = 0; ib < 17; ib += 8) { f32x2v vr[8];
#pragma unroll
                          for (int jj = 0; jj < 8; ++jj) { const int j = (tid >> 6) + 8 * (ib + jj); vr[jj] = (f32x2v){0.f, 0.f}; if (j < 128) vr[jj] = __builtin_nontemporal_load((const f32x2v*)(cv + j * 128 + lane * 2)); else if (j == 128) { vr[jj].x = vnew[lane * 2]; vr[jj].y = vnew[lane * 2 + 1]; } }
#pragma unroll
                          for (int jj = 0; jj < 8; ++jj) { const int j = (tid >> 6) + 8 * (ib + jj);
                              if (j >= 1 && j < 129) __builtin_nontemporal_store(vr[jj], (f32x2v*)(vo + (j - 1) * 128 + lane * 2));
                              if (j < 129) { const float p0 = sc[(kvh * 2) * 132 + j], p1 = sc[(kvh * 2 + 1) * 132 + j]; a00 += p0 * vr[jj].x; a01 += p0 * vr[jj].y; a10 += p1 * vr[jj].x; a11 += p1 * vr[jj].y; } } }
                      red[wave * 256 + (kvh * 2) * 64 + dd] = a00; red[wave * 256 + (kvh * 2) * 64 + dd + 1] = a01; red[wave * 256 + (kvh * 2 + 1) * 64 + dd] = a10; red[wave * 256 + (kvh * 2 + 1) * 64 + dd + 1] = a11;
                      __syncthreads();
                      if (tid < 256) { float s = 0.f;
#pragma unroll
                          for (int w = 0; w < 8; ++w) s += red[w * 256 + tid];
                          OMIX[row * D + 768 + tid] = (bf16)f2bf(s); }
                      __syncthreads(); }
            }
            if (l == 0) {
                for (int w = bid * NWAVES + wave; w < DEPTH * 512 * 4; w += G * NWAVES) { const int lw = w / 2048, row = (w >> 2) & 511, h = w & 3;
                    const float kx = KVRAW[((size_t)lw * 512 + row) * 512 + h * 64 + lane], vx = KVRAW[((size_t)lw * 512 + row) * 512 + 256 + h * 64 + lane];
                    const float ssq = wave_sum(kx * kx); const size_t o = ((size_t)lw * 512 + row) * 256 + h * 64 + lane;
                    out[O_MEMK + o] = kx * rsqrtf(ssq * (1.f / 64.f) + EPS) * a.in[31][lw * 64 + lane]; out[O_MEMV + o] = vx; }
            }
        }
        PH_NEXT;
        if (PH_ON) { TID_DECL
            for (int gr = wave * G + bid; gr < 588; gr += G * NWAVES) { const int e = gr * 64 + lane;
                if (e < 36864) { const int b = e / 18432, rem = e % 18432, hk = rem / 96; float S = 0.f;
                    const float* __restrict__ Ub = U + (size_t)b * 128 * 18432 + rem; bf16* __restrict__ Sb = S0G + (size_t)b * 128 * 18432 + rem; const float* __restrict__ Db = DEC + (size_t)b * 128 * 192 + hk;
#pragma unroll 1
                    for (int c0 = 0; c0 < 128; c0 += 16) { float uv[16], dv[16];
#pragma unroll
                        for (int j = 0; j < 16; ++j) { uv[j] = Ub[(size_t)(c0 + j) * 18432]; dv[j] = Db[(c0 + j) * 192]; }
#pragma unroll
                        for (int j = 0; j < 16; ++j) { Sb[(size_t)(c0 + j) * 18432] = (bf16)f2bf(S); S = dv[j] * S + uv[j]; } }
                    out[O_GLAP + (size_t)(l * NB + b) * 18432 + rem] = S;
                } else { const int q = e - 36864, b = q / 384, ch = q % 384; float cr = 0.f;
#pragma unroll 1
                    for (int c0 = 0; c0 < 128; c0 += 16) { float hv[16], av[16];
#pragma unroll
                        for (int j = 0; j < 16; ++j) { hv[j] = HEND[(b * 128 + c0 + j) * 384 + ch]; av[j] = AEND[(b * 128 + c0 + j) * 384 + ch]; }
#pragma unroll
                        for (int j = 0; j < 16; ++j) { CARRY[(b * 128 + c0 + j) * 384 + ch] = cr; cr = av[j] * cr + hv[j]; } }
                    out[O_RGHP + (size_t)(l * NB + b) * 384 + ch] = cr;
#pragma unroll
                    for (int j = 0; j < 3; ++j) out[O_RGCP + ((size_t)(l * NB + b) * 3 + j) * 384 + ch] = bf2f(H[((size_t)b * T + T - 3 + j) * HW + C_RX + ch]);
                }
            }
        }
        PH_NEXT;
        if (PH_ON) { TID_DECL
            for (int u = bid; u < 1024; u += G) {
                const int b = u >> 9, c = (u >> 2) & 127, h = u & 3; const size_t r0 = (size_t)b * T + c * 64;
                LAS bf16* qeb = (LAS bf16*)lds; LAS bf16* keb = (LAS bf16*)(lds + 9216); LAS bf16* Ab = (LAS bf16*)(lds + 18432); LAS bf16* Vt = (LAS bf16*)(lds + 27648); LAS bf16* S0t = (LAS bf16*)(lds + 41472);
                LAS float* o = (LAS float*)(lds + 55296);
                const bf16* Ub = S0G + ((size_t)(b * 128 + c) * 4 + h) * 4608;
                float gg0[8], gg1[8];
#pragma unroll
                for (int q = 0; q < 8; ++q) { const bf16* gp = H + (r0 + (tid >> 6) * 8 + q) * HW + C_GOG + h * 96; gg0[q] = bf2f(gp[lane]); gg1[q] = bf2f(gp[64 + (lane & 31)]); }
                if (tid < 384) { const int t = tid / 6, k0 = (tid % 6) * 8;
                    const v4u qr = *(const v4u*)(H + (r0 + t) * HW + C_GQ + h * 48 + k0), kr = *(const v4u*)(H + (r0 + t) * HW + C_GK + h * 48 + k0);
                    const f32x4 c0 = *(const f32x4*)(CUM + (r0 + t) * 192 + h * 48 + k0), c1 = *(const f32x4*)(CUM + (r0 + t) * 192 + h * 48 + k0 + 4);
                    float cu[8] = {c0.x, c0.y, c0.z, c0.w, c1.x, c1.y, c1.z, c1.w}; float qe[8], ke[8];
#pragma unroll
                    for (int e = 0; e < 4; ++e) { const float q0 = __uint_as_float(qr[e] << 16), q1 = __uint_as_float(qr[e] & 0xffff0000u), k0_ = __uint_as_float(kr[e] << 16), k1_ = __uint_as_float(kr[e] & 0xffff0000u);
                        const float e0 = __expf(cu[2 * e]), e1 = __expf(cu[2 * e + 1]);
                        qe[2 * e] = q0 * 0.14433756729740643f * e0; qe[2 * e + 1] = q1 * 0.14433756729740643f * e1; ke[2 * e] = k0_ / e0; ke[2 * e + 1] = k1_ / e1; }
                    v4u w; w.x = pg8::cvt_pk_bf16(qe[0], qe[1]); w.y = pg8::cvt_pk_bf16(qe[2], qe[3]); w.z = pg8::cvt_pk_bf16(qe[4], qe[5]); w.w = pg8::cvt_pk_bf16(qe[6], qe[7]); *(LAS v4u*)(qeb + t * 72 + k0) = w;
                    w.x = pg8::cvt_pk_bf16(ke[0], ke[1]); w.y = pg8::cvt_pk_bf16(ke[2], ke[3]); w.z = pg8::cvt_pk_bf16(ke[4], ke[5]); w.w = pg8::cvt_pk_bf16(ke[6], ke[7]); *(LAS v4u*)(keb + t * 72 + k0) = w;
                } else {
                    for (int i = tid - 384; i < 448; i += 128) { LAS bf16* base = i < 128 ? qeb : (i < 256 ? keb : S0t); const int r = i < 128 ? i : (i < 256 ? i - 128 : i - 256);
                        *(LAS v4u*)(base + (r >> 1) * 72 + 48 + (r & 1) * 8) = (v4u){0u, 0u, 0u, 0u}; } }
#pragma unroll
                for (int i = 0; i < 2; ++i) { const int v = tid + NTHR * i; if (v < 768) { const int t = v / 12, c8 = (v % 12) * 8;
                    const v4u raw = *(const v4u*)(H + (r0 + t) * HW + C_GV + h * 96 + c8);
#pragma unroll
                    for (int e = 0; e < 4; ++e) { Vt[(c8 + 2 * e) * 72 + t] = (bf16)(raw[e] & 0xffffu); Vt[(c8 + 2 * e + 1) * 72 + t] = (bf16)(raw[e] >> 16); } } }
#pragma unroll
                for (int i = 0; i < 3; ++i) { const int idx = tid + NTHR * i; if (idx < 1152) { const int k = idx / 24, v4 = (idx % 24) * 4;
                    typedef unsigned u32x2v __attribute__((ext_vector_type(2))); const u32x2v sv = *(const u32x2v*)(Ub + k * 96 + v4);
                    S0t[(v4 + 0) * 72 + k] = (bf16)(sv.x & 0xffffu); S0t[(v4 + 1) * 72 + k] = (bf16)(sv.x >> 16); S0t[(v4 + 2) * 72 + k] = (bf16)(sv.y & 0xffffu); S0t[(v4 + 3) * 72 + k] = (bf16)(sv.y >> 16); } }
                __syncthreads();
                for (int tile = wave; tile < 16; tile += 8) { const int ti = tile >> 2, tj = tile & 3; f32x4 acc = (f32x4){0.f, 0.f, 0.f, 0.f};
                    if (tj <= ti) acc = mmb16(qeb + ti * 16 * 72, 72, keb + tj * 16 * 72, 72, 64, acc, lane);
#pragma unroll
                    for (int r = 0; r < 4; ++r) { const int tr = ti * 16 + 4 * fq + r, sc_ = tj * 16 + fr; Ab[tr * 72 + sc_] = (bf16)f2bf((sc_ <= tr) ? acc[r] : 0.f); } }
                __syncthreads();
                for (int tile = wave; tile < 24; tile += 8) { const int ti = tile / 6, tj = tile % 6;
                    f32x4 acc = mmb16(qeb + ti * 16 * 72, 72, S0t + tj * 16 * 72, 72, 64, (f32x4){0.f, 0.f, 0.f, 0.f}, lane);
                    acc = mmb16(Ab + ti * 16 * 72, 72, Vt + tj * 16 * 72, 72, 64, acc, lane);
#pragma unroll
                    for (int r = 0; r < 4; ++r) o[(ti * 16 + 4 * fq + r) * 98 + tj * 16 + fr] = acc[r]; }
                __syncthreads();
                const float go0 = a.in[14][l * 96 + lane], go1 = a.in[14][l * 96 + 64 + (lane & 31)];
#pragma unroll
                for (int q = 0; q < 8; ++q) { const int t = wave * 8 + q; const float x0 = o[t * 98 + lane], x1 = lane < 32 ? o[t * 98 + 64 + lane] : 0.f;
                    const float rs = rsqrtf(wave_sum(x0 * x0 + x1 * x1) * (1.f / 96.f) + EPS);
                    OMIX[(r0 + t) * D + h * 96 + lane] = (bf16)f2bf(x0 * rs * go0 * siluf_(gg0[q]));
                    if (lane < 32) OMIX[(r0 + t) * D + h * 96 + 64 + lane] = (bf16)f2bf(x1 * rs * go1 * siluf_(gg1[q])); }
                __syncthreads();
            }
            SUB_PROF(14);
            for (int e4 = bid * NTHR + tid; e4 < MP * 96; e4 += G * NTHR) { const int row = e4 / 96, ch = (e4 % 96) * 4; const int bc = row >> 6;
                typedef unsigned u32x2v __attribute__((ext_vector_type(2)));
                const u32x2v hlr = *(const u32x2v*)(HLOC + (size_t)row * 384 + ch), acr = *(const u32x2v*)(ACUM + (size_t)row * 384 + ch); const f32x4 cr = *(const f32x4*)(CARRY + (size_t)bc * 384 + ch);
                const f32x4 hl = (f32x4){__uint_as_float(hlr.x << 16), __uint_as_float(hlr.x & 0xffff0000u), __uint_as_float(hlr.y << 16), __uint_as_float(hlr.y & 0xffff0000u)}, ac = (f32x4){__uint_as_float(acr.x << 16), __uint_as_float(acr.x & 0xffff0000u), __uint_as_float(acr.y << 16), __uint_as_float(acr.y & 0xffff0000u)};
                const u32x2v ry = *(const u32x2v*)(H + (size_t)row * HW + C_RY + ch);
                const f32x4 hv = hl + ac * cr;
                u32x2v w; w.x = pg8::cvt_pk_bf16(hv.x * gelu_tanh(__uint_as_float(ry.x << 16)), hv.y * gelu_tanh(__uint_as_float(ry.x & 0xffff0000u)));
                w.y = pg8::cvt_pk_bf16(hv.z * gelu_tanh(__uint_as_float(ry.y << 16)), hv.w * gelu_tanh(__uint_as_float(ry.y & 0xffff0000u)));
                *(u32x2v*)(OMIX + (size_t)row * D + 384 + ch) = w; }
        }
        PH_NEXT;
        if (PH_ON) { TID_DECL
            pg8::Gemm g{OMIX, (const bf16*)(wl + WO_OUT), MP, D, D}; pg8::StaticOrder S; S.init(MP, D, G, bid);
            pg8::EpiResid E{out, XB, ss1, MR, l == 0 ? a.in[0] : nullptr};
            pg8::gemm_phase<pg8::EpiResid, pg8::StaticOrder, true, true>(lds, g, S, E);
            for (int u = G - 1 - bid; u < 256; u += G) small_gemm_sk<3>(OMIX + (size_t)MP * D, (const bf16*)(wl + WO_OUT), D, u, L, nullptr, 0, nullptr, ss1, out, XB, lane, wave, l == 0 ? a.in[1] : nullptr);
            __syncthreads();
        }
        PH_NEXT;
        if (PH_ON) { TID_DECL
            for (int rep_ = 0; rep_ < REP_G6; ++rep_) {
            pg8::Gemm g{XB, (const bf16*)(wl + WO_Q), MP, 256, D}; pg8::StaticOrder S; S.init(MP, 256, G, bid);
            pg8::EpiScaleBf16<0> E{QM, 256, ss1};
            pg8::gemm_phase<pg8::EpiScaleBf16<0>, pg8::StaticOrder, true, true>(lds, g, S, E);
            for (int u = G - 1 - bid; u < 64; u += G) small_gemm_sk<2>(XB + (size_t)MP * D, (const bf16*)(wl + WO_Q), D, u, L, QM, 256, ss1, nullptr, nullptr, nullptr, lane, wave);
            __syncthreads(); }
            __syncthreads();
        }
        PH_NEXT;
        if (PH_ON) { TID_DECL
            const float* gmq = a.in[30] + l * 64;
            int staged_bh = -1;
            for (int u = bid; u < 1024 + 2 * NS; u += G) {
                if (u < 1024) { int b = u >> 9, rb = (u >> 2) & 127, h = u & 3; if (G == 256) { const int k_ = u >> 8, w_ = u & 255; b = w_ >> 7; h = w_ & 3; rb = ((w_ >> 2) & 31) * 4 + k_; }     const size_t r0 = (size_t)b * T + rb * 64;
                    LAS bf16* Kb = (LAS bf16*)lds; LAS bf16* Vt = (LAS bf16*)(lds + 36864); LAS bf16* Qb = (LAS bf16*)(lds + 70656); LAS float* S = (LAS float*)(lds + 79872);
                    const float* mk = out + O_MEMK + (size_t)(l * NB + b) * 256 * 256 + h * 64; const float* mv = out + O_MEMV + (size_t)(l * NB + b) * 256 * 256 + h * 64;
                    const bool restage = (b * 4 + h) != staged_bh; staged_bh = b * 4 + h;
#pragma unroll
                    for (int i = 0; i < 2; ++i) { const int v = tid + NTHR * i; const int r = v >> 4, c4 = (v & 15) * 4;
                        typedef unsigned u32x2q __attribute__((ext_vector_type(2))); const u32x2q xr = *(const u32x2q*)(QM + (r0 + r) * 256 + h * 64 + c4);
                        f32x4 x = (f32x4){__uint_as_float(xr.x << 16), __uint_as_float(xr.x & 0xffff0000u), __uint_as_float(xr.y << 16), __uint_as_float(xr.y & 0xffff0000u)}; float ssq = (x.x * x.x + x.y * x.y) + (x.z * x.z + x.w * x.w);
                        ssq = sum16(ssq);
                        const float sc = rsqrtf(ssq * (1.f / 64.f) + EPS) * 0.125f; const f32x4 g4 = *(const f32x4*)(gmq + c4);
                        typedef unsigned u32x2v __attribute__((ext_vector_type(2)));
                        u32x2v w; w.x = pg8::cvt_pk_bf16(x.x * sc * g4.x, x.y * sc * g4.y); w.y = pg8::cvt_pk_bf16(x.z * sc * g4.z, x.w * sc * g4.w); *(LAS u32x2v*)(Qb + r * 72 + c4) = w; }
                    if (restage)
#pragma unroll
                    for (int i = 0; i < 8; ++i) { const int v = tid + NTHR * i; const int j = v >> 4, c4 = (v & 15) * 4;
                        const f32x4 kx = *(const f32x4*)(mk + (size_t)j * 256 + c4); const f32x4 vx = *(const f32x4*)(mv + (size_t)j * 256 + c4);
                        typedef unsigned u32x2v __attribute__((ext_vector_type(2)));
                        u32x2v w; w.x = pg8::cvt_pk_bf16(kx.x, kx.y); w.y = pg8::cvt_pk_bf16(kx.z, kx.w); *(LAS u32x2v*)(Kb + j * 72 + c4) = w;
                        Vt[(c4 + 0) * 264 + j] = (bf16)f2bf(vx.x); Vt[(c4 + 1) * 264 + j] = (bf16)f2bf(vx.y); Vt[(c4 + 2) * 264 + j] = (bf16)f2bf(vx.z); Vt[(c4 + 3) * 264 + j] = (bf16)f2bf(vx.w); }
                    __syncthreads();
                    for (int tile = wave; tile < 64; tile += 8) { const int ti = tile >> 4, tj = tile & 15;
                        f32x4 acc = mmb16(Qb + ti * 16 * 72, 72, Kb + tj * 16 * 72, 72, 64, (f32x4){0.f, 0.f, 0.f, 0.f}, lane);
#pragma unroll
                        for (int r = 0; r < 4; ++r) S[(ti * 16 + 4 * fq + r) * 260 + tj * 16 + fr] = acc[r]; }
                    __syncthreads();
#pragma unroll
                    for (int q = 0; q < 8; ++q) { const int rr = wave * 8 + q; float x[4]; float mx = -INFINITY;
#pragma unroll
                        for (int j = 0; j < 4; ++j) { x[j] = S[rr * 260 + lane + 64 * j]; mx = fmaxf(mx, x[j]); }
                        mx = wave_max(mx); float sum = 0.f;
#pragma unroll
                        for (int j = 0; j < 4; ++j) { x[j] = __expf(x[j] - mx); sum += x[j]; }
                        const float inv = 1.f / wave_sum(sum); LAS bf16* pr = (LAS bf16*)(S + rr * 260);
#pragma unroll
                        for (int j = 0; j < 4; ++j) pr[lane + 64 * j] = (bf16)f2bf(x[j] * inv); }
                    __syncthreads();
                    for (int tile = wave; tile < 16; tile += 8) { const int ti = tile >> 2, tj = tile & 3;
                      f32x4 acc = mmb16((LAS bf16*)S + ti * 16 * 520, 520, Vt + tj * 16 * 264, 264, 256, (f32x4){0.f, 0.f, 0.f, 0.f}, lane);
#pragma unroll
                      for (int r = 0; r < 4; ++r) OMEM[(r0 + ti * 16 + 4 * fq + r) * 256 + h * 64 + tj * 16 + fr] = (bf16)f2bf(acc[r]); }
                    __syncthreads();
                } else { SUB_PROF(15); TID_UNIT const int idx = u - 1024, n = idx >> 1, part = idx & 1; const size_t row = (size_t)MP + n; const size_t ln = (size_t)l * NS + n;
                    typedef float f32x2v __attribute__((ext_vector_type(2)));
                    LAS float* qn = L; LAS float* sc = L + 128; LAS float* red = L + 648;
                    if (wave < 2) { const int hq = part * 2 + wave; const float qx = bf2f(QM[row * 256 + hq * 64 + lane]); const float ssq = wave_sum(qx * qx); qn[wave * 64 + lane] = qx * rsqrtf(ssq * (1.f / 64.f) + EPS) * gmq[lane] * 0.125f; }
                    __syncthreads();
                    const int hl = lane >> 5, dd = (lane & 31) * 2; const float q0 = qn[hl * 64 + dd], q1 = qn[hl * 64 + dd + 1];
                    const float* ck = a.in[8] + ln * 256 * 256 + part * 128; const float* cv = a.in[9] + ln * 256 * 256 + part * 128;
#pragma unroll 1
                    for (int ib = 0; ib < 32; ib += 16) { f32x2v kr[16];
#pragma unroll
                        for (int jj = 0; jj < 16; ++jj) kr[jj] = __builtin_nontemporal_load((const f32x2v*)(ck + (size_t)((tid >> 6) + 8 * (ib + jj)) * 256 + lane * 2));
#pragma unroll
                        for (int jj = 0; jj < 16; ++jj) { float s_ = kr[jj].x * q0 + kr[jj].y * q1; s_ = sum32_hi(s_);
                            if ((lane & 31) == 16) sc[hl * 260 + (tid >> 6) + 8 * (ib + jj)] = s_; } }
                    __syncthreads();
                    if (wave < 2) { float x[4]; float mx = -INFINITY;
#pragma unroll
                        for (int j = 0; j < 4; ++j) { x[j] = sc[wave * 260 + lane + 64 * j]; mx = fmaxf(mx, x[j]); }
                        mx = wave_max(mx); float sum = 0.f;
#pragma unroll
                        for (int j = 0; j < 4; ++j) { x[j] = __expf(x[j] - mx); sum += x[j]; }
                        const float inv = 1.f / wave_sum(sum);
#pragma unroll
                        for (int j = 0; j < 4; ++j) sc[wave * 260 + lane + 64 * j] = x[j] * inv; }
                    __syncthreads();
                    float a0 = 0.f, a1 = 0.f;
#pragma unroll 1
                    for (int ib = 0; ib < 32; ib += 16) { f32x2v vr[16];
#pragma unroll
                        for (int jj = 0; jj < 16; ++jj) vr[jj] = __builtin_nontemporal_load((const f32x2v*)(cv + (size_t)((tid >> 6) + 8 * (ib + jj)) * 256 + lane * 2));
#pragma unroll
                        for (int jj = 0; jj < 16; ++jj) { const float p_ = sc[hl * 260 + (tid >> 6) + 8 * (ib + jj)]; a0 += p_ * vr[jj].x; a1 += p_ * vr[jj].y; } }
                    red[wave * 128 + lane * 2] = a0; red[wave * 128 + lane * 2 + 1] = a1;
                    __syncthreads();
                    if (tid < 128) { float s_ = 0.f;
#pragma unroll
                        for (int w = 0; w < 8; ++w) s_ += red[w * 128 + tid];
                        OMEM[row * 256 + part * 128 + tid] = (bf16)f2bf(s_); }
                    __syncthreads();
                }
            }
        }
        PH_NEXT;
        if (PH_ON) { TID_DECL
            pg8::Gemm g{OMEM, (const bf16*)(wl + WO_O), MP, D, 256}; pg8::StaticOrder S; S.init(MP, D, G, bid);
            pg8::EpiResid E{out, XB, ss2, MR};
            pg8::gemm_phase<pg8::EpiResid, pg8::StaticOrder, true, true>(lds, g, S, E);
            for (int u = G - 1 - bid; u < 256; u += G) small_gemm_sk<3>(OMEM + (size_t)MP * 256, (const bf16*)(wl + WO_O), 256, u, L, nullptr, 0, nullptr, ss2, out, XB, lane, wave);
            __syncthreads();
        }
        PH_NEXT;
        if (PH_ON) { TID_DECL
            for (int rep_ = 0; rep_ < REP_G9; ++rep_) {
            pg8::Gemm g{XB, (const bf16*)(wl + WO_1), MP, FF, D}; pg8::StaticOrder S; S.init(MP, FF, G, bid);
            pg8::EpiScaleBf16<1> E{HF, FF, ss2};
            pg8::gemm_phase<pg8::EpiScaleBf16<1>, pg8::StaticOrder, true, true>(lds, g, S, E);
            for (int u = G - 1 - bid; u < FF / 32; u += G) small_gemm<1>(XB + (size_t)MP * D, (const bf16*)(wl + WO_1), D, u, HF, FF, ss2, nullptr, nullptr, nullptr, lane, wave);
            __syncthreads(); }
            __syncthreads();
        }
        PH_NEXT;
        if (PH_ON) { TID_DECL
            pg8::Gemm g{HF, (const bf16*)(wl + WO_2), MP, D, FF}; pg8::StaticOrder S; S.init(MP, D, G, bid);
            unsigned long long* sso = l + 1 < DEPTH ? ssn : SSM + 512;
            for (int rep_ = 1; rep_ < REP_G10; ++rep_) { pg8::Gemm g{HF, (const bf16*)(wl + WO_2), MP, D, FF}; pg8::StaticOrder S; S.init(MP, D, G, bid);
                pg8::EpiResid E{(float*)(ws + WS_DUMX), (bf16*)(ws + WS_DUMB), (unsigned long long*)(ws + WS_DUMS), MR};
                pg8::gemm_phase<pg8::EpiResid, pg8::StaticOrder, true, true>(lds, g, S, E); __syncthreads(); }
            pg8::EpiResid E{out, XB, sso, MR};
            pg8::gemm_phase<pg8::EpiResid, pg8::StaticOrder, true, true>(lds, g, S, E);
            for (int u = G - 1 - bid; u < 256; u += G) small_gemm_sk<3>(HF + (size_t)MP * FF, (const bf16*)(wl + WO_2), FF, u, L, nullptr, 0, nullptr, sso, out, XB, lane, wave);
            __syncthreads();
        }
        PH_NEXT;
    }
#if PROF_MASK
    if (blockIdx.x == 0) { const unsigned long long t_end = rt(); while (rt() - t_end < 4ull * t_acc) __builtin_amdgcn_s_sleep(16); }
#endif
}

#ifndef MK_MULTI
#define MK_MULTI 0
#endif
extern "C" void kernel_launch(void* const* d_in, const int* in_sizes, int n_in, void* d_out, int out_size, void* d_ws, size_t ws_size, hipStream_t stream) {
    static int grid = 0;
    constexpr int NPH = 1 + DEPTH * 10;
    if (grid == 0) {
        if (n_in != 36 || out_size != (int)O_END || ws_size < WS_END) { fprintf(stderr, "kernel_launch: unexpected shapes: n_in %d out %d ws %zu\n", n_in, out_size, ws_size); grid = -1; return; }
        int dev = 0, cus = 0, per_cu = 0;
        (void)hipGetDevice(&dev); (void)hipDeviceGetAttribute(&cus, hipDeviceAttributeMultiprocessorCount, dev);
        if (hipFuncSetAttribute((const void*)mk_fwd, hipFuncAttributeMaxDynamicSharedMemorySize, LDS_BYTES) != hipSuccess) { fprintf(stderr, "kernel_launch: hipFuncSetAttribute failed\n"); grid = -1; return; }
        if (hipOccupancyMaxActiveBlocksPerMultiprocessor(&per_cu, (const void*)mk_fwd, NTHR, LDS_BYTES) != hipSuccess || per_cu < 1) { fprintf(stderr, "kernel_launch: occupancy query says %d\n", per_cu); per_cu = 1; }
        (void)hipGetLastError();
        grid = cus;
        fprintf(stderr, "kernel_launch: grid %d (occupancy %d per CU)\n", grid, per_cu);
    }
    if (grid < 0) return;
    (void)hipMemsetAsync((char*)d_ws + WS_CTL, 0, CTL_ZERO_BYTES, stream);
    (void)hipMemsetAsync((char*)d_ws + WS_SS, 0, SS_BYTES, stream);
    Args a{};
    for (int i = 0; i < 36; ++i) a.in[i] = (const float*)d_in[i];
    a.out = (float*)d_out; a.ws = (unsigned char*)d_ws; a.use_cg = 0; a.pad = 0;
#if MK_MULTI
    for (int p = 0; p < NPH; ++p) { a.ph_lo = p; a.ph_hi = p + 1; hipLaunchKernelGGL(mk_fwd, dim3(grid), dim3(NTHR), LDS_BYTES, stream, a); }
#else
    a.ph_lo = 0; a.ph_hi = NPH; a.use_cg = 1;
    void* args[] = {&a};
    hipError_t e = hipLaunchCooperativeKernel((const void*)mk_fwd, dim3(grid), dim3(NTHR), args, LDS_BYTES, stream);
    if (e != hipSuccess) fprintf(stderr, "cooperative launch failed: %s (grid %d)\n", hipGetErrorString(e), grid);
#endif
}
```
